# Optimizing an MI355X kernel written in HIP

```python
import jax, jax.numpy as jnp
from jax import lax
import numpy as np

D_MODEL = 1024
BATCH = 16
SEQ = 2048
DEPTH = 4

FOX_HEADS = 8
FOX_HEAD_DIM = 64
FOX_WIDTH = FOX_HEADS * FOX_HEAD_DIM
Q_BLOCK = 128
SGU_GROUPS = 8
SGU_WIDTH = 512
SGU_CHUNK = 128
CONV_WIDTH = 512
CONV_KERNEL = 31
POOL_WINDOWS = (2, 4, 8, 16)
POOL_WIDTH = 512
POOL_GROUP = POOL_WIDTH // len(POOL_WINDOWS)
N_BRANCH = 4
BRANCH_WIDTH = 512
IN_SIZES = (FOX_WIDTH, FOX_WIDTH, FOX_WIDTH, FOX_HEADS, SGU_WIDTH, SGU_WIDTH, 2 * CONV_WIDTH, POOL_WIDTH, N_BRANCH * D_MODEL)
IN_WIDTH = 3 * FOX_WIDTH + FOX_HEADS + 2 * SGU_WIDTH + 2 * CONV_WIDTH + POOL_WIDTH + N_BRANCH * D_MODEL
DENSE_FF = 2816
N_EXPERTS = 8
TOP_K = 2
EXPERT_FF = 3584
MOE_BLOCK = 256
N_DENSE = (DEPTH + 1) // 2
N_MOE = DEPTH // 2
EPS = 1e-6

kernel_name = "hybrid_gated_fox_sgu_conv_pool_moe"


def rms_norm(x, g):
    xf = x.astype(jnp.float32)
    y = xf * lax.rsqrt(jnp.mean(xf * xf, axis=-1, keepdims=True) + EPS)
    return (y * g.astype(jnp.float32)).astype(x.dtype)


def forget_attention(q, k, v, f_logit, b_f, g_q, g_k):
    B, S, _ = q.shape
    H, Dh = FOX_HEADS, FOX_HEAD_DIM
    nb = S // Q_BLOCK
    q = rms_norm(q.reshape(B, S, H, Dh), g_q)
    k = rms_norm(k.reshape(B, S, H, Dh), g_k).transpose(0, 2, 1, 3)
    v = v.reshape(B, S, H, Dh).transpose(0, 2, 1, 3)
    log_f = jax.nn.log_sigmoid((f_logit + b_f).astype(jnp.float32))
    c = jnp.cumsum(log_f, axis=1).transpose(0, 2, 1)
    qb = q.reshape(B, nb, Q_BLOCK, H, Dh).transpose(1, 0, 3, 2, 4)
    cqb = c.reshape(B, H, nb, Q_BLOCK).transpose(2, 0, 1, 3)
    kpos = jnp.arange(S)
    scale = Dh ** -0.5

    def block(args):
        qi, cqi, i = args
        s = jnp.einsum('bhqd,bhkd->bhqk', qi, k, preferred_element_type=jnp.float32) * scale
        s = s + cqi[..., None] - c[:, :, None, :]
        qpos = i * Q_BLOCK + jnp.arange(Q_BLOCK)
        s = jnp.where(kpos[None, :] <= qpos[:, None], s, -jnp.inf)
        p = jax.nn.softmax(s, axis=-1).astype(v.dtype)
        return jnp.einsum('bhqk,bhkd->bhqd', p, v)

    out = lax.map(block, (qb, cqb, jnp.arange(nb)))
    return out.transpose(1, 0, 3, 2, 4).reshape(B, S, H * Dh)


def chunked_sgu(u, v, g_v, w_s, b_s):
    B, S, C = u.shape
    L, G = SGU_CHUNK, SGU_GROUPS
    u = jax.nn.gelu(u)
    v = rms_norm(jax.nn.gelu(v), g_v)
    vc = v.reshape(B, S // L, L, G, C // G)
    w = jnp.where(jnp.tril(jnp.ones((L, L), dtype=bool)), w_s, jnp.zeros_like(w_s))
    mixed = jnp.einsum('gts,bnsgc->bntgc', w, vc) + b_s.T[None, None, :, :, None]
    return u * mixed.reshape(B, S, C)


def conformer_conv(a, w_dw, b_dw, g_c):
    val, gate = jnp.split(a, 2, axis=-1)
    y = val * jax.nn.sigmoid(gate)
    C = y.shape[-1]
    y = lax.conv_general_dilated(y, w_dw[:, None, :], window_strides=(1,), padding=[(CONV_KERNEL - 1, 0)],
                                 dimension_numbers=('NWC', 'WIO', 'NWC'), feature_group_count=C) + b_dw
    return jax.nn.silu(rms_norm(y, g_c))


def multiscale_pool(p, w_pg, ls):
    B, S, C = p.shape
    cs = jnp.pad(jnp.cumsum(p.astype(jnp.float32), axis=1), ((0, 0), (1, 0), (0, 0)))
    t = jnp.arange(S)
    outs = []
    for gi, w in enumerate(POOL_WINDOWS):
        csg = cs[..., gi * POOL_GROUP:(gi + 1) * POOL_GROUP]
        lo = jnp.maximum(t + 1 - w, 0)
        total = csg[:, 1:] - jnp.take(csg, lo, axis=1)
        cnt = jnp.minimum(t + 1, w).astype(jnp.float32)
        outs.append(total / cnt[None, :, None])
    pooled = jnp.concatenate(outs, axis=-1).astype(p.dtype) - p
    pooled = jnp.einsum('bsgc,gcd->bsgd', pooled.reshape(B, S, len(POOL_WINDOWS), POOL_GROUP), w_pg)
    return pooled.reshape(B, S, C) * ls


def dense_swiglu(h, w_g, w_u, w_d):
    return (jax.nn.silu(h @ w_g) * (h @ w_u)) @ w_d


def moe_swiglu(h, w_router, w_g, w_u, w_d):
    B, S, D = h.shape
    N = B * S
    NK = N * TOP_K
    xt = h.reshape(N, D)
    logits = (xt @ w_router).astype(jnp.float32)
    top_val, top_idx = lax.top_k(logits, TOP_K)
    gates = jax.nn.softmax(top_val, axis=-1)
    e_flat = top_idx.reshape(-1)
    tok_flat = jnp.arange(NK) // TOP_K
    g_flat = gates.reshape(-1)
    order = jnp.argsort(e_flat)
    e_sorted = e_flat[order]
    sizes = jnp.bincount(e_flat, length=N_EXPERTS)
    padded = (sizes + MOE_BLOCK - 1) // MOE_BLOCK * MOE_BLOCK
    start = jnp.cumsum(sizes) - sizes
    pend = jnp.cumsum(padded)
    pstart = pend - padded
    dest = pstart[e_sorted] + jnp.arange(NK) - start[e_sorted]
    P = -(-NK // MOE_BLOCK) * MOE_BLOCK + N_EXPERTS * MOE_BLOCK
    nb = P // MOE_BLOCK
    tok_buf = jnp.full((P,), N, dtype=jnp.int32).at[dest].set(tok_flat[order].astype(jnp.int32))
    g_buf = jnp.zeros((P,), jnp.float32).at[dest].set(g_flat[order])
    blk_e = jnp.minimum(jnp.searchsorted(pend, jnp.arange(nb) * MOE_BLOCK, side='right'), N_EXPERTS - 1)
    x_pad = jnp.concatenate([xt, jnp.zeros((1, D), xt.dtype)], axis=0)
    xs = x_pad[tok_buf].reshape(nb, MOE_BLOCK, D)

    def expert_block(args):
        xb, e = args
        return (jax.nn.silu(xb @ w_g[e]) * (xb @ w_u[e])) @ w_d[e]

    ys = lax.map(expert_block, (xs, blk_e)).reshape(P, D)
    ys = ys * g_buf[:, None].astype(ys.dtype)
    out = jax.ops.segment_sum(ys, tok_buf, num_segments=N + 1)[:N]
    return out.reshape(B, S, D)


def setup_inputs(seed: int = 0) -> dict:
    key = jax.random.key(seed)
    ks = jax.random.split(key, 26)
    nrm = lambda k, shape, s: jax.random.normal(k, shape, jnp.float32) * s
    L, D = DEPTH, D_MODEL
    return {
        "x": nrm(ks[0], (BATCH, SEQ, D), 1.0),
        "g_mix": 1.0 + nrm(ks[1], (L, D), 0.05),
        "w_in": nrm(ks[2], (L, D, IN_WIDTH), D ** -0.5),
        "b_forget": jax.random.uniform(ks[3], (L, FOX_HEADS), jnp.float32, 1.0, 6.0),
        "g_q": 1.0 + nrm(ks[4], (L, FOX_HEAD_DIM), 0.05),
        "g_k": 1.0 + nrm(ks[5], (L, FOX_HEAD_DIM), 0.05),
        "g_sgu": 1.0 + nrm(ks[6], (L, SGU_WIDTH), 0.05),
        "w_spatial": nrm(ks[7], (L, SGU_GROUPS, SGU_CHUNK, SGU_CHUNK), 0.5 * SGU_CHUNK ** -0.5),
        "b_spatial": 1.0 + nrm(ks[8], (L, SGU_GROUPS, SGU_CHUNK), 0.1),
        "w_dwconv": nrm(ks[9], (L, CONV_KERNEL, CONV_WIDTH), CONV_KERNEL ** -0.5),
        "b_dwconv": nrm(ks[10], (L, CONV_WIDTH), 0.02),
        "g_conv": 1.0 + nrm(ks[11], (L, CONV_WIDTH), 0.05),
        "w_pool": nrm(ks[12], (L, len(POOL_WINDOWS), POOL_GROUP, POOL_GROUP), POOL_GROUP ** -0.5),
        "pool_scale": 1.0 + nrm(ks[13], (L, POOL_WIDTH), 0.1),
        "w_branch": nrm(ks[14], (L, N_BRANCH, BRANCH_WIDTH, D), BRANCH_WIDTH ** -0.5),
        "b_gate": nrm(ks[15], (L, N_BRANCH, D), 0.02),
        "w_out": nrm(ks[16], (L, D, D), D ** -0.5),
        "g_ffn": 1.0 + nrm(ks[17], (L, D), 0.05),
        "w_ffn_gate": nrm(ks[18], (N_DENSE, D, DENSE_FF), D ** -0.5),
        "w_ffn_up": nrm(ks[19], (N_DENSE, D, DENSE_FF), D ** -0.5),
        "w_ffn_down": nrm(ks[20], (N_DENSE, DENSE_FF, D), DENSE_FF ** -0.5),
        "w_router": nrm(ks[21], (N_MOE, D, N_EXPERTS), D ** -0.5),
        "w_exp_gate": nrm(ks[22], (N_MOE, N_EXPERTS, D, EXPERT_FF), D ** -0.5),
        "w_exp_up": nrm(ks[23], (N_MOE, N_EXPERTS, D, EXPERT_FF), D ** -0.5),
        "w_exp_down": nrm(ks[24], (N_MOE, N_EXPERTS, EXPERT_FF, D), EXPERT_FF ** -0.5),
    }


def reference(x, g_mix, w_in, b_forget, g_q, g_k, g_sgu, w_spatial, b_spatial, w_dwconv, b_dwconv, g_conv,
              w_pool, pool_scale, w_branch, b_gate, w_out, g_ffn, w_ffn_gate, w_ffn_up, w_ffn_down,
              w_router, w_exp_gate, w_exp_up, w_exp_down):
    B, S, D = x.shape
    splits = np.cumsum(IN_SIZES)[:-1].tolist()
    for l in range(DEPTH):
        h = rms_norm(x, g_mix[l])
        proj = h @ w_in[l]
        q, k, v, f_logit, su, sv, conv_in, pool_in, gate_logits = jnp.split(proj, splits, axis=-1)
        y_fox = forget_attention(q, k, v, f_logit, b_forget[l], g_q[l], g_k[l])
        y_sgu = chunked_sgu(su, sv, g_sgu[l], w_spatial[l], b_spatial[l])
        y_conv = conformer_conv(conv_in, w_dwconv[l], b_dwconv[l], g_conv[l])
        y_pool = multiscale_pool(pool_in, w_pool[l], pool_scale[l])
        ys = jnp.stack([y_fox, y_sgu, y_conv, y_pool], axis=2)
        yb = jnp.einsum('bsnc,ncd->bsnd', ys, w_branch[l])
        gates = jax.nn.sigmoid(gate_logits.reshape(B, S, N_BRANCH, D) + b_gate[l])
        merged = jnp.einsum('bsnd,bsnd->bsd', gates, yb)
        x = x + merged @ w_out[l]
        h2 = rms_norm(x, g_ffn[l])
        if l % 2 == 0:
            i = l // 2
            x = x + dense_swiglu(h2, w_ffn_gate[i], w_ffn_up[i], w_ffn_down[i])
        else:
            i = l // 2
            x = x + moe_swiglu(h2, w_router[i], w_exp_gate[i], w_exp_up[i], w_exp_down[i])
    return x
```

```cpp
#include <hip/hip_runtime.h>
#include <cstdio>
#include <cstdint>
namespace pg8 {
#define PG8_LAS __attribute__((address_space(3)))
typedef unsigned short bf16_t;
typedef short bf16x8 __attribute__((ext_vector_type(8)));
typedef float f32x4 __attribute__((ext_vector_type(4)));
typedef unsigned u32x4 __attribute__((ext_vector_type(4)));
constexpr int BM = 256, BK = 64, HALF = 128, HTB = HALF * BK * 2  , STAGE_BYTES = 8 * HTB, NXCD = 8, WGM = 8;

__host__ __device__ __forceinline__ int lds_byte(int r, int c) { const int st = (r >> 4) * 2 + (c >> 5), rr = r & 15, cc = c & 31, ob = rr * 64 + cc * 2; return st * 1024 + (ob ^ (((ob >> 9) & 1) << 5)); }
__host__ __device__ __forceinline__ void stage_rc(int b, int& R, int& C) { const int st = b / 1024, sb = b % 1024, swz = sb ^ (((sb >> 9) & 1) << 5); R = (st >> 1) * 16 + swz / 64; C = (st & 1) * 32 + (swz % 64) / 2; }
__host__ __device__ __forceinline__ int perm32(int rho) { const int n = rho >> 4, i = rho & 15; return 8 * (i >> 2) + 4 * n + (i & 3); }

struct Unit { int pm, pn; };
struct Gemm { const bf16_t* A; const bf16_t* Bt; int M, N, K; };

struct StaticOrder {
    int nM, nN, nwg, G, c;
    __host__ __device__ void init(int M, int N, int G_, int c_) { nM = M / BM; nN = N / BM; nwg = nM * nN; G = G_; c = c_; }
    __host__ __device__ bool next(int i, Unit& u) const {
        const long L = (long)i * G + c; if (L >= nwg) return false;
        int wgid = (int)L; { const int q = nwg / NXCD, r = nwg % NXCD, xcd = wgid % NXCD, off = wgid / NXCD; wgid = (xcd < r ? xcd * (q + 1) : r * (q + 1) + (xcd - r) * q) + off; }
        const int nig = WGM * nN, gid = wgid / nig, fm = gid * WGM, gsz = (nM - fm) < WGM ? (nM - fm) : WGM;
        u.pm = fm + ((wgid % nig) % gsz); u.pn = (wgid % nig) / gsz; return true;
    }
    __device__ __forceinline__ void a_ready(const Unit&) const {}
    __device__ __forceinline__ void done(const Unit&) const {}
};

__device__ __forceinline__ unsigned cvt_pk_bf16(float lo, float hi) { unsigned r; asm volatile("v_cvt_pk_bf16_f32 %0, %1, %2" : "=v"(r) : "v"(lo), "v"(hi)); return r; }
typedef float f32x2 __attribute__((ext_vector_type(2)));
__device__ __forceinline__ f32x2 gelu_pk(f32x2 v) {
    const f32x2 av = __builtin_elementwise_abs(v), d = av * 0.2316418882f + 1.0f;
    f32x2 t; t.x = __builtin_amdgcn_rcpf(d.x); t.y = __builtin_amdgcn_rcpf(d.y);
    f32x2 q = t * 0.5307027145f + (-0.7265760135f); q = q * t + 0.7107068705f; q = q * t + (-0.142248368f); q = q * t + 0.127414796f; q = q * t;
    const f32x2 s = (v * v) * (-0.72134752044f);
    f32x2 e; e.x = __builtin_amdgcn_exp2f(s.x); e.y = __builtin_amdgcn_exp2f(s.y);
    const f32x2 m = v * (q * e), r = v - m;
    f32x2 o; o.x = v.x < 0.f ? m.x : r.x; o.y = v.y < 0.f ? m.y : r.y; return o;
}

template <int ACT  > struct EpiBf16 {
    static constexpr bool PERM = true, AFTER_DRAIN = false; static_assert(ACT == 0 || ACT == 1, "EpiBf16: ACT is 0 (none) or 1 (gelu_pk)");
    bf16_t* O; int ldc; const float* bias; int split_cols; size_t split_stride; float scale0;
    __device__ __forceinline__ void operator()(const f32x4 (&acc)[2][2][4][2], const Unit& u, int wr, int wc, int fr, int fq) const {
        const int row0 = u.pm * BM + wr * 64 + fr; int colt = u.pn * BM; bf16_t* base = O;
        float sc = 1.f; if (split_cols) { const int t = colt / split_cols; base += (size_t)t * split_stride; colt -= t * split_cols; if (t == 0) sc = scale0; }
        const int col0 = colt + wc * 32 + 8 * fq, bcol0 = u.pn * BM + wc * 32 + 8 * fq;
        f32x4 bv[2][2];
#pragma unroll
        for (int bj = 0; bj < 2; ++bj)
#pragma unroll
            for (int n = 0; n < 2; ++n) bv[bj][n] = bias ? *(const f32x4*)(bias + bcol0 + bj * HALF + 4 * n) : (f32x4){0.f, 0.f, 0.f, 0.f};
#pragma unroll
        for (int ai = 0; ai < 2; ++ai)
#pragma unroll
            for (int m = 0; m < 4; ++m) { bf16_t* rowp = base + (size_t)(row0 + ai * HALF + m * 16) * ldc + col0;
#pragma unroll
                for (int bj = 0; bj < 2; ++bj) { f32x4 v0 = acc[ai][bj][m][0] + bv[bj][0], v1 = acc[ai][bj][m][1] + bv[bj][1];
                    if (ACT == 1) { f32x2 a = gelu_pk((f32x2){v0[0], v0[1]}), b = gelu_pk((f32x2){v0[2], v0[3]}), c = gelu_pk((f32x2){v1[0], v1[1]}), d = gelu_pk((f32x2){v1[2], v1[3]});
                        v0 = (f32x4){a.x, a.y, b.x, b.y}; v1 = (f32x4){c.x, c.y, d.x, d.y}; }
                    v0 = v0 * sc; v1 = v1 * sc; u32x4 w; w.x = cvt_pk_bf16(v0[0], v0[1]); w.y = cvt_pk_bf16(v0[2], v0[3]); w.z = cvt_pk_bf16(v1[0], v1[1]); w.w = cvt_pk_bf16(v1[2], v1[3]);
                    *(u32x4*)(rowp + bj * HALF) = w; } }
    }
};


typedef unsigned u32x2 __attribute__((ext_vector_type(2)));
__device__ __forceinline__ float fast_sigmoid(float x) { return __builtin_amdgcn_rcpf(1.0f + __builtin_amdgcn_exp2f(-1.4426950408889634f * x)); }
__device__ __forceinline__ float gelu_tanh(float x) {
    const float a = 1.5957691216057308f * (x + 0.044715f * x * x * x);
    return x * fast_sigmoid(a);
}
__device__ __forceinline__ float bf_lo(unsigned w) { return __uint_as_float(w << 16); }
__device__ __forceinline__ float bf_hi(unsigned w) { return __uint_as_float(w & 0xffff0000u); }
__device__ __forceinline__ u32x4 pack8(f32x4 v0, f32x4 v1) { u32x4 w; w.x = cvt_pk_bf16(v0[0], v0[1]); w.y = cvt_pk_bf16(v0[2], v0[3]); w.z = cvt_pk_bf16(v1[0], v1[1]); w.w = cvt_pk_bf16(v1[2], v1[3]); return w; }

struct EpiProj {
    static constexpr bool PERM = true, AFTER_DRAIN = false;
    unsigned char* ws; const float* bgate; size_t oQ, oK, oSUV, oCY, oPIN, oG;
    __device__ __forceinline__ void operator()(const f32x4 (&acc)[2][2][4][2], const Unit& u, int wr, int wc, int fr, int fq) const {
        const int row0 = u.pm * BM + wr * 64 + fr; const int pn = u.pn; const int cw = wc * 32 + 8 * fq;
        if (pn >= 8 && pn < 12) {
            bf16_t* base = (bf16_t*)(ws + oCY) + (pn - 8) * HALF + cw;
#pragma unroll
            for (int ai = 0; ai < 2; ++ai)
#pragma unroll
                for (int m = 0; m < 4; ++m) { bf16_t* rowp = base + (size_t)(row0 + ai * HALF + m * 16) * 512;
                    f32x4 v0 = acc[ai][0][m][0], v1 = acc[ai][0][m][1]; const f32x4 g0 = acc[ai][1][m][0], g1 = acc[ai][1][m][1];
#pragma unroll
                    for (int e = 0; e < 4; ++e) { v0[e] *= fast_sigmoid(g0[e]); v1[e] *= fast_sigmoid(g1[e]); }
                    *(u32x4*)rowp = pack8(v0, v1); }
        } else {
            size_t boff; int ld, colt, kind;
            if (pn < 2) { boff = oQ; ld = 512; colt = pn * BM; kind = 0; }
            else if (pn < 4) { boff = oK; ld = 512; colt = (pn - 2) * BM; kind = 0; }
            else if (pn < 8) { boff = oSUV; ld = 1024; colt = (pn - 4) * BM; kind = 1; }
            else if (pn < 14) { boff = oPIN; ld = 512; colt = (pn - 12) * BM; kind = 0; }
            else { boff = oG; ld = 4096; colt = (pn - 14) * BM; kind = 2; }
            bf16_t* base = (bf16_t*)(ws + boff) + colt + cw;
            f32x4 bv[2][2];
#pragma unroll
            for (int bj = 0; bj < 2; ++bj)
#pragma unroll
                for (int n = 0; n < 2; ++n) bv[bj][n] = (kind == 2) ? *(const f32x4*)(bgate + colt + cw + bj * HALF + 4 * n) : (f32x4){0.f, 0.f, 0.f, 0.f};
#pragma unroll
            for (int ai = 0; ai < 2; ++ai)
#pragma unroll
                for (int m = 0; m < 4; ++m) { bf16_t* rowp = base + (size_t)(row0 + ai * HALF + m * 16) * ld;
#pragma unroll
                    for (int bj = 0; bj < 2; ++bj) { f32x4 v0 = acc[ai][bj][m][0] + bv[bj][0], v1 = acc[ai][bj][m][1] + bv[bj][1];
                        if (kind == 2) {
#pragma unroll
                            for (int e = 0; e < 4; ++e) { v0[e] = fast_sigmoid(v0[e]); v1[e] = fast_sigmoid(v1[e]); }
                        } else if (kind == 1) {
#pragma unroll
                            for (int e = 0; e < 4; ++e) { v0[e] = gelu_tanh(v0[e]); v1[e] = gelu_tanh(v1[e]); } }
                        *(u32x4*)(rowp + bj * HALF) = pack8(v0, v1); } }
        }
    }
};

struct EpiMerge {
    static constexpr bool PERM = true, AFTER_DRAIN = false;
    const bf16_t* G; bf16_t* MG;
    __device__ __forceinline__ void operator()(const f32x4 (&acc)[2][2][4][2], const Unit& u, int wr, int wc, int fr, int fq) const {
        const int br = u.pn >> 2, ct = u.pn & 3, rt = u.pm - br * 128;
        const int row0 = rt * BM + wr * 64 + fr, col0 = ct * BM + wc * 32 + 8 * fq;
#pragma unroll
        for (int ai = 0; ai < 2; ++ai)
#pragma unroll
            for (int m = 0; m < 4; ++m) { const size_t row = (size_t)(row0 + ai * HALF + m * 16);
#pragma unroll
                for (int bj = 0; bj < 2; ++bj) { const int col = col0 + bj * HALF;
                    const u32x4 g = *(const u32x4*)(G + row * 4096 + br * 1024 + col);
                    f32x4 v0 = acc[ai][bj][m][0], v1 = acc[ai][bj][m][1];
                    v0[0] *= bf_lo(g.x); v0[1] *= bf_hi(g.x); v0[2] *= bf_lo(g.y); v0[3] *= bf_hi(g.y);
                    v1[0] *= bf_lo(g.z); v1[1] *= bf_hi(g.z); v1[2] *= bf_lo(g.w); v1[3] *= bf_hi(g.w);
                    bf16_t* mp = MG + row * 1024 + col;
                    if (br > 0) { const u32x4 o = *(const u32x4*)mp;
                        v0[0] += bf_lo(o.x); v0[1] += bf_hi(o.x); v0[2] += bf_lo(o.y); v0[3] += bf_hi(o.y);
                        v1[0] += bf_lo(o.z); v1[1] += bf_hi(o.z); v1[2] += bf_lo(o.w); v1[3] += bf_hi(o.w); }
                    *(u32x4*)mp = pack8(v0, v1); } }
    }
};
struct MergeOrder {
    int G, c;
    __device__ __forceinline__ bool next(int i, Unit& u) const {
        const int tl = (i >> 2) * G + c; if (tl >= 512) return false;
        const int br = i & 3, rt = tl >> 2, ct = tl & 3; u.pm = br * 128 + rt; u.pn = br * 4 + ct; return true;
    }
    __device__ __forceinline__ void a_ready(const Unit&) const {}
    __device__ __forceinline__ void done(const Unit&) const {}
};

struct EpiResid {
    static constexpr bool PERM = true, AFTER_DRAIN = false;
    const float* xin; float* xout;
    __device__ __forceinline__ void operator()(const f32x4 (&acc)[2][2][4][2], const Unit& u, int wr, int wc, int fr, int fq) const {
        const int row0 = u.pm * BM + wr * 64 + fr, col0 = u.pn * BM + wc * 32 + 8 * fq;
#pragma unroll
        for (int ai = 0; ai < 2; ++ai)
#pragma unroll
            for (int m = 0; m < 4; ++m) { const size_t off = (size_t)(row0 + ai * HALF + m * 16) * 1024 + col0;
#pragma unroll
                for (int bj = 0; bj < 2; ++bj) {
                    const f32x4 a = *(const f32x4*)(xin + off + bj * HALF), b = *(const f32x4*)(xin + off + bj * HALF + 4);
                    *(f32x4*)(xout + off + bj * HALF) = a + acc[ai][bj][m][0]; *(f32x4*)(xout + off + bj * HALF + 4) = b + acc[ai][bj][m][1]; } }
    }
};

struct EpiSwiglu {
    static constexpr bool PERM = true, AFTER_DRAIN = false;
    bf16_t* ACT; int ldc, nct;
    __device__ __forceinline__ void operator()(const f32x4 (&acc)[2][2][4][2], const Unit& u, int wr, int wc, int fr, int fq) const {
        const int row0 = u.pm * BM + wr * 64 + fr, col0 = (u.pn % nct) * HALF + wc * 32 + 8 * fq;
#pragma unroll
        for (int ai = 0; ai < 2; ++ai)
#pragma unroll
            for (int m = 0; m < 4; ++m) { bf16_t* rowp = ACT + (size_t)(row0 + ai * HALF + m * 16) * ldc + col0;
                const f32x4 g0 = acc[ai][0][m][0], g1 = acc[ai][0][m][1]; f32x4 v0 = acc[ai][1][m][0], v1 = acc[ai][1][m][1];
#pragma unroll
                for (int e = 0; e < 4; ++e) { v0[e] *= g0[e] * fast_sigmoid(g0[e]); v1[e] *= g1[e] * fast_sigmoid(g1[e]); }
                *(u32x4*)rowp = pack8(v0, v1); }
    }
};

struct EpiDownMoe {
    static constexpr bool PERM = true, AFTER_DRAIN = false;
    const int* rinfo; bf16_t* Y;
    __device__ __forceinline__ void operator()(const f32x4 (&acc)[2][2][4][2], const Unit& u, int wr, int wc, int fr, int fq) const {
        const int prow0 = u.pm * BM + wr * 64 + fr, col0 = (u.pn & 3) * BM + wc * 32 + 8 * fq;
#pragma unroll
        for (int ai = 0; ai < 2; ++ai)
#pragma unroll
            for (int m = 0; m < 4; ++m) { const int prow = prow0 + ai * HALF + m * 16;
                const u32x2 ri = *(const u32x2*)(rinfo + 2 * (size_t)prow); const int tokk = (int)ri.x; const float gt = __uint_as_float(ri.y);
                if (tokk >= 0) { bf16_t* rowp = Y + ((size_t)(tokk & 1) * 32768 + (size_t)(tokk >> 1)) * 1024 + col0;
#pragma unroll
                    for (int bj = 0; bj < 2; ++bj) *(u32x4*)(rowp + bj * HALF) = pack8(acc[ai][bj][m][0] * gt, acc[ai][bj][m][1] * gt); } }
    }
};
struct GroupedOrder {
    int G, c, nct, T; int tend[8];
    __device__ __forceinline__ bool next(int i, Unit& u) const {
        const int L = i * G + c; if (L >= T * nct) return false;
        const int nig = 8 * nct, grp = L / nig, w = L % nig, fm = grp * 8, gsz = (T - fm) < 8 ? (T - fm) : 8;
        const int rt = fm + w % gsz, ct = w / gsz; int e = 0;
#pragma unroll
        for (int k = 0; k < 7; ++k) e += (rt >= tend[k]) ? 1 : 0;
        u.pm = rt; u.pn = e * nct + ct; return true;
    }
    __device__ __forceinline__ void a_ready(const Unit&) const {}
    __device__ __forceinline__ void done(const Unit&) const {}
};
template <class Epi, class Sched, bool ALIGN_EPI = false, bool SP2 = false>
__device__ __forceinline__ void gemm_phase(PG8_LAS unsigned char* lds, const Gemm g, const Sched& S, const Epi& E) {
    int tid_l = threadIdx.x; asm volatile("" : "+v"(tid_l));
    const int tid = tid_l, wid = __builtin_amdgcn_readfirstlane(tid >> 6), lane = tid & 63, wr = wid >> 2, wc = wid & 3, fr = lane & 15, fq = lane >> 4;
    const int K = g.K, nt = K / BK;
    unsigned voffA[2], voffB[2];
#pragma unroll
    for (int i = 0; i < 2; ++i) { int R, C; stage_rc(tid * 16 + i * 8192, R, C); const int Rb = Epi::PERM ? ((R & ~31) + perm32(R & 31)) : R;
        voffA[i] = (unsigned)(R * K + C) * 2u; voffB[i] = (unsigned)(Rb * K + C) * 2u; }
    const size_t kstep = (size_t)(BK * 2);
    const size_t hstep = (size_t)HALF * K * 2;
    const size_t tstep = 2 * hstep;
    const unsigned ldsw = (unsigned)wid * 1024u;
    const int aoff = lds_byte(wr * 64 + fr, fq * 8), boff = lds_byte(wc * 32 + fr, fq * 8);
#define PG8_SA(b, h) (((b) * 2 + (h)) * HTB)
#define PG8_SB(b, h) ((4 + (b) * 2 + (h)) * HTB)
#define PG8_STAGE(bufoff, gbase, voff) do { _Pragma("unroll") for (int _i = 0; _i < 2; ++_i) \
        __builtin_amdgcn_global_load_lds((const unsigned*)((const char*)(gbase) + (voff)[_i]), (PG8_LAS unsigned*)(lds + (bufoff) + ldsw + _i * 8192), 16, 0, 0); } while (0)
#define PG8_LDA(dst, b, h) do { _Pragma("unroll") for (int m = 0; m < 4; ++m) _Pragma("unroll") for (int k = 0; k < 2; ++k) dst[m][k] = *(const PG8_LAS bf16x8*)(lds + PG8_SA(b, h) + aoff + m * 2048 + k * 1024); } while (0)
#define PG8_LDB(dst, b, h) do { _Pragma("unroll") for (int n = 0; n < 2; ++n) _Pragma("unroll") for (int k = 0; k < 2; ++k) dst[n][k] = *(const PG8_LAS bf16x8*)(lds + PG8_SB(b, h) + boff + n * 2048 + k * 1024); } while (0)
#define PG8_MMA(ai, bj, At, Bt) do { __builtin_amdgcn_s_setprio(1); _Pragma("unroll") for (int m = 0; m < 4; ++m) _Pragma("unroll") for (int n = 0; n < 2; ++n) _Pragma("unroll") for (int k = 0; k < 2; ++k) \
        acc[ai][bj][m][n] = __builtin_amdgcn_mfma_f32_16x16x32_bf16(Bt[n][k], At[m][k], acc[ai][bj][m][n], 0, 0, 0); __builtin_amdgcn_s_setprio(0); } while (0)
#define PG8_WAIT_V(n) asm volatile("s_waitcnt vmcnt(" #n ")" ::: "memory")
#define PG8_WAIT_L(n) asm volatile("s_waitcnt lgkmcnt(" #n ")" ::: "memory")
#define PG8_BAR __builtin_amdgcn_s_barrier()
#define PG8_SCHED __builtin_amdgcn_sched_barrier(0)
    Unit cur, nxt; int ui = 0;
    if (!S.next(0, cur)) return;
    f32x4 acc[2][2][4][2];
#pragma unroll
    for (int a = 0; a < 2; ++a)
#pragma unroll
        for (int b = 0; b < 2; ++b)
#pragma unroll
            for (int m = 0; m < 4; ++m)
#pragma unroll
                for (int n = 0; n < 2; ++n) acc[a][b][m][n] = (f32x4){0.f, 0.f, 0.f, 0.f};
    bf16x8 At[4][2], B0[2][2], B1[2][2];
    const char* cA = (const char*)g.A + (size_t)cur.pm * tstep; const char* cB = (const char*)g.Bt + (size_t)cur.pn * tstep;
    S.a_ready(cur);
    if constexpr (SP2) {
        PG8_STAGE(PG8_SB(0, 0), cB, voffB); PG8_STAGE(PG8_SB(0, 1), cB + hstep, voffB); PG8_STAGE(PG8_SA(0, 0), cA, voffA); PG8_STAGE(PG8_SA(0, 1), cA + hstep, voffA);
        if (wr == 1) PG8_BAR;
        PG8_WAIT_V(2); PG8_BAR;
        PG8_STAGE(PG8_SB(1, 0), cB + kstep, voffB); PG8_STAGE(PG8_SA(1, 0), cA + kstep, voffA); PG8_STAGE(PG8_SB(1, 1), cB + hstep + kstep, voffB);
        PG8_WAIT_V(6); PG8_BAR;
    } else {
        PG8_STAGE(PG8_SB(0, 0), cB, voffB); PG8_STAGE(PG8_SA(0, 0), cA, voffA); PG8_STAGE(PG8_SB(0, 1), cB + hstep, voffB); PG8_STAGE(PG8_SA(0, 1), cA + hstep, voffA);
        if (wr == 1) PG8_BAR;
        PG8_WAIT_V(4); PG8_BAR;
        PG8_STAGE(PG8_SB(1, 0), cB + kstep, voffB); PG8_STAGE(PG8_SA(1, 0), cA + kstep, voffA); PG8_STAGE(PG8_SB(1, 1), cB + hstep + kstep, voffB);
        PG8_WAIT_V(6); PG8_BAR;
    }
    for (;;) {
        const bool has_next = S.next(ui + 1, nxt);
        const char* nA = has_next ? (const char*)g.A + (size_t)nxt.pm * tstep : cA; const char* nB = has_next ? (const char*)g.Bt + (size_t)nxt.pn * tstep : cB;
        for (int t = 0; t < nt; t += 2) {
            const bool last = (t == nt - 2);
            const char* a1 = cA + (size_t)(t + 1) * kstep;
            const char* a2 = last ? nA : cA + (size_t)(t + 2) * kstep; const char* b2 = last ? nB : cB + (size_t)(t + 2) * kstep;
            const char* a3 = a2 + kstep; const char* b3 = b2 + kstep;
            if (last && has_next) S.a_ready(nxt);
            if constexpr (SP2) {
            PG8_LDB(B0, 0, 0); PG8_LDB(B1, 0, 1); PG8_SCHED; PG8_LDA(At, 0, 0); PG8_STAGE(PG8_SA(1, 1), a1 + hstep, voffA);
            PG8_WAIT_V(8); PG8_WAIT_L(0); PG8_BAR; PG8_MMA(0, 0, At, B0); PG8_MMA(0, 1, At, B1); PG8_BAR; PG8_SCHED;
            PG8_LDA(At, 0, 1); PG8_STAGE(PG8_SB(0, 0), b2, voffB); PG8_STAGE(PG8_SB(0, 1), b2 + hstep, voffB); PG8_STAGE(PG8_SA(0, 0), a2, voffA);
            PG8_WAIT_V(8); PG8_WAIT_L(0); PG8_BAR; PG8_MMA(1, 0, At, B0); PG8_MMA(1, 1, At, B1); PG8_BAR; PG8_SCHED;
            PG8_LDB(B0, 1, 0); PG8_LDB(B1, 1, 1); PG8_SCHED; PG8_LDA(At, 1, 0); PG8_STAGE(PG8_SA(0, 1), a2 + hstep, voffA);
            PG8_WAIT_V(8); PG8_WAIT_L(0); PG8_BAR; PG8_MMA(0, 0, At, B0); PG8_MMA(0, 1, At, B1); PG8_BAR; PG8_SCHED;
            PG8_LDA(At, 1, 1); PG8_STAGE(PG8_SB(1, 0), b3, voffB); PG8_STAGE(PG8_SB(1, 1), b3 + hstep, voffB); PG8_STAGE(PG8_SA(1, 0), a3, voffA);
            PG8_WAIT_V(8); PG8_WAIT_L(0); PG8_BAR; PG8_MMA(1, 0, At, B0); PG8_MMA(1, 1, At, B1); PG8_BAR; PG8_SCHED;
            } else {
            PG8_LDB(B0, 0, 0); PG8_SCHED; PG8_LDA(At, 0, 0); PG8_STAGE(PG8_SA(1, 1), a1 + hstep, voffA);
            PG8_WAIT_L(8); PG8_BAR; PG8_WAIT_L(0); PG8_MMA(0, 0, At, B0); PG8_BAR; PG8_SCHED;
            PG8_LDB(B1, 0, 1); PG8_STAGE(PG8_SB(0, 0), b2, voffB);
            PG8_BAR; PG8_WAIT_L(0); PG8_MMA(0, 1, At, B1); PG8_BAR;
            PG8_LDA(At, 0, 1); PG8_STAGE(PG8_SA(0, 0), a2, voffA);
            PG8_BAR; PG8_WAIT_L(0); PG8_MMA(1, 0, At, B0); PG8_BAR; PG8_SCHED;
            PG8_STAGE(PG8_SB(0, 1), b2 + hstep, voffB);
            PG8_WAIT_V(6); PG8_BAR; PG8_MMA(1, 1, At, B1); PG8_BAR;
            PG8_LDB(B0, 1, 0); PG8_SCHED; PG8_LDA(At, 1, 0); PG8_STAGE(PG8_SA(0, 1), a2 + hstep, voffA);
            PG8_WAIT_L(8); PG8_BAR; PG8_WAIT_L(0); PG8_MMA(0, 0, At, B0); PG8_BAR; PG8_SCHED;
            PG8_LDB(B1, 1, 1); PG8_STAGE(PG8_SB(1, 0), b3, voffB);
            PG8_BAR; PG8_WAIT_L(0); PG8_MMA(0, 1, At, B1); PG8_BAR;
            PG8_LDA(At, 1, 1); PG8_STAGE(PG8_SA(1, 0), a3, voffA);
            PG8_BAR; PG8_WAIT_L(0); PG8_MMA(1, 0, At, B0); PG8_BAR; PG8_SCHED;
            PG8_STAGE(PG8_SB(1, 1), b3 + hstep, voffB);
            PG8_WAIT_V(6); PG8_BAR; PG8_MMA(1, 1, At, B1); PG8_BAR;
            }
        }
        if constexpr (ALIGN_EPI) { if (wr == 0) PG8_BAR; }
        if constexpr (!Epi::AFTER_DRAIN) { E(acc, cur, wr, wc, fr, fq); S.done(cur); }
        if (!has_next) break;
#pragma unroll
        for (int a = 0; a < 2; ++a)
#pragma unroll
            for (int b = 0; b < 2; ++b)
#pragma unroll
                for (int m = 0; m < 4; ++m)
#pragma unroll
                    for (int n = 0; n < 2; ++n) acc[a][b][m][n] = (f32x4){0.f, 0.f, 0.f, 0.f};
        cur = nxt; cA = nA; cB = nB; ++ui;
        if constexpr (ALIGN_EPI) { if (wr == 1) PG8_BAR; }
    }
    PG8_WAIT_V(0);
    if constexpr (!ALIGN_EPI) { if (wr == 0) PG8_BAR; }
    PG8_BAR;
    if constexpr (Epi::AFTER_DRAIN) { E.fused(acc, cur, wr, wc, fr, fq, lds, wid, lane); S.done(cur); }
#undef PG8_SA
#undef PG8_SB
#undef PG8_STAGE
#undef PG8_LDA
#undef PG8_LDB
#undef PG8_MMA
#undef PG8_WAIT_V
#undef PG8_WAIT_L
#undef PG8_BAR
#undef PG8_SCHED
}
}

constexpr int NTOK = 32768, SEQ = 2048, DM = 1024, NLAYER = 4;
constexpr int INW = 8200;
constexpr int C_Q = 0, C_K = 512, C_V = 1024, C_F = 1536, C_SU = 1544, C_CONV = 2568, C_POOL = 3592, C_GATE = 4104;
constexpr int NPROJ = 7680;
constexpr int FFD = 2816, FFE = 3584, NEXP = 8;
constexpr int PMAX = 65536 + NEXP * 256;
constexpr float EPS = 1e-6f, LOG2E = 1.4426950408889634f;
constexpr int NWAVES = 8;

constexpr size_t MiB = 1u << 20;
constexpr size_t WS_CTL = 0, CTL_ZERO_BYTES = 1 * MiB;
constexpr size_t WS_LF = 1 * MiB;
constexpr size_t WS_RINFO = 2 * MiB;
constexpr size_t WS_ASG = 3 * MiB;
constexpr size_t WS_WMIX = 4 * MiB;
constexpr size_t WM_PROJ = WS_WMIX, WM_V = WM_PROJ + (size_t)NPROJ * 1024 * 2, WM_B = WM_V + 512 * 1024 * 2, WM_OUT = WM_B + (size_t)4096 * 512 * 2,
                 WM_PG = WM_OUT + (size_t)1024 * 1024 * 2, WM_SP = WM_PG + 4 * 128 * 128 * 2, WM_END = WM_SP + 8 * 128 * 128 * 2;
static_assert(WM_END <= 28 * MiB, "mixer weights");
constexpr size_t WS_H = 28 * MiB;
constexpr size_t WS_R = 92 * MiB;
constexpr size_t WS_Q = WS_R, WS_K = WS_Q + 32 * MiB, WS_VT = WS_K + 32 * MiB, WS_SUV = WS_VT + 32 * MiB, WS_CY = WS_SUV + 64 * MiB, WS_PIN = WS_CY + 32 * MiB,
                 WS_G = WS_PIN + 32 * MiB, WS_YS = WS_G + 256 * MiB, WS_MG = WS_YS + 128 * MiB, WS_MIX_END = WS_MG + 64 * MiB;
constexpr size_t WS_XS = WS_R;
constexpr size_t WS_WFFN = WS_XS + 132 * MiB;
constexpr size_t WF_GU = WS_WFFN, WF_D_DENSE = WF_GU + (size_t)2 * FFD * 1024 * 2, WF_D_MOE = WF_GU + (size_t)NEXP * 2 * FFE * 1024 * 2;
constexpr size_t WS_ACT = WS_WFFN + 168 * MiB;
constexpr size_t WS_END = WS_ACT + 462 * MiB;
static_assert(WF_D_MOE + (size_t)NEXP * 1024 * FFE * 2 <= WS_ACT && (size_t)PMAX * FFE * 2 <= 462 * MiB && (size_t)PMAX * 1024 * 2 <= 132 * MiB && WS_MIX_END <= WS_END, "d_ws map");
constexpr int CW_BAR = 4096;
constexpr int CW_CNT = 16384;

constexpr int RING_BYTES = 147456;
constexpr int MISC_OFF = RING_BYTES;
constexpr int LDS_BYTES = RING_BYTES + 256;

#define GAS __attribute__((address_space(1)))
#define LAS __attribute__((address_space(3)))
typedef unsigned short bf16_t;
typedef unsigned v4u __attribute__((ext_vector_type(4)));
typedef unsigned v2u __attribute__((ext_vector_type(2)));
typedef float f32x4 __attribute__((ext_vector_type(4)));
typedef float f32x16 __attribute__((ext_vector_type(16)));
typedef short bf16x8 __attribute__((ext_vector_type(8)));
typedef GAS unsigned gu32;
#define RLX_AGENT __ATOMIC_RELAXED, __HIP_MEMORY_SCOPE_AGENT
#define LDS_WAIT() asm volatile("s_waitcnt lgkmcnt(0)" ::: "memory")
typedef float f32x2_t __attribute__((ext_vector_type(2))); typedef __bf16 bf16x2_t __attribute__((ext_vector_type(2)));
__device__ __forceinline__ unsigned pk2(float lo, float hi) { f32x2_t v = {lo, hi}; bf16x2_t b = __builtin_convertvector(v, bf16x2_t); return __builtin_bit_cast(unsigned, b); }
__device__ __forceinline__ float blo(unsigned w) { return __uint_as_float(w << 16); }
__device__ __forceinline__ float bhi(unsigned w) { return __uint_as_float(w & 0xffff0000u); }
__device__ __forceinline__ float bf1(bf16_t b) { return __uint_as_float((unsigned)b << 16); }
__device__ __forceinline__ bf16_t f2bf(float f) { return (bf16_t)(pk2(f, 0.f) & 0xffffu); }
__device__ __forceinline__ float sigm(float x) { return __builtin_amdgcn_rcpf(1.0f + __builtin_amdgcn_exp2f(-LOG2E * x)); }
__device__ __forceinline__ float wave_sum(float v) {
#pragma unroll
    for (int o = 1; o < 64; o <<= 1) v += __shfl_xor(v, o);
    return v;
}
__device__ __forceinline__ int crow(int r, int hi) { return (r & 3) + 8 * (r >> 2) + 4 * hi; }
#define MFMA32(a, b, c) __builtin_amdgcn_mfma_f32_32x32x16_bf16((a), (b), (c), 0, 0, 0)

__device__ __forceinline__ void tr_item(const float* src, int ldn, int c0, int k0, bf16_t* dst, int ldk, int drow0, LAS float* scr, int lane) {
#pragma unroll 8
    for (int i = 0; i < 32; ++i) { const int kk = 2 * i + (lane >> 5); scr[kk * 33 + (lane & 31)] = src[(size_t)(k0 + kk) * ldn + c0 + (lane & 31)]; }
    LDS_WAIT(); asm volatile("" ::: "memory");
    const int c = lane & 7;
#pragma unroll
    for (int j = 0; j < 4; ++j) { const int n = (lane >> 3) + 8 * j; const LAS float* s = scr + (8 * c) * 33 + n;
        v4u o; o.x = pk2(s[0 * 33], s[1 * 33]); o.y = pk2(s[2 * 33], s[3 * 33]); o.z = pk2(s[4 * 33], s[5 * 33]); o.w = pk2(s[6 * 33], s[7 * 33]);
        *(v4u*)(dst + (size_t)(drow0 + n) * ldk + k0 + 8 * c) = o; }
    LDS_WAIT(); asm volatile("" ::: "memory");
}
__device__ __forceinline__ void tr_segment(const float* src, int ldn, int K, int c_begin, int ncols, bf16_t* dst, int drow_begin, int blk, LAS float* scr, int gw, int NGW, int lane, int& off) {
    const int nblk = ncols / 32, nitems = (K / 64) * nblk;
    int start = (gw - (off % NGW) + NGW) % NGW;
    for (int it = start; it < nitems; it += NGW) {
        const int kb = it / nblk, nb = it % nblk, n0 = nb * 32;
        const int drow0 = drow_begin + (blk ? (n0 / blk) * (2 * blk) + (n0 % blk) : n0);
        tr_item(src, ldn, c_begin + n0, kb * 64, dst, K, drow0, scr, lane);
    }
    off += nitems;
}

template <int MODE>
__device__ __forceinline__ void norm_rows(const float* xin, float* xout, bool write_x, const bf16_t* ycomb  , const float* gain, bf16_t* H,
                                          const float* w8, int ldw8, const float* b8, float* LF, int* ASG, gu32* cnt, int gw, int NGW, int lane) {
    f32x4 gv[4];
#pragma unroll
    for (int jj = 0; jj < 4; ++jj) gv[jj] = ((const f32x4*)gain)[64 * jj + lane];
    float wf[4][4][8];
    if (MODE != 1) {
#pragma unroll
        for (int jj = 0; jj < 4; ++jj)
#pragma unroll
            for (int i = 0; i < 4; ++i) { const float* wr = w8 + (size_t)(4 * lane + 256 * jj + i) * ldw8; const f32x4 a = *(const f32x4*)wr, b = *(const f32x4*)(wr + 4);
                wf[jj][i][0] = a[0]; wf[jj][i][1] = a[1]; wf[jj][i][2] = a[2]; wf[jj][i][3] = a[3]; wf[jj][i][4] = b[0]; wf[jj][i][5] = b[1]; wf[jj][i][6] = b[2]; wf[jj][i][7] = b[3]; }
    }
    int my_e = -1, my_row = 0, my_k = 0, nheld = 0; float my_g = 0.f;
    for (int row = gw; row < NTOK; row += NGW) {
        f32x4 v[4];
#pragma unroll
        for (int jj = 0; jj < 4; ++jj) v[jj] = ((const f32x4*)(xin + (size_t)row * DM))[64 * jj + lane];
        if (ycomb) {
#pragma unroll
            for (int jj = 0; jj < 4; ++jj) { const v2u a = ((const v2u*)(ycomb + (size_t)row * DM))[64 * jj + lane], b = ((const v2u*)(ycomb + ((size_t)NTOK + row) * DM))[64 * jj + lane];
                v[jj][0] += blo(a.x) + blo(b.x); v[jj][1] += bhi(a.x) + bhi(b.x); v[jj][2] += blo(a.y) + blo(b.y); v[jj][3] += bhi(a.y) + bhi(b.y); }
        }
        if (write_x) {
#pragma unroll
            for (int jj = 0; jj < 4; ++jj) ((f32x4*)(xout + (size_t)row * DM))[64 * jj + lane] = v[jj];
        }
        float ss = 0.f;
#pragma unroll
        for (int jj = 0; jj < 4; ++jj) ss += (v[jj][0] * v[jj][0] + v[jj][1] * v[jj][1]) + (v[jj][2] * v[jj][2] + v[jj][3] * v[jj][3]);
        const float r = __builtin_amdgcn_rsqf(wave_sum(ss) * (1.0f / DM) + EPS);
#pragma unroll
        for (int jj = 0; jj < 4; ++jj) { v[jj] = v[jj] * r * gv[jj]; v2u o; o.x = pk2(v[jj][0], v[jj][1]); o.y = pk2(v[jj][2], v[jj][3]); ((v2u*)(H + (size_t)row * DM))[64 * jj + lane] = o; }
        if (MODE != 1) {
            float fd[8];
#pragma unroll
            for (int j = 0; j < 8; ++j) { float s = 0.f;
#pragma unroll
                for (int jj = 0; jj < 4; ++jj)
#pragma unroll
                    for (int i = 0; i < 4; ++i) s += v[jj][i] * wf[jj][i][j];
                fd[j] = wave_sum(s); }
            if (MODE == 0) {
                float z = fd[0];
#pragma unroll
                for (int j = 1; j < 8; ++j) z = (lane == j) ? fd[j] : z;
                if (lane < 8) { z += b8[lane]; const float az = __builtin_fabsf(z);
                    const float ls = __builtin_fminf(z, 0.f) - __builtin_amdgcn_logf(1.0f + __builtin_amdgcn_exp2f(-LOG2E * az)) * 0.6931471805599453f;
                    LF[(size_t)row * 8 + lane] = ls; }
            } else {
                int i0 = 0; float v0 = fd[0];
#pragma unroll
                for (int j = 1; j < 8; ++j) if (fd[j] > v0) { v0 = fd[j]; i0 = j; }
                int i1 = -1; float v1 = -3.0e38f;
#pragma unroll
                for (int j = 0; j < 8; ++j) if (j != i0 && fd[j] > v1) { v1 = fd[j]; i1 = j; }
                const float g0 = __builtin_amdgcn_rcpf(1.0f + __builtin_amdgcn_exp2f(LOG2E * (v1 - v0))), g1 = 1.0f - g0;
                if (lane == 2 * nheld) { my_e = i0; my_g = g0; my_row = row; my_k = 0; }
                if (lane == 2 * nheld + 1) { my_e = i1; my_g = g1; my_row = row; my_k = 1; }
                ++nheld;
            }
        }
        if (MODE == 2 && (nheld == 32 || row + NGW >= NTOK)) {
            int pos = 0;
#pragma unroll
            for (int e = 0; e < 8; ++e) { const unsigned long long mk = __ballot(my_e == e);
                if (mk) { const int leader = __builtin_ctzll(mk); unsigned base = 0;
                    if (lane == leader) base = __hip_atomic_fetch_add(cnt + 64 * e, (unsigned)__builtin_popcountll(mk), RLX_AGENT);
                    base = __shfl(base, leader);
                    if (my_e == e) pos = (int)base + __builtin_popcountll(mk & ((1ull << lane) - 1ull)); } }
            if (my_e >= 0) { ASG[(size_t)(my_row * 2 + my_k) * 2] = (my_e << 24) | pos; ASG[(size_t)(my_row * 2 + my_k) * 2 + 1] = (int)__float_as_uint(my_g); }
            my_e = -1; nheld = 0;
        }
    }
}

constexpr int AT_KT = 0, AT_VT = 18432, AT_CK = 36864, AT_WT = 45056, AT_TS = 144;
__device__ __forceinline__ void attn_unit(LAS unsigned char* lds, int b, int h, int qb, const bf16_t* Qr, const bf16_t* Kr, const bf16_t* VT, const float* LF,
                                          const float* gq, const float* gk, bf16_t* O, int tid) {
    const int lane = tid & 63, wave = __builtin_amdgcn_readfirstlane(tid >> 6), r32 = lane & 31, hi = lane >> 5;
    const size_t rowbase = (size_t)b * SEQ;
    LAS float* CK = (LAS float*)(lds + AT_CK); LAS float* WT = (LAS float*)(lds + AT_WT);
    {
        float v0 = LF[(rowbase + 4 * tid + 0) * 8 + h], v1 = LF[(rowbase + 4 * tid + 1) * 8 + h], v2 = LF[(rowbase + 4 * tid + 2) * 8 + h], v3 = LF[(rowbase + 4 * tid + 3) * 8 + h];
        v1 += v0; v2 += v1; v3 += v2;
        float incl = v3;
#pragma unroll
        for (int o = 1; o < 64; o <<= 1) { const float n = __shfl_up(incl, o); if (lane >= o) incl += n; }
        if (lane == 63) WT[wave] = incl;
        __syncthreads();
        float base = 0.f;
        for (int w = 0; w < wave; ++w) base += WT[w];
        const float ex = base + incl - v3;
        *(LAS f32x4*)(CK + 4 * tid) = (f32x4){(ex + v0) * LOG2E, (ex + v1) * LOG2E, (ex + v2) * LOG2E, (ex + v3) * LOG2E};
        __syncthreads();
    }
    const int q_abs = qb * 256 + wave * 32 + r32;
    bf16x8 qf[4];
    {
        const bf16_t* qp = Qr + (rowbase + q_abs) * 512 + h * 64 + 8 * hi;
        v4u raw[4]; float ss = 0.f;
#pragma unroll
        for (int s = 0; s < 4; ++s) { raw[s] = *(const v4u*)(qp + 16 * s);
#pragma unroll
            for (int e = 0; e < 4; ++e) { const float a = blo(raw[s][e]), c = bhi(raw[s][e]); ss += a * a + c * c; } }
        ss += __shfl_xor(ss, 32);
        const float r = __builtin_amdgcn_rsqf(ss * (1.0f / 64.0f) + EPS) * (0.125f * LOG2E);
#pragma unroll
        for (int s = 0; s < 4; ++s) { const f32x4 g0 = *(const f32x4*)(gq + 16 * s + 8 * hi), g1 = *(const f32x4*)(gq + 16 * s + 8 * hi + 4); v4u o;
            o.x = pk2(blo(raw[s].x) * r * g0[0], bhi(raw[s].x) * r * g0[1]); o.y = pk2(blo(raw[s].y) * r * g0[2], bhi(raw[s].y) * r * g0[3]);
            o.z = pk2(blo(raw[s].z) * r * g1[0], bhi(raw[s].z) * r * g1[1]); o.w = pk2(blo(raw[s].w) * r * g1[2], bhi(raw[s].w) * r * g1[3]);
            qf[s] = __builtin_bit_cast(bf16x8, o); }
    }
    const float cq = CK[q_abs];
    const int NT = 4 * qb + 4;
    const int lkv = tid >> 3, lch = tid & 7;
    const bf16_t* kp = Kr + (rowbase + lkv) * 512 + h * 64 + 8 * lch;
    const bf16_t* vp = VT + (size_t)(h * 64 + lkv) * NTOK + rowbase + 8 * lch;
    const f32x4 gk0 = *(const f32x4*)(gk + 8 * lch), gk1 = *(const f32x4*)(gk + 8 * lch + 4);
    v4u kreg = *(const v4u*)kp, vreg = *(const v4u*)vp;
    f32x16 o0, o1;
#pragma unroll
    for (int i = 0; i < 16; ++i) { o0[i] = 0.f; o1[i] = 0.f; }
    float mrun = -1.0e30f, lrun = 0.f;
    const int qw_max = qb * 256 + wave * 32 + 31, qw_min = qb * 256 + wave * 32;
    for (int j = 0; j < NT; ++j) {
        const int buf = j & 1;
        {
            float f[8]; f[0] = blo(kreg.x); f[1] = bhi(kreg.x); f[2] = blo(kreg.y); f[3] = bhi(kreg.y); f[4] = blo(kreg.z); f[5] = bhi(kreg.z); f[6] = blo(kreg.w); f[7] = bhi(kreg.w);
            float ss = 0.f;
#pragma unroll
            for (int e = 0; e < 8; ++e) ss += f[e] * f[e];
            ss += __shfl_xor(ss, 1); ss += __shfl_xor(ss, 2); ss += __shfl_xor(ss, 4);
            const float r = __builtin_amdgcn_rsqf(ss * (1.0f / 64.0f) + EPS);
            v4u ko; ko.x = pk2(f[0] * r * gk0[0], f[1] * r * gk0[1]); ko.y = pk2(f[2] * r * gk0[2], f[3] * r * gk0[3]); ko.z = pk2(f[4] * r * gk1[0], f[5] * r * gk1[1]); ko.w = pk2(f[6] * r * gk1[2], f[7] * r * gk1[3]);
            *(LAS v4u*)(lds + AT_KT + buf * 9216 + lkv * AT_TS + lch * 16) = ko;
            *(LAS v4u*)(lds + AT_VT + buf * 9216 + lkv * AT_TS + lch * 16) = vreg;
        }
        __syncthreads();
        if (j + 1 < NT) { kreg = *(const v4u*)(kp + (size_t)(j + 1) * 64 * 512); vreg = *(const v4u*)(vp + (j + 1) * 64); }
        if (64 * j <= qw_max) {
            const LAS unsigned char* KT = lds + AT_KT + buf * 9216; const LAS unsigned char* VTL = lds + AT_VT + buf * 9216;
            f32x16 p0, p1;
#pragma unroll
            for (int i = 0; i < 16; ++i) { p0[i] = 0.f; p1[i] = 0.f; }
#pragma unroll
            for (int s = 0; s < 4; ++s) {
                const bf16x8 a0 = *(const LAS bf16x8*)(KT + r32 * AT_TS + (16 * s + 8 * hi) * 2);
                const bf16x8 a1 = *(const LAS bf16x8*)(KT + (32 + r32) * AT_TS + (16 * s + 8 * hi) * 2);
                p0 = MFMA32(a0, qf[s], p0); p1 = MFMA32(a1, qf[s], p1);
            }
            const int kvb = 64 * j;
#pragma unroll
            for (int g4 = 0; g4 < 4; ++g4) { const f32x4 c0 = *(const LAS f32x4*)(CK + kvb + 4 * hi + 8 * g4), c1 = *(const LAS f32x4*)(CK + kvb + 32 + 4 * hi + 8 * g4);
#pragma unroll
                for (int e = 0; e < 4; ++e) { p0[4 * g4 + e] += cq - c0[e]; p1[4 * g4 + e] += cq - c1[e]; } }
            if (kvb + 63 > qw_min) {
#pragma unroll
                for (int i = 0; i < 16; ++i) { const int kv = kvb + crow(i, hi); if (kv > q_abs) p0[i] = -1.0e30f; if (kv + 32 > q_abs) p1[i] = -1.0e30f; }
            }
            float mx = p0[0];
#pragma unroll
            for (int i = 1; i < 16; ++i) mx = __builtin_fmaxf(mx, p0[i]);
#pragma unroll
            for (int i = 0; i < 16; ++i) mx = __builtin_fmaxf(mx, p1[i]);
            mx = __builtin_fmaxf(mx, __shfl_xor(mx, 32));
            const float mnew = __builtin_fmaxf(mrun, mx), alpha = __builtin_amdgcn_exp2f(mrun - mnew); mrun = mnew;
            float ls = 0.f;
#pragma unroll
            for (int i = 0; i < 16; ++i) { p0[i] = __builtin_amdgcn_exp2f(p0[i] - mnew); p1[i] = __builtin_amdgcn_exp2f(p1[i] - mnew); ls += p0[i] + p1[i]; }
            lrun = lrun * alpha + ls;
#pragma unroll
            for (int i = 0; i < 16; ++i) { o0[i] *= alpha; o1[i] *= alpha; }
            bf16x8 pf[4];
            { v4u w;
              w.x = pk2(p0[0], p0[1]); w.y = pk2(p0[2], p0[3]); w.z = pk2(p0[4], p0[5]); w.w = pk2(p0[6], p0[7]); pf[0] = __builtin_bit_cast(bf16x8, w);
              w.x = pk2(p0[8], p0[9]); w.y = pk2(p0[10], p0[11]); w.z = pk2(p0[12], p0[13]); w.w = pk2(p0[14], p0[15]); pf[1] = __builtin_bit_cast(bf16x8, w);
              w.x = pk2(p1[0], p1[1]); w.y = pk2(p1[2], p1[3]); w.z = pk2(p1[4], p1[5]); w.w = pk2(p1[6], p1[7]); pf[2] = __builtin_bit_cast(bf16x8, w);
              w.x = pk2(p1[8], p1[9]); w.y = pk2(p1[10], p1[11]); w.z = pk2(p1[12], p1[13]); w.w = pk2(p1[14], p1[15]); pf[3] = __builtin_bit_cast(bf16x8, w); }
#pragma unroll
            for (int ks = 0; ks < 4; ++ks) {
                const v2u a0l = *(const LAS v2u*)(VTL + r32 * AT_TS + (16 * ks + 4 * hi) * 2), a0h = *(const LAS v2u*)(VTL + r32 * AT_TS + (16 * ks + 8 + 4 * hi) * 2);
                const v2u a1l = *(const LAS v2u*)(VTL + (32 + r32) * AT_TS + (16 * ks + 4 * hi) * 2), a1h = *(const LAS v2u*)(VTL + (32 + r32) * AT_TS + (16 * ks + 8 + 4 * hi) * 2);
                const v4u A0 = (v4u){a0l.x, a0l.y, a0h.x, a0h.y}, A1 = (v4u){a1l.x, a1l.y, a1h.x, a1h.y};
                o0 = MFMA32(__builtin_bit_cast(bf16x8, A0), pf[ks], o0); o1 = MFMA32(__builtin_bit_cast(bf16x8, A1), pf[ks], o1);
            }
        }
    }
    lrun += __shfl_xor(lrun, 32);
    const float inv = __builtin_amdgcn_rcpf(lrun);
    bf16_t* op = O + (rowbase + q_abs) * 512 + h * 64 + 4 * hi;
#pragma unroll
    for (int g4 = 0; g4 < 4; ++g4) {
        v2u w0, w1; w0.x = pk2(o0[4 * g4] * inv, o0[4 * g4 + 1] * inv); w0.y = pk2(o0[4 * g4 + 2] * inv, o0[4 * g4 + 3] * inv);
        w1.x = pk2(o1[4 * g4] * inv, o1[4 * g4 + 1] * inv); w1.y = pk2(o1[4 * g4 + 2] * inv, o1[4 * g4 + 3] * inv);
        *(v2u*)(op + 8 * g4) = w0; *(v2u*)(op + 32 + 8 * g4) = w1;
    }
    __syncthreads();
}

constexpr int SG_VT = 0, SG_VS = 272, SG_WB = 64 * 272, SG_PS = 8 * SG_WB;
__device__ __forceinline__ void sgu_unit(LAS unsigned char* lds, int chunk, const bf16_t* SUV, const float* gsgu, const bf16_t* Wsp, const float* bsp, bf16_t* O, int tid) {
    const int lane = tid & 63, g = __builtin_amdgcn_readfirstlane(tid >> 6), r32 = lane & 31, hi = lane >> 5;
    const size_t row0 = (size_t)chunk * 128;
    LAS float* PS = (LAS float*)(lds + SG_PS);
    LAS unsigned char* VTw = lds + SG_VT + g * SG_WB;
    const int c8 = lane & 7, rl = lane >> 3;
    v4u raw[16];
#pragma unroll
    for (int i = 0; i < 16; ++i) raw[i] = *(const v4u*)(SUV + (row0 + rl + 8 * i) * 1024 + 512 + g * 64 + 8 * c8);
#pragma unroll
    for (int i = 0; i < 16; ++i) { float ss = 0.f;
#pragma unroll
        for (int e = 0; e < 4; ++e) { const float a = blo(raw[i][e]), c = bhi(raw[i][e]); ss += a * a + c * c; }
        ss += __shfl_xor(ss, 1); ss += __shfl_xor(ss, 2); ss += __shfl_xor(ss, 4);
        if (c8 == 0) PS[(rl + 8 * i) * 8 + g] = ss; }
    __syncthreads();
    const f32x4 gs0 = *(const f32x4*)(gsgu + g * 64 + 8 * c8), gs1 = *(const f32x4*)(gsgu + g * 64 + 8 * c8 + 4);
#pragma unroll
    for (int i = 0; i < 16; ++i) { const int t = rl + 8 * i;
        const f32x4 pa = *(const LAS f32x4*)(PS + t * 8), pb = *(const LAS f32x4*)(PS + t * 8 + 4);
        const float r = __builtin_amdgcn_rsqf(((pa[0] + pa[1]) + (pa[2] + pa[3]) + (pb[0] + pb[1]) + (pb[2] + pb[3])) * (1.0f / 512.0f) + EPS);
        float f[8]; f[0] = blo(raw[i].x) * r * gs0[0]; f[1] = bhi(raw[i].x) * r * gs0[1]; f[2] = blo(raw[i].y) * r * gs0[2]; f[3] = bhi(raw[i].y) * r * gs0[3];
        f[4] = blo(raw[i].z) * r * gs1[0]; f[5] = bhi(raw[i].z) * r * gs1[1]; f[6] = blo(raw[i].w) * r * gs1[2]; f[7] = bhi(raw[i].w) * r * gs1[3];
#pragma unroll
        for (int e = 0; e < 8; ++e) *(LAS bf16_t*)(VTw + (8 * c8 + e) * SG_VS + t * 2) = f2bf(f[e]); }
    __syncthreads();
    const bf16_t* Wg = Wsp + (size_t)g * 128 * 128;
#pragma unroll 1
    for (int tb = 0; tb < 4; ++tb) {
        f32x16 a0, a1;
#pragma unroll
        for (int i = 0; i < 16; ++i) { a0[i] = 0.f; a1[i] = 0.f; }
        const int nks = 2 * (tb + 1);
        for (int ks = 0; ks < nks; ++ks) {
            const bf16x8 A = *(const bf16x8*)(Wg + (32 * tb + r32) * 128 + 16 * ks + 8 * hi);
            const bf16x8 B0 = *(const LAS bf16x8*)(VTw + r32 * SG_VS + (16 * ks + 8 * hi) * 2), B1 = *(const LAS bf16x8*)(VTw + (32 + r32) * SG_VS + (16 * ks + 8 * hi) * 2);
            a0 = MFMA32(A, B0, a0); a1 = MFMA32(A, B1, a1);
        }
#pragma unroll
        for (int i = 0; i < 16; ++i) { const int t = 32 * tb + crow(i, hi); const size_t row = row0 + t; const float bs = bsp[g * 128 + t];
            const float u0 = bf1(SUV[row * 1024 + g * 64 + r32]), u1 = bf1(SUV[row * 1024 + g * 64 + 32 + r32]);
            O[row * 512 + g * 64 + r32] = f2bf(u0 * (a0[i] + bs)); O[row * 512 + g * 64 + 32 + r32] = f2bf(u1 * (a1[i] + bs)); }
    }
    __syncthreads();
}

constexpr int CP_RS = 1040, CP_PS = 98304;
__device__ __forceinline__ void conv_unit(LAS unsigned char* lds, int tile, const bf16_t* CY, const float* wdw, const float* bdw, const float* gcv, bf16_t* Oc, int tid) {
    const int lane = tid & 63, wave = __builtin_amdgcn_readfirstlane(tid >> 6);
    const size_t row0 = (size_t)tile * 64; const int t0 = (tile * 64) % SEQ;
    LAS float* PS = (LAS float*)(lds + CP_PS);
    for (int idx = tid; idx < 94 * 64; idx += 512) { const int r = idx >> 6, ch = idx & 63; const int tt = t0 - 30 + r;
        v4u v = (v4u){0u, 0u, 0u, 0u}; if (tt >= 0) v = *(const v4u*)(CY + (row0 - 30 + r) * 512 + 8 * ch);
        *(LAS v4u*)(lds + r * CP_RS + ch * 16) = v; }
    float w[31];
#pragma unroll
    for (int j = 0; j < 31; ++j) w[j] = wdw[j * 512 + tid];
    const float bias = bdw[tid], gc = gcv[tid];
    __syncthreads();
#pragma unroll 1
    for (int tg = 0; tg < 8; ++tg) {
        float z8[8];
#pragma unroll
        for (int t = 0; t < 8; ++t) z8[t] = bias;
        const LAS unsigned char* col = lds + (8 * tg) * CP_RS + tid * 2;
        float yv[38];
#pragma unroll
        for (int i = 0; i < 38; ++i) yv[i] = bf1(*(const LAS bf16_t*)(col + i * CP_RS));
#pragma unroll
        for (int t = 0; t < 8; ++t)
#pragma unroll
            for (int j = 0; j < 31; ++j) z8[t] = __builtin_fmaf(w[j], yv[t + j], z8[t]);
        float q8[8];
#pragma unroll
        for (int t = 0; t < 8; ++t) { *(LAS bf16_t*)(lds + (8 * tg + t) * CP_RS + tid * 2) = f2bf(z8[t]); q8[t] = z8[t] * z8[t]; }
#define RS_STEP(HH) { const bool up = (lane & HH) != 0; _Pragma("unroll") for (int i = 0; i < HH; ++i) { const float keep = up ? q8[i + HH] : q8[i]; const float send = up ? q8[i] : q8[i + HH]; q8[i] = keep + __shfl_xor(send, HH); } }
        RS_STEP(4) RS_STEP(2) RS_STEP(1)
#undef RS_STEP
        float s = q8[0]; s += __shfl_xor(s, 8); s += __shfl_xor(s, 16); s += __shfl_xor(s, 32);
        if (lane < 8) PS[wave * 64 + 8 * tg + lane] = s;
    }
    __syncthreads();
    if (tid < 64) { float s = 0.f;
#pragma unroll
        for (int wv = 0; wv < 8; ++wv) s += PS[wv * 64 + tid];
        PS[512 + tid] = __builtin_amdgcn_rsqf(s * (1.0f / 512.0f) + EPS); }
    __syncthreads();
#pragma unroll 4
    for (int t = 0; t < 64; ++t) { const float v = bf1(*(const LAS bf16_t*)(lds + t * CP_RS + tid * 2)) * PS[512 + t] * gc; Oc[(row0 + t) * 512 + tid] = f2bf(v * sigm(v)); }
    __syncthreads();
}
__device__ __forceinline__ void pool_unit(LAS unsigned char* lds, int tile, const bf16_t* PIN, const bf16_t* Wpg, const float* pls, bf16_t* Op, int tid) {
    const int lane = tid & 63, wave = __builtin_amdgcn_readfirstlane(tid >> 6), r32 = lane & 31, hi = lane >> 5;
    const size_t row0 = (size_t)tile * 64; const int t0 = (tile * 64) % SEQ;
    for (int idx = tid; idx < 79 * 64; idx += 512) { const int r = idx >> 6, ch = idx & 63; const int tt = t0 - 15 + r;
        v4u v = (v4u){0u, 0u, 0u, 0u}; if (tt >= 0) v = *(const v4u*)(PIN + (row0 - 15 + r) * 512 + 8 * ch);
        *(LAS v4u*)(lds + r * CP_RS + ch * 16) = v; }
    __syncthreads();
    {
        const int wnd = 2 << (tid >> 7);
        for (int t = 0; t < 64; ++t) { float s = 0.f;
            for (int j = 0; j < wnd; ++j) s += bf1(*(const LAS bf16_t*)(lds + (t + 15 - j) * CP_RS + tid * 2));
            const int cnt = (t0 + t + 1) < wnd ? (t0 + t + 1) : wnd;
            const float self = bf1(*(const LAS bf16_t*)(lds + (t + 15) * CP_RS + tid * 2));
            const float pv = s / (float)cnt - self;
            *(LAS bf16_t*)(lds + t * CP_RS + tid * 2) = f2bf(pv); }
    }
    __syncthreads();
    {
        const int g = wave >> 1, nh = wave & 1;
        f32x16 acc[2][2];
#pragma unroll
        for (int a = 0; a < 2; ++a)
#pragma unroll
            for (int c = 0; c < 2; ++c)
#pragma unroll
                for (int i = 0; i < 16; ++i) acc[a][c][i] = 0.f;
#pragma unroll
        for (int ks = 0; ks < 8; ++ks) {
            const bf16x8 A0 = *(const LAS bf16x8*)(lds + r32 * CP_RS + (g * 128 + 16 * ks + 8 * hi) * 2), A1 = *(const LAS bf16x8*)(lds + (32 + r32) * CP_RS + (g * 128 + 16 * ks + 8 * hi) * 2);
            const bf16x8 B0 = *(const bf16x8*)(Wpg + ((size_t)g * 128 + 64 * nh + r32) * 128 + 16 * ks + 8 * hi), B1 = *(const bf16x8*)(Wpg + ((size_t)g * 128 + 64 * nh + 32 + r32) * 128 + 16 * ks + 8 * hi);
            acc[0][0] = MFMA32(A0, B0, acc[0][0]); acc[0][1] = MFMA32(A0, B1, acc[0][1]); acc[1][0] = MFMA32(A1, B0, acc[1][0]); acc[1][1] = MFMA32(A1, B1, acc[1][1]);
        }
#pragma unroll
        for (int ct = 0; ct < 2; ++ct) { const int col = g * 128 + 64 * nh + 32 * ct + r32; const float sc = pls[col];
#pragma unroll
            for (int rt = 0; rt < 2; ++rt)
#pragma unroll
                for (int i = 0; i < 16; ++i) Op[(row0 + 32 * rt + crow(i, hi)) * 512 + col] = f2bf(acc[rt][ct][i] * sc); }
    }
    __syncthreads();
}

__device__ __forceinline__ void moe_offsets(const gu32* cnt, int (&pstart)[8], int (&tend)[8], int& T) {
    int acc = 0;
#pragma unroll
    for (int e = 0; e < 8; ++e) { const int c = (int)__hip_atomic_load(cnt + 64 * e, RLX_AGENT); pstart[e] = acc; acc += (c + 255) & ~255; tend[e] = acc >> 8; }
    T = acc >> 8;
}
__device__ __forceinline__ void moe_scatter(const gu32* cnt, const int* ASG, const bf16_t* H, bf16_t* XS, int* RINFO, int gw, int NGW, int lane, int tid, int blk, int nblk) {
    int pstart[8], tend[8], T; moe_offsets(cnt, pstart, tend, T);
    for (int e = blk; e < 8; e += nblk) { const int c = (int)__hip_atomic_load(cnt + 64 * e, RLX_AGENT); const int pe = (c + 255) & ~255;
        for (int r = c + tid; r < pe; r += 512) { RINFO[2 * (size_t)(pstart[e] + r)] = -1; RINFO[2 * (size_t)(pstart[e] + r) + 1] = 0; } }
    for (int a = gw; a < NTOK * 2; a += NGW) {
        const int w0 = ASG[2 * (size_t)a], gb = ASG[2 * (size_t)a + 1]; const int e = w0 >> 24, pos = w0 & 0xffffff;
        int ps = 0;
#pragma unroll
        for (int k = 0; k < 8; ++k) ps = (e == k) ? pstart[k] : ps;
        const size_t dest = (size_t)(ps + pos);
        if (lane == 0) { RINFO[2 * dest] = a; RINFO[2 * dest + 1] = gb; }
        const v4u* src = (const v4u*)(H + (size_t)(a >> 1) * DM); v4u* dst = (v4u*)(XS + dest * DM);
        dst[lane] = src[lane]; dst[64 + lane] = src[64 + lane];
    }
}
__device__ __forceinline__ void final_combine(float* xio, const bf16_t* Y, int gw, int NGW, int lane) {
    for (int row = gw; row < NTOK; row += NGW) {
#pragma unroll
        for (int jj = 0; jj < 4; ++jj) { f32x4 v = ((const f32x4*)(xio + (size_t)row * DM))[64 * jj + lane];
            const v2u a = ((const v2u*)(Y + (size_t)row * DM))[64 * jj + lane], b = ((const v2u*)(Y + ((size_t)NTOK + row) * DM))[64 * jj + lane];
            v[0] += blo(a.x) + blo(b.x); v[1] += bhi(a.x) + bhi(b.x); v[2] += blo(a.y) + blo(b.y); v[3] += bhi(a.y) + bhi(b.y);
            ((f32x4*)(xio + (size_t)row * DM))[64 * jj + lane] = v; }
    }
}
#define XB_TMO      128
#define XB_XCNT(j)  (256  + 64 * (j))
#define XB_XSUB(j)  (1280 + 64 * (j))
#define XB_XGEN(j)  (2304 + 64 * (j))
#define XB_TOP      3328
#define XB_TOPGEN   3392
#define XCD_BAR_WORDS 3456
#define XB_SPIN_CAP (1u << 18)

__device__ __forceinline__ unsigned xb_ld(unsigned* p)              { return __hip_atomic_load(p, __ATOMIC_RELAXED, __HIP_MEMORY_SCOPE_AGENT); }
__device__ __forceinline__ unsigned xb_add(unsigned* p, unsigned v) { return __hip_atomic_fetch_add(p, v, __ATOMIC_RELAXED, __HIP_MEMORY_SCOPE_AGENT); }
__device__ __forceinline__ unsigned xb_xcc_id() { return (unsigned)__builtin_amdgcn_s_getreg((3 << 11) | 20) & 0xFu; }
#define XB_SPIN(cond, bar) do { unsigned _sp = 0; while (cond) { __builtin_amdgcn_s_sleep(1); \
    if ((++_sp & 255u) == 0u) { if (xb_ld(&(bar)[XB_TMO])) break; if (_sp > XB_SPIN_CAP) { atomicAdd(&(bar)[XB_TMO], 1u); break; } } } } while (0)

struct XcdBarrier {
    unsigned* bar; unsigned x;
    volatile LAS unsigned* st;
};

__device__ __forceinline__ XcdBarrier xcd_barrier_post(unsigned* bar, volatile LAS unsigned* st) {
    XcdBarrier b; b.bar = bar; b.x = xb_xcc_id(); b.st = st;
    if (threadIdx.x == 0) (void)xb_add(&bar[XB_XCNT(b.x)], 1u);
    return b;
}
__device__ __forceinline__ void xcd_barrier_complete(unsigned* bar, unsigned x, unsigned& nloc, unsigned& nx) {
    const unsigned G = gridDim.x * gridDim.y * gridDim.z;
    unsigned sum, cnt, mine, sp = 0u;
    for (;;) {
        sum = 0u; cnt = 0u; mine = 0u;
#pragma unroll
        for (unsigned j = 0; j < 16; ++j) { const unsigned c = xb_ld(&bar[XB_XCNT(j)]); sum += c; cnt += (c > 0u) ? 1u : 0u; mine = (j == x) ? c : mine; }
        if (sum == G) break;
        __builtin_amdgcn_s_sleep(1);
        if ((++sp & 255u) == 0u) { if (xb_ld(&bar[XB_TMO])) break; if (sp > XB_SPIN_CAP) { atomicAdd(&bar[XB_TMO], 1u); break; } }
    }
    nloc = mine > 0u ? mine : 1u; nx = cnt > 0u ? cnt : 1u;
}

__device__ __forceinline__ void xcd_barrier(const XcdBarrier& b) {
    asm volatile("s_waitcnt vmcnt(0)" ::: "memory");
    __syncthreads();
    if (threadIdx.x == 0) {
        unsigned* bar = b.bar;
        __builtin_amdgcn_s_waitcnt(0);
        unsigned nloc = b.st[0], nx = b.st[1];
        if (nloc == 0u) { xcd_barrier_complete(bar, b.x, nloc, nx); b.st[0] = nloc; b.st[1] = nx; }
        const unsigned old = xb_add(&bar[XB_XSUB(b.x)], 1u);
        const unsigned gen = old / nloc;
        if (old + 1u == (gen + 1u) * nloc) {
            __builtin_amdgcn_fence(__ATOMIC_RELEASE, "agent");
            asm volatile("s_waitcnt vmcnt(0)" ::: "memory");
            const unsigned og = xb_add(&bar[XB_TOP], 1u);
            const unsigned tg = og / nx;
            if (og + 1u == (tg + 1u) * nx) xb_add(&bar[XB_TOPGEN], 1u);
            else XB_SPIN(xb_ld(&bar[XB_TOPGEN]) == tg, bar);
            __builtin_amdgcn_fence(__ATOMIC_ACQUIRE, "agent");
            xb_add(&bar[XB_XGEN(b.x)], 1u);
            asm volatile("s_waitcnt vmcnt(0)" ::: "memory");
        } else {
            XB_SPIN(xb_ld(&bar[XB_XGEN(b.x)]) == gen, bar);
            __builtin_amdgcn_fence(__ATOMIC_ACQUIRE, "agent");
            asm volatile("s_waitcnt vmcnt(0)" ::: "memory");
        }
    }
    __syncthreads();
}


struct Args {
    const float* in[25]; float* out; unsigned char* ws; int pad0, pad1;
};
typedef const Args __attribute__((address_space(4)))* KArgs;
enum { I_X = 0, I_GMIX, I_WIN, I_BF, I_GQ, I_GK, I_GSGU, I_WSP, I_BSP, I_WDW, I_BDW, I_GCONV, I_WPOOL, I_PSCALE, I_WBR, I_BGATE, I_WOUT, I_GFFN,
       I_WFG, I_WFU, I_WFD, I_WROUTER, I_WEG, I_WEU, I_WED };
__device__ __forceinline__ int opaque_v(int v) { asm volatile("" : "+v"(v)); return v; }
__device__ __forceinline__ KArgs kargs() { KArgs p = (KArgs)__builtin_amdgcn_kernarg_segment_ptr(); asm volatile("" : "+s"(p)); return p; }

#ifndef MK_ONLY
#define MK_ONLY -1
#endif
#define PH(n) (MK_ONLY < 0 || MK_ONLY == (n))

__global__ void __launch_bounds__(NWAVES * 64, 2) fwd_kernel(Args args_unused) {
    extern __shared__ __attribute__((aligned(16))) unsigned char lds_raw[];
    LAS unsigned char* lds = (LAS unsigned char*)lds_raw;
    const int tid = threadIdx.x, lane = tid & 63, wave = __builtin_amdgcn_readfirstlane(tid >> 6);
    const int G = gridDim.x, bx = blockIdx.x;
    const int gw = bx * NWAVES + wave, NGW = G * NWAVES;
    volatile LAS unsigned* MISC = (volatile LAS unsigned*)(lds + MISC_OFF);
    for (int u = tid; u < 64; u += NWAVES * 64) ((LAS unsigned*)(lds + MISC_OFF))[u] = 0u;
    __syncthreads();
    XcdBarrier bar;
    { KArgs ka = kargs(); bar = xcd_barrier_post((unsigned*)(ka->ws + WS_CTL) + CW_BAR, MISC + 8); }
#define GRID_BAR() do { XcdBarrier b_ = bar; asm volatile("" : "+s"(b_.bar), "+s"(b_.x)); xcd_barrier(b_); } while (0)
    LAS float* scr = (LAS float*)(lds + wave * 16384);

    for (int l = 0; l < NLAYER; ++l) {
        const bool moe = (l & 1) != 0; const int fi = l >> 1;
        if (PH(1)) {
            KArgs ka = kargs(); unsigned char* ws = ka->ws; float* xout = ka->out; const int lane = opaque_v(tid) & 63;
            bf16_t* Wproj = (bf16_t*)(ws + WM_PROJ);
            int off = 0;
            const float* win = ka->in[I_WIN] + (size_t)l * DM * INW;
            tr_segment(win, INW, DM, C_Q, 512, Wproj, 0, 0, scr, gw, NGW, lane, off);
            tr_segment(win, INW, DM, C_K, 512, Wproj, 512, 0, scr, gw, NGW, lane, off);
            tr_segment(win, INW, DM, C_V, 512, (bf16_t*)(ws + WM_V), 0, 0, scr, gw, NGW, lane, off);
            tr_segment(win, INW, DM, C_SU, 1024, Wproj, 1024, 0, scr, gw, NGW, lane, off);
            tr_segment(win, INW, DM, C_CONV, 512, Wproj, 2048, 128, scr, gw, NGW, lane, off);
            tr_segment(win, INW, DM, C_CONV + 512, 512, Wproj, 2048 + 128, 128, scr, gw, NGW, lane, off);
            tr_segment(win, INW, DM, C_POOL, 512, Wproj, 3072, 0, scr, gw, NGW, lane, off);
            tr_segment(win, INW, DM, C_GATE, 4096, Wproj, 3584, 0, scr, gw, NGW, lane, off);
            for (int i = 0; i < 4; ++i) tr_segment(ka->in[I_WBR] + ((size_t)l * 4 + i) * 512 * 1024, 1024, 512, 0, 1024, (bf16_t*)(ws + WM_B) + (size_t)i * 1024 * 512, 0, 0, scr, gw, NGW, lane, off);
            tr_segment(ka->in[I_WOUT] + (size_t)l * 1024 * 1024, 1024, 1024, 0, 1024, (bf16_t*)(ws + WM_OUT), 0, 0, scr, gw, NGW, lane, off);
            for (int g = 0; g < 4; ++g) tr_segment(ka->in[I_WPOOL] + ((size_t)l * 4 + g) * 128 * 128, 128, 128, 0, 128, (bf16_t*)(ws + WM_PG) + (size_t)g * 128 * 128, 0, 0, scr, gw, NGW, lane, off);
            { const float* wsp = ka->in[I_WSP] + (size_t)l * 8 * 128 * 128; bf16_t* Wsp = (bf16_t*)(ws + WM_SP);
              for (int i = bx * 512 + opaque_v(tid); i < 8 * 128 * 128; i += G * 512) { const int t = (i >> 7) & 127, s = i & 127; Wsp[i] = (s <= t) ? f2bf(wsp[i]) : (bf16_t)0; } }
            const float* xin = (l == 0) ? ka->in[I_X] : xout;
            const bf16_t* yc = (l > 0 && ((l - 1) & 1)) ? (const bf16_t*)(ws + WS_XS) : nullptr;
            norm_rows<0>(xin, xout, yc != nullptr, yc, ka->in[I_GMIX] + l * DM, (bf16_t*)(ws + WS_H), win + C_F, INW, ka->in[I_BF] + l * 8, (float*)(ws + WS_LF), nullptr, nullptr, gw, NGW, lane);
        }
        GRID_BAR();
        if (PH(2)) {
            KArgs ka = kargs(); unsigned char* ws = ka->ws;
            pg8::Gemm g{(bf16_t*)(ws + WS_H), (bf16_t*)(ws + WM_PROJ), NTOK, NPROJ, DM}; pg8::StaticOrder S; S.init(NTOK, NPROJ, G, bx);
            pg8::EpiProj E{ws, ka->in[I_BGATE] + (size_t)l * 4096, WS_Q, WS_K, WS_SUV, WS_CY, WS_PIN, WS_G};
            pg8::gemm_phase<pg8::EpiProj, pg8::StaticOrder, true, true>(lds, g, S, E);
        }
        if (PH(2)) {
            KArgs ka = kargs(); unsigned char* ws = ka->ws;
            pg8::Gemm g2{(bf16_t*)(ws + WM_V), (bf16_t*)(ws + WS_H), 512, NTOK, DM}; pg8::StaticOrder S2; S2.init(512, NTOK, G, bx);
            pg8::EpiBf16<0> E2{(bf16_t*)(ws + WS_VT), NTOK, nullptr, 0, 0, 1.f};
            pg8::gemm_phase<pg8::EpiBf16<0>, pg8::StaticOrder, true, true>(lds, g2, S2, E2);
        }
        GRID_BAR();
        if (PH(3)) {
#ifndef MK_NO_ATTN
            for (int i = 0;; ++i) {
                int bh, qb;
                if (G == 256) { if (i >= 4) break; bh = bx >> 1; const int s = (bx & 1); qb = (i == 0) ? s : (i == 1) ? 7 - s : (i == 2) ? 2 + s : 5 - s; }
                else { const int u = i * G + bx; if (u >= 1024) break; bh = u >> 3; qb = u & 7; }
                KArgs ka = kargs(); unsigned char* ws = ka->ws;
                attn_unit(lds, bh >> 3, bh & 7, qb, (const bf16_t*)(ws + WS_Q), (const bf16_t*)(ws + WS_K), (const bf16_t*)(ws + WS_VT), (const float*)(ws + WS_LF),
                          ka->in[I_GQ] + l * 64, ka->in[I_GK] + l * 64, (bf16_t*)(ws + WS_YS), opaque_v(tid));
            }
#endif
#ifndef MK_NO_SGU
            for (int c = bx; c < 256; c += G) {
                KArgs ka = kargs(); unsigned char* ws = ka->ws;
                sgu_unit(lds, c, (const bf16_t*)(ws + WS_SUV), ka->in[I_GSGU] + l * 512, (const bf16_t*)(ws + WM_SP), ka->in[I_BSP] + l * 8 * 128, (bf16_t*)(ws + WS_YS) + (size_t)NTOK * 512, opaque_v(tid));
            }
#endif
#ifndef MK_NO_CONV
            for (int t = bx; t < 512; t += G) {
                KArgs ka = kargs(); unsigned char* ws = ka->ws;
                conv_unit(lds, t, (const bf16_t*)(ws + WS_CY), ka->in[I_WDW] + (size_t)l * 31 * 512, ka->in[I_BDW] + l * 512, ka->in[I_GCONV] + l * 512, (bf16_t*)(ws + WS_YS) + (size_t)2 * NTOK * 512, opaque_v(tid));
                pool_unit(lds, t, (const bf16_t*)(ws + WS_PIN), (const bf16_t*)(ws + WM_PG), ka->in[I_PSCALE] + l * 512, (bf16_t*)(ws + WS_YS) + (size_t)3 * NTOK * 512, opaque_v(tid));
            }
#endif
        }
        GRID_BAR();
        if (PH(4)) {
            KArgs ka = kargs(); unsigned char* ws = ka->ws;
            pg8::Gemm g{(bf16_t*)(ws + WS_YS), (bf16_t*)(ws + WM_B), 4 * NTOK, 4096, 512}; pg8::MergeOrder S{G, bx};
            pg8::EpiMerge E{(bf16_t*)(ws + WS_G), (bf16_t*)(ws + WS_MG)};
            pg8::gemm_phase<pg8::EpiMerge, pg8::MergeOrder, true, true>(lds, g, S, E);
        }
        GRID_BAR();
        if (PH(5)) {
            KArgs ka = kargs(); unsigned char* ws = ka->ws; float* xout = ka->out;
            pg8::Gemm g{(bf16_t*)(ws + WS_MG), (bf16_t*)(ws + WM_OUT), NTOK, DM, DM}; pg8::StaticOrder S; S.init(NTOK, DM, G, bx);
            pg8::EpiResid E{(l == 0) ? ka->in[I_X] : xout, xout};
            pg8::gemm_phase<pg8::EpiResid, pg8::StaticOrder, true, true>(lds, g, S, E);
        }
        GRID_BAR();
        if (PH(6)) {
            KArgs ka = kargs(); unsigned char* ws = ka->ws; float* xout = ka->out; const int lane = opaque_v(tid) & 63;
            bf16_t* Wgu = (bf16_t*)(ws + WF_GU);
            int off = 0;
            if (!moe) {
                tr_segment(ka->in[I_WFG] + (size_t)fi * DM * FFD, FFD, DM, 0, FFD, Wgu, 0, 128, scr, gw, NGW, lane, off);
                tr_segment(ka->in[I_WFU] + (size_t)fi * DM * FFD, FFD, DM, 0, FFD, Wgu, 128, 128, scr, gw, NGW, lane, off);
                tr_segment(ka->in[I_WFD] + (size_t)fi * FFD * DM, DM, FFD, 0, DM, (bf16_t*)(ws + WF_D_DENSE), 0, 0, scr, gw, NGW, lane, off);
                norm_rows<1>(xout, xout, false, nullptr, ka->in[I_GFFN] + l * DM, (bf16_t*)(ws + WS_H), nullptr, 0, nullptr, nullptr, nullptr, nullptr, gw, NGW, lane);
            } else {
                for (int e = 0; e < NEXP; ++e) {
                    tr_segment(ka->in[I_WEG] + ((size_t)fi * NEXP + e) * DM * FFE, FFE, DM, 0, FFE, Wgu + (size_t)e * 2 * FFE * DM, 0, 128, scr, gw, NGW, lane, off);
                    tr_segment(ka->in[I_WEU] + ((size_t)fi * NEXP + e) * DM * FFE, FFE, DM, 0, FFE, Wgu + (size_t)e * 2 * FFE * DM, 128, 128, scr, gw, NGW, lane, off);
                    tr_segment(ka->in[I_WED] + ((size_t)fi * NEXP + e) * FFE * DM, DM, FFE, 0, DM, (bf16_t*)(ws + WF_D_MOE) + (size_t)e * DM * FFE, 0, 0, scr, gw, NGW, lane, off);
                }
                norm_rows<2>(xout, xout, false, nullptr, ka->in[I_GFFN] + l * DM, (bf16_t*)(ws + WS_H), ka->in[I_WROUTER] + (size_t)fi * DM * 8, 8, nullptr, nullptr, (int*)(ws + WS_ASG),
                             (gu32*)(ws + WS_CTL) + CW_CNT + fi * 1024, gw, NGW, lane);
            }
        }
        GRID_BAR();
        if (!moe) {
            if (PH(7)) {
                KArgs ka = kargs(); unsigned char* ws = ka->ws;
                pg8::Gemm g{(bf16_t*)(ws + WS_H), (bf16_t*)(ws + WF_GU), NTOK, 2 * FFD, DM}; pg8::StaticOrder S; S.init(NTOK, 2 * FFD, G, bx);
                pg8::EpiSwiglu E{(bf16_t*)(ws + WS_ACT), FFD, 2 * FFD / 256};
                pg8::gemm_phase<pg8::EpiSwiglu, pg8::StaticOrder, true, true>(lds, g, S, E);
            }
            GRID_BAR();
            if (PH(8)) {
                KArgs ka = kargs(); unsigned char* ws = ka->ws; float* xout = ka->out;
                pg8::Gemm g{(bf16_t*)(ws + WS_ACT), (bf16_t*)(ws + WF_D_DENSE), NTOK, DM, FFD}; pg8::StaticOrder S; S.init(NTOK, DM, G, bx);
                pg8::EpiResid E{xout, xout};
                pg8::gemm_phase<pg8::EpiResid, pg8::StaticOrder, true, true>(lds, g, S, E);
            }
            GRID_BAR();
        } else {
            if (PH(9)) {
                KArgs ka = kargs(); unsigned char* ws = ka->ws;
                { const int t_ = opaque_v(tid); moe_scatter((gu32*)(ws + WS_CTL) + CW_CNT + fi * 1024, (const int*)(ws + WS_ASG), (const bf16_t*)(ws + WS_H), (bf16_t*)(ws + WS_XS), (int*)(ws + WS_RINFO), gw, NGW, t_ & 63, t_, bx, G); }
            }
            GRID_BAR();
            if (PH(10)) {
                KArgs ka = kargs(); unsigned char* ws = ka->ws;
                pg8::GroupedOrder S; S.G = G; S.c = bx; S.nct = 2 * FFE / 256; { int ps[8]; moe_offsets((gu32*)(ws + WS_CTL) + CW_CNT + fi * 1024, ps, S.tend, S.T); }
                pg8::Gemm g{(bf16_t*)(ws + WS_XS), (bf16_t*)(ws + WF_GU), PMAX, NEXP * 2 * FFE, DM};
                pg8::EpiSwiglu E{(bf16_t*)(ws + WS_ACT), FFE, 2 * FFE / 256};
                pg8::gemm_phase<pg8::EpiSwiglu, pg8::GroupedOrder, true, true>(lds, g, S, E);
            }
            GRID_BAR();
            if (PH(11)) {
                KArgs ka = kargs(); unsigned char* ws = ka->ws;
                pg8::GroupedOrder S; S.G = G; S.c = bx; S.nct = 4; { int ps[8]; moe_offsets((gu32*)(ws + WS_CTL) + CW_CNT + fi * 1024, ps, S.tend, S.T); }
                pg8::Gemm g{(bf16_t*)(ws + WS_ACT), (bf16_t*)(ws + WF_D_MOE), PMAX, NEXP * DM, FFE};
                pg8::EpiDownMoe E{(const int*)(ws + WS_RINFO), (bf16_t*)(ws + WS_XS)};
                pg8::gemm_phase<pg8::EpiDownMoe, pg8::GroupedOrder, true, true>(lds, g, S, E);
            }
            GRID_BAR();
        }
    }
    { KArgs ka = kargs(); final_combine(ka->out, (const bf16_t*)(ka->ws + WS_XS), gw, NGW, opaque_v(tid) & 63); }
}

extern "C" void kernel_launch(void* const* d_in, const int* in_sizes, int n_in, void* d_out, int out_size, void* d_ws, size_t ws_size, hipStream_t stream) {
    static int grid = 0;
    if (grid == 0) {
        if (n_in != 25 || in_sizes[0] != NTOK * DM || out_size != NTOK * DM || ws_size < WS_END) {
            fprintf(stderr, "kernel_launch: unexpected shapes / workspace (n_in %d, in0 %d, out %d, ws %zu < %zu)\n", n_in, n_in > 0 ? in_sizes[0] : -1, out_size, ws_size, (size_t)WS_END); grid = -1; return; }
        int dev = 0, cus = 0, per_cu = 0;
        if (hipGetDevice(&dev) != hipSuccess || hipDeviceGetAttribute(&cus, hipDeviceAttributeMultiprocessorCount, dev) != hipSuccess) { grid = -1; return; }
        if (hipFuncSetAttribute((const void*)fwd_kernel, hipFuncAttributeMaxDynamicSharedMemorySize, LDS_BYTES) != hipSuccess) { fprintf(stderr, "kernel_launch: hipFuncSetAttribute failed\n"); grid = -1; return; }
        if (hipOccupancyMaxActiveBlocksPerMultiprocessor(&per_cu, (const void*)fwd_kernel, NWAVES * 64, LDS_BYTES) != hipSuccess || per_cu < 1) { fprintf(stderr, "kernel_launch: occupancy query reports %d\n", per_cu); }
        (void)hipGetLastError();
        grid = cus;
    }
    if (grid < 0) return;
    if (hipMemsetAsync((char*)d_ws + WS_CTL, 0, CTL_ZERO_BYTES, stream) != hipSuccess) return;
    Args a{};
    for (int i = 0; i < 25; ++i) a.in[i] = (const float*)d_in[i];
    a.out = (float*)d_out; a.ws = (unsigned char*)d_ws;
    hipLaunchKernelGGL(fwd_kernel, dim3(grid), dim3(NWAVES * 64), LDS_BYTES, stream, a);
}
```

```cpp
#include <hip/hip_runtime.h>
#include <cstdio>
#include <cstdint>
namespace pg8 {
#define PG8_LAS __attribute__((address_space(3)))
typedef unsigned short bf16_t;
typedef short bf16x8 __attribute__((ext_vector_type(8)));
typedef float f32x4 __attribute__((ext_vector_type(4)));
typedef unsigned u32x4 __attribute__((ext_vector_type(4)));
constexpr int BM = 256, BK = 64, HALF = 128, HTB = HALF * BK * 2  , STAGE_BYTES = 8 * HTB, NXCD = 8, WGM = 8;

__host__ __device__ __forceinline__ int lds_byte(int r, int c) { const int st = (r >> 4) * 2 + (c >> 5), rr = r & 15, cc = c & 31, ob = rr * 64 + cc * 2; return st * 1024 + (ob ^ (((ob >> 9) & 1) << 5)); }
__host__ __device__ __forceinline__ void stage_rc(int b, int& R, int& C) { const int st = b / 1024, sb = b % 1024, swz = sb ^ (((sb >> 9) & 1) << 5); R = (st >> 1) * 16 + swz / 64; C = (st & 1) * 32 + (swz % 64) / 2; }
__host__ __device__ __forceinline__ int perm32(int rho) { const int n = rho >> 4, i = rho & 15; return 8 * (i >> 2) + 4 * n + (i & 3); }

struct Unit { int pm, pn; };
struct Gemm { const bf16_t* A; const bf16_t* Bt; int M, N, K; };

struct StaticOrder {
    int nM, nN, nwg, G, c;
    __host__ __device__ void init(int M, int N, int G_, int c_) { nM = M / BM; nN = N / BM; nwg = nM * nN; G = G_; c = c_; }
    __host__ __device__ bool next(int i, Unit& u) const {
        const long L = (long)i * G + c; if (L >= nwg) return false;
        int wgid = (int)L; { const int q = nwg / NXCD, r = nwg % NXCD, xcd = wgid % NXCD, off = wgid / NXCD; wgid = (xcd < r ? xcd * (q + 1) : r * (q + 1) + (xcd - r) * q) + off; }
        const int nig = WGM * nN, gid = wgid / nig, fm = gid * WGM, gsz = (nM - fm) < WGM ? (nM - fm) : WGM;
        u.pm = fm + ((wgid % nig) % gsz); u.pn = (wgid % nig) / gsz; return true;
    }
    __device__ __forceinline__ void a_ready(const Unit&) const {}
    __device__ __forceinline__ void done(const Unit&) const {}
};

__device__ __forceinline__ unsigned cvt_pk_bf16(float lo, float hi) { unsigned r; asm volatile("v_cvt_pk_bf16_f32 %0, %1, %2" : "=v"(r) : "v"(lo), "v"(hi)); return r; }
typedef float f32x2 __attribute__((ext_vector_type(2)));
__device__ __forceinline__ f32x2 gelu_pk(f32x2 v) {
    const f32x2 av = __builtin_elementwise_abs(v), d = av * 0.2316418882f + 1.0f;
    f32x2 t; t.x = __builtin_amdgcn_rcpf(d.x); t.y = __builtin_amdgcn_rcpf(d.y);
    f32x2 q = t * 0.5307027145f + (-0.7265760135f); q = q * t + 0.7107068705f; q = q * t + (-0.142248368f); q = q * t + 0.127414796f; q = q * t;
    const f32x2 s = (v * v) * (-0.72134752044f);
    f32x2 e; e.x = __builtin_amdgcn_exp2f(s.x); e.y = __builtin_amdgcn_exp2f(s.y);
    const f32x2 m = v * (q * e), r = v - m;
    f32x2 o; o.x = v.x < 0.f ? m.x : r.x; o.y = v.y < 0.f ? m.y : r.y; return o;
}

template <int ACT  > struct EpiBf16 {
    static constexpr bool PERM = true, AFTER_DRAIN = false; static_assert(ACT == 0 || ACT == 1, "EpiBf16: ACT is 0 (none) or 1 (gelu_pk)");
    bf16_t* O; int ldc; const float* bias; int split_cols; size_t split_stride; float scale0;
    __device__ __forceinline__ void operator()(const f32x4 (&acc)[2][2][4][2], const Unit& u, int wr, int wc, int fr, int fq) const {
        const int row0 = u.pm * BM + wr * 64 + fr; int colt = u.pn * BM; bf16_t* base = O;
        float sc = 1.f; if (split_cols) { const int t = colt / split_cols; base += (size_t)t * split_stride; colt -= t * split_cols; if (t == 0) sc = scale0; }
        const int col0 = colt + wc * 32 + 8 * fq, bcol0 = u.pn * BM + wc * 32 + 8 * fq;
        f32x4 bv[2][2];
#pragma unroll
        for (int bj = 0; bj < 2; ++bj)
#pragma unroll
            for (int n = 0; n < 2; ++n) bv[bj][n] = bias ? *(const f32x4*)(bias + bcol0 + bj * HALF + 4 * n) : (f32x4){0.f, 0.f, 0.f, 0.f};
#pragma unroll
        for (int ai = 0; ai < 2; ++ai)
#pragma unroll
            for (int m = 0; m < 4; ++m) { bf16_t* rowp = base + (size_t)(row0 + ai * HALF + m * 16) * ldc + col0;
#pragma unroll
                for (int bj = 0; bj < 2; ++bj) { f32x4 v0 = acc[ai][bj][m][0] + bv[bj][0], v1 = acc[ai][bj][m][1] + bv[bj][1];
                    if (ACT == 1) { f32x2 a = gelu_pk((f32x2){v0[0], v0[1]}), b = gelu_pk((f32x2){v0[2], v0[3]}), c = gelu_pk((f32x2){v1[0], v1[1]}), d = gelu_pk((f32x2){v1[2], v1[3]});
                        v0 = (f32x4){a.x, a.y, b.x, b.y}; v1 = (f32x4){c.x, c.y, d.x, d.y}; }
                    v0 = v0 * sc; v1 = v1 * sc; u32x4 w; w.x = cvt_pk_bf16(v0[0], v0[1]); w.y = cvt_pk_bf16(v0[2], v0[3]); w.z = cvt_pk_bf16(v1[0], v1[1]); w.w = cvt_pk_bf16(v1[2], v1[3]);
                    *(u32x4*)(rowp + bj * HALF) = w; } }
    }
};


typedef unsigned u32x2 __attribute__((ext_vector_type(2)));
__device__ __forceinline__ float fast_sigmoid(float x) { return __builtin_amdgcn_rcpf(1.0f + __builtin_amdgcn_exp2f(-1.4426950408889634f * x)); }
__device__ __forceinline__ float gelu_tanh(float x) {
    const float a = 1.5957691216057308f * (x + 0.044715f * x * x * x);
    return x * fast_sigmoid(a);
}
__device__ __forceinline__ float bf_lo(unsigned w) { return __uint_as_float(w << 16); }
__device__ __forceinline__ float bf_hi(unsigned w) { return __uint_as_float(w & 0xffff0000u); }
__device__ __forceinline__ u32x4 pack8(f32x4 v0, f32x4 v1) { u32x4 w; w.x = cvt_pk_bf16(v0[0], v0[1]); w.y = cvt_pk_bf16(v0[2], v0[3]); w.z = cvt_pk_bf16(v1[0], v1[1]); w.w = cvt_pk_bf16(v1[2], v1[3]); return w; }

struct EpiProj {
    static constexpr bool PERM = true, AFTER_DRAIN = false;
    unsigned char* ws; const float* bgate; size_t oQ, oK, oSUV, oCY, oPIN, oG;
    __device__ __forceinline__ void operator()(const f32x4 (&acc)[2][2][4][2], const Unit& u, int wr, int wc, int fr, int fq) const {
        const int row0 = u.pm * BM + wr * 64 + fr; const int pn = u.pn; const int cw = wc * 32 + 8 * fq;
        if (pn >= 8 && pn < 12) {
            bf16_t* base = (bf16_t*)(ws + oCY) + (pn - 8) * HALF + cw;
#pragma unroll
            for (int ai = 0; ai < 2; ++ai)
#pragma unroll
                for (int m = 0; m < 4; ++m) { bf16_t* rowp = base + (size_t)(row0 + ai * HALF + m * 16) * 512;
                    f32x4 v0 = acc[ai][0][m][0], v1 = acc[ai][0][m][1]; const f32x4 g0 = acc[ai][1][m][0], g1 = acc[ai][1][m][1];
#pragma unroll
                    for (int e = 0; e < 4; ++e) { v0[e] *= fast_sigmoid(g0[e]); v1[e] *= fast_sigmoid(g1[e]); }
                    *(u32x4*)rowp = pack8(v0, v1); }
        } else {
            size_t boff; int ld, colt, kind;
            if (pn < 2) { boff = oQ; ld = 512; colt = pn * BM; kind = 0; }
            else if (pn < 4) { boff = oK; ld = 512; colt = (pn - 2) * BM; kind = 0; }
            else if (pn < 8) { boff = oSUV; ld = 1024; colt = (pn - 4) * BM; kind = 1; }
            else if (pn < 14) { boff = oPIN; ld = 512; colt = (pn - 12) * BM; kind = 0; }
            else { boff = oG; ld = 4096; colt = (pn - 14) * BM; kind = 2; }
            bf16_t* base = (bf16_t*)(ws + boff) + colt + cw;
            f32x4 bv[2][2];
#pragma unroll
            for (int bj = 0; bj < 2; ++bj)
#pragma unroll
                for (int n = 0; n < 2; ++n) bv[bj][n] = (kind == 2) ? *(const f32x4*)(bgate + colt + cw + bj * HALF + 4 * n) : (f32x4){0.f, 0.f, 0.f, 0.f};
#pragma unroll
            for (int ai = 0; ai < 2; ++ai)
#pragma unroll
                for (int m = 0; m < 4; ++m) { bf16_t* rowp = base + (size_t)(row0 + ai * HALF + m * 16) * ld;
#pragma unroll
                    for (int bj = 0; bj < 2; ++bj) { f32x4 v0 = acc[ai][bj][m][0] + bv[bj][0], v1 = acc[ai][bj][m][1] + bv[bj][1];
                        if (kind == 2) {
#pragma unroll
                            for (int e = 0; e < 4; ++e) { v0[e] = fast_sigmoid(v0[e]); v1[e] = fast_sigmoid(v1[e]); }
                        } else if (kind == 1) {
#pragma unroll
                            for (int e = 0; e < 4; ++e) { v0[e] = gelu_tanh(v0[e]); v1[e] = gelu_tanh(v1[e]); } }
                        *(u32x4*)(rowp + bj * HALF) = pack8(v0, v1); } }
        }
    }
};

struct EpiMerge {
    static constexpr bool PERM = true, AFTER_DRAIN = false;
    const bf16_t* G; bf16_t* MG;
    __device__ __forceinline__ void operator()(const f32x4 (&acc)[2][2][4][2], const Unit& u, int wr, int wc, int fr, int fq) const {
        const int br = u.pn >> 2, ct = u.pn & 3, rt = u.pm - br * 128;
        const int row0 = rt * BM + wr * 64 + fr, col0 = ct * BM + wc * 32 + 8 * fq;
#pragma unroll
        for (int ai = 0; ai < 2; ++ai)
#pragma unroll
            for (int m = 0; m < 4; ++m) { const size_t row = (size_t)(row0 + ai * HALF + m * 16);
#pragma unroll
                for (int bj = 0; bj < 2; ++bj) { const int col = col0 + bj * HALF;
                    const u32x4 g = *(const u32x4*)(G + row * 4096 + br * 1024 + col);
                    f32x4 v0 = acc[ai][bj][m][0], v1 = acc[ai][bj][m][1];
                    v0[0] *= bf_lo(g.x); v0[1] *= bf_hi(g.x); v0[2] *= bf_lo(g.y); v0[3] *= bf_hi(g.y);
                    v1[0] *= bf_lo(g.z); v1[1] *= bf_hi(g.z); v1[2] *= bf_lo(g.w); v1[3] *= bf_hi(g.w);
                    bf16_t* mp = MG + row * 1024 + col;
                    if (br > 0) { const u32x4 o = *(const u32x4*)mp;
                        v0[0] += bf_lo(o.x); v0[1] += bf_hi(o.x); v0[2] += bf_lo(o.y); v0[3] += bf_hi(o.y);
                        v1[0] += bf_lo(o.z); v1[1] += bf_hi(o.z); v1[2] += bf_lo(o.w); v1[3] += bf_hi(o.w); }
                    *(u32x4*)mp = pack8(v0, v1); } }
    }
};
struct MergeOrder {
    int G, c;
    __device__ __forceinline__ bool next(int i, Unit& u) const {
        const int tl = (i >> 2) * G + c; if (tl >= 512) return false;
        const int br = i & 3, rt = tl >> 2, ct = tl & 3; u.pm = br * 128 + rt; u.pn = br * 4 + ct; return true;
    }
    __device__ __forceinline__ void a_ready(const Unit&) const {}
    __device__ __forceinline__ void done(const Unit&) const {}
};

struct EpiResid {
    static constexpr bool PERM = true, AFTER_DRAIN = false;
    const float* xin; float* xout;
    __device__ __forceinline__ void operator()(const f32x4 (&acc)[2][2][4][2], const Unit& u, int wr, int wc, int fr, int fq) const {
        const int row0 = u.pm * BM + wr * 64 + fr, col0 = u.pn * BM + wc * 32 + 8 * fq;
#pragma unroll
        for (int ai = 0; ai < 2; ++ai)
#pragma unroll
            for (int m = 0; m < 4; ++m) { const size_t off = (size_t)(row0 + ai * HALF + m * 16) * 1024 + col0;
#pragma unroll
                for (int bj = 0; bj < 2; ++bj) {
                    const f32x4 a = *(const f32x4*)(xin + off + bj * HALF), b = *(const f32x4*)(xin + off + bj * HALF + 4);
                    *(f32x4*)(xout + off + bj * HALF) = a + acc[ai][bj][m][0]; *(f32x4*)(xout + off + bj * HALF + 4) = b + acc[ai][bj][m][1]; } }
    }
};

struct EpiSwiglu {
    static constexpr bool PERM = true, AFTER_DRAIN = false;
    bf16_t* ACT; int ldc, nct;
    __device__ __forceinline__ void operator()(const f32x4 (&acc)[2][2][4][2], const Unit& u, int wr, int wc, int fr, int fq) const {
        const int row0 = u.pm * BM + wr * 64 + fr, col0 = (u.pn % nct) * HALF + wc * 32 + 8 * fq;
#pragma unroll
        for (int ai = 0; ai < 2; ++ai)
#pragma unroll
            for (int m = 0; m < 4; ++m) { bf16_t* rowp = ACT + (size_t)(row0 + ai * HALF + m * 16) * ldc + col0;
                const f32x4 g0 = acc[ai][0][m][0], g1 = acc[ai][0][m][1]; f32x4 v0 = acc[ai][1][m][0], v1 = acc[ai][1][m][1];
#pragma unroll
                for (int e = 0; e < 4; ++e) { v0[e] *= g0[e] * fast_sigmoid(g0[e]); v1[e] *= g1[e] * fast_sigmoid(g1[e]); }
                *(u32x4*)rowp = pack8(v0, v1); }
    }
};

struct EpiDownMoe {
    static constexpr bool PERM = true, AFTER_DRAIN = false;
    const int* rinfo; bf16_t* Y;
    __device__ __forceinline__ void operator()(const f32x4 (&acc)[2][2][4][2], const Unit& u, int wr, int wc, int fr, int fq) const {
        const int prow0 = u.pm * BM + wr * 64 + fr, col0 = (u.pn & 3) * BM + wc * 32 + 8 * fq;
#pragma unroll
        for (int ai = 0; ai < 2; ++ai)
#pragma unroll
            for (int m = 0; m < 4; ++m) { const int prow = prow0 + ai * HALF + m * 16;
                const u32x2 ri = *(const u32x2*)(rinfo + 2 * (size_t)prow); const int tokk = (int)ri.x; const float gt = __uint_as_float(ri.y);
                if (tokk >= 0) { bf16_t* rowp = Y + ((size_t)(tokk & 1) * 32768 + (size_t)(tokk >> 1)) * 1024 + col0;
#pragma unroll
                    for (int bj = 0; bj < 2; ++bj) *(u32x4*)(rowp + bj * HALF) = pack8(acc[ai][bj][m][0] * gt, acc[ai][bj][m][1] * gt); } }
    }
};
struct GroupedOrder {
    int G, c, nct, T; int tend[8];
    __device__ __forceinline__ bool next(int i, Unit& u) const {
        const int L = i * G + c; if (L >= T * nct) return false;
        const int nig = 8 * nct, grp = L / nig, w = L % nig, fm = grp * 8, gsz = (T - fm) < 8 ? (T - fm) : 8;
        const int rt = fm + w % gsz, ct = w / gsz; int e = 0;
#pragma unroll
        for (int k = 0; k < 7; ++k) e += (rt >= tend[k]) ? 1 : 0;
        u.pm = rt; u.pn = e * nct + ct; return true;
    }
    __device__ __forceinline__ void a_ready(const Unit&) const {}
    __device__ __forceinline__ void done(const Unit&) const {}
};
template <class Epi, class Sched, bool ALIGN_EPI = false, bool SP2 = false>
__device__ __forceinline__ void gemm_phase(PG8_LAS unsigned char* lds, const Gemm g, const Sched& S, const Epi& E) {
    int tid_l = threadIdx.x; asm volatile("" : "+v"(tid_l));
    const int tid = tid_l, wid = __builtin_amdgcn_readfirstlane(tid >> 6), lane = tid & 63, wr = wid >> 2, wc = wid & 3, fr = lane & 15, fq = lane >> 4;
    const int K = g.K, nt = K / BK;
    unsigned voffA[2], voffB[2];
#pragma unroll
    for (int i = 0; i < 2; ++i) { int R, C; stage_rc(tid * 16 + i * 8192, R, C); const int Rb = Epi::PERM ? ((R & ~31) + perm32(R & 31)) : R;
        voffA[i] = (unsigned)(R * K + C) * 2u; voffB[i] = (unsigned)(Rb * K + C) * 2u; }
    const size_t kstep = (size_t)(BK * 2);
    const size_t hstep = (size_t)HALF * K * 2;
    const size_t tstep = 2 * hstep;
    const unsigned ldsw = (unsigned)wid * 1024u;
    const int aoff = lds_byte(wr * 64 + fr, fq * 8), boff = lds_byte(wc * 32 + fr, fq * 8);
#define PG8_SA(b, h) (((b) * 2 + (h)) * HTB)
#define PG8_SB(b, h) ((4 + (b) * 2 + (h)) * HTB)
#define PG8_STAGE(bufoff, gbase, voff) do { _Pragma("unroll") for (int _i = 0; _i < 2; ++_i) \
        __builtin_amdgcn_global_load_lds((const unsigned*)((const char*)(gbase) + (voff)[_i]), (PG8_LAS unsigned*)(lds + (bufoff) + ldsw + _i * 8192), 16, 0, 0); } while (0)
#define PG8_LDA(dst, b, h) do { _Pragma("unroll") for (int m = 0; m < 4; ++m) _Pragma("unroll") for (int k = 0; k < 2; ++k) dst[m][k] = *(const PG8_LAS bf16x8*)(lds + PG8_SA(b, h) + aoff + m * 2048 + k * 1024); } while (0)
#define PG8_LDB(dst, b, h) do { _Pragma("unroll") for (int n = 0; n < 2; ++n) _Pragma("unroll") for (int k = 0; k < 2; ++k) dst[n][k] = *(const PG8_LAS bf16x8*)(lds + PG8_SB(b, h) + boff + n * 2048 + k * 1024); } while (0)
#define PG8_MMA(ai, bj, At, Bt) do { __builtin_amdgcn_s_setprio(1); _Pragma("unroll") for (int m = 0; m < 4; ++m) _Pragma("unroll") for (int n = 0; n < 2; ++n) _Pragma("unroll") for (int k = 0; k < 2; ++k) \
        acc[ai][bj][m][n] = __builtin_amdgcn_mfma_f32_16x16x32_bf16(Bt[n][k], At[m][k], acc[ai][bj][m][n], 0, 0, 0); __builtin_amdgcn_s_setprio(0); } while (0)
#define PG8_WAIT_V(n) asm volatile("s_waitcnt vmcnt(" #n ")" ::: "memory")
#define PG8_WAIT_L(n) asm volatile("s_waitcnt lgkmcnt(" #n ")" ::: "memory")
#define PG8_BAR __builtin_amdgcn_s_barrier()
#define PG8_SCHED __builtin_amdgcn_sched_barrier(0)
    Unit cur, nxt; int ui = 0;
    if (!S.next(0, cur)) return;
    f32x4 acc[2][2][4][2];
#pragma unroll
    for (int a = 0; a < 2; ++a)
#pragma unroll
        for (int b = 0; b < 2; ++b)
#pragma unroll
            for (int m = 0; m < 4; ++m)
#pragma unroll
                for (int n = 0; n < 2; ++n) acc[a][b][m][n] = (f32x4){0.f, 0.f, 0.f, 0.f};
    bf16x8 At[4][2], B0[2][2], B1[2][2];
    const char* cA = (const char*)g.A + (size_t)cur.pm * tstep; const char* cB = (const char*)g.Bt + (size_t)cur.pn * tstep;
    S.a_ready(cur);
    if constexpr (SP2) {
        PG8_STAGE(PG8_SB(0, 0), cB, voffB); PG8_STAGE(PG8_SB(0, 1), cB + hstep, voffB); PG8_STAGE(PG8_SA(0, 0), cA, voffA); PG8_STAGE(PG8_SA(0, 1), cA + hstep, voffA);
        if (wr == 1) PG8_BAR;
        PG8_WAIT_V(2); PG8_BAR;
        PG8_STAGE(PG8_SB(1, 0), cB + kstep, voffB); PG8_STAGE(PG8_SA(1, 0), cA + kstep, voffA); PG8_STAGE(PG8_SB(1, 1), cB + hstep + kstep, voffB);
        PG8_WAIT_V(6); PG8_BAR;
    } else {
        PG8_STAGE(PG8_SB(0, 0), cB, voffB); PG8_STAGE(PG8_SA(0, 0), cA, voffA); PG8_STAGE(PG8_SB(0, 1), cB + hstep, voffB); PG8_STAGE(PG8_SA(0, 1), cA + hstep, voffA);
        if (wr == 1) PG8_BAR;
        PG8_WAIT_V(4); PG8_BAR;
        PG8_STAGE(PG8_SB(1, 0), cB + kstep, voffB); PG8_STAGE(PG8_SA(1, 0), cA + kstep, voffA); PG8_STAGE(PG8_SB(1, 1), cB + hstep + kstep, voffB);
        PG8_WAIT_V(6); PG8_BAR;
    }
    for (;;) {
        const bool has_next = S.next(ui + 1, nxt);
        const char* nA = has_next ? (const char*)g.A + (size_t)nxt.pm * tstep : cA; const char* nB = has_next ? (const char*)g.Bt + (size_t)nxt.pn * tstep : cB;
        for (int t = 0; t < nt; t += 2) {
            const bool last = (t == nt - 2);
            const char* a1 = cA + (size_t)(t + 1) * kstep;
            const char* a2 = last ? nA : cA + (size_t)(t + 2) * kstep; const char* b2 = last ? nB : cB + (size_t)(t + 2) * kstep;
            const char* a3 = a2 + kstep; const char* b3 = b2 + kstep;
            if (last && has_next) S.a_ready(nxt);
            if constexpr (SP2) {
            PG8_LDB(B0, 0, 0); PG8_LDB(B1, 0, 1); PG8_SCHED; PG8_LDA(At, 0, 0); PG8_STAGE(PG8_SA(1, 1), a1 + hstep, voffA);
            PG8_WAIT_V(8); PG8_WAIT_L(0); PG8_BAR; PG8_MMA(0, 0, At, B0); PG8_MMA(0, 1, At, B1); PG8_BAR; PG8_SCHED;
            PG8_LDA(At, 0, 1); PG8_STAGE(PG8_SB(0, 0), b2, voffB); PG8_STAGE(PG8_SB(0, 1), b2 + hstep, voffB); PG8_STAGE(PG8_SA(0, 0), a2, voffA);
            PG8_WAIT_V(8); PG8_WAIT_L(0); PG8_BAR; PG8_MMA(1, 0, At, B0); PG8_MMA(1, 1, At, B1); PG8_BAR; PG8_SCHED;
            PG8_LDB(B0, 1, 0); PG8_LDB(B1, 1, 1); PG8_SCHED; PG8_LDA(At, 1, 0); PG8_STAGE(PG8_SA(0, 1), a2 + hstep, voffA);
            PG8_WAIT_V(8); PG8_WAIT_L(0); PG8_BAR; PG8_MMA(0, 0, At, B0); PG8_MMA(0, 1, At, B1); PG8_BAR; PG8_SCHED;
            PG8_LDA(At, 1, 1); PG8_STAGE(PG8_SB(1, 0), b3, voffB); PG8_STAGE(PG8_SB(1, 1), b3 + hstep, voffB); PG8_STAGE(PG8_SA(1, 0), a3, voffA);
            PG8_WAIT_V(8); PG8_WAIT_L(0); PG8_BAR; PG8_MMA(1, 0, At, B0); PG8_MMA(1, 1, At, B1); PG8_BAR; PG8_SCHED;
            } else {
            PG8_LDB(B0, 0, 0); PG8_SCHED; PG8_LDA(At, 0, 0); PG8_STAGE(PG8_SA(1, 1), a1 + hstep, voffA);
            PG8_WAIT_L(8); PG8_BAR; PG8_WAIT_L(0); PG8_MMA(0, 0, At, B0); PG8_BAR; PG8_SCHED;
            PG8_LDB(B1, 0, 1); PG8_STAGE(PG8_SB(0, 0), b2, voffB);
            PG8_BAR; PG8_WAIT_L(0); PG8_MMA(0, 1, At, B1); PG8_BAR;
            PG8_LDA(At, 0, 1); PG8_STAGE(PG8_SA(0, 0), a2, voffA);
            PG8_BAR; PG8_WAIT_L(0); PG8_MMA(1, 0, At, B0); PG8_BAR; PG8_SCHED;
            PG8_STAGE(PG8_SB(0, 1), b2 + hstep, voffB);
            PG8_WAIT_V(6); PG8_BAR; PG8_MMA(1, 1, At, B1); PG8_BAR;
            PG8_LDB(B0, 1, 0); PG8_SCHED; PG8_LDA(At, 1, 0); PG8_STAGE(PG8_SA(0, 1), a2 + hstep, voffA);
            PG8_WAIT_L(8); PG8_BAR; PG8_WAIT_L(0); PG8_MMA(0, 0, At, B0); PG8_BAR; PG8_SCHED;
            PG8_LDB(B1, 1, 1); PG8_STAGE(PG8_SB(1, 0), b3, voffB);
            PG8_BAR; PG8_WAIT_L(0); PG8_MMA(0, 1, At, B1); PG8_BAR;
            PG8_LDA(At, 1, 1); PG8_STAGE(PG8_SA(1, 0), a3, voffA);
            PG8_BAR; PG8_WAIT_L(0); PG8_MMA(1, 0, At, B0); PG8_BAR; PG8_SCHED;
            PG8_STAGE(PG8_SB(1, 1), b3 + hstep, voffB);
            PG8_WAIT_V(6); PG8_BAR; PG8_MMA(1, 1, At, B1); PG8_BAR;
            }
        }
        if constexpr (ALIGN_EPI) { if (wr == 0) PG8_BAR; }
        if constexpr (!Epi::AFTER_DRAIN) { E(acc, cur, wr, wc, fr, fq); S.done(cur); }
        if (!has_next) break;
#pragma unroll
        for (int a = 0; a < 2; ++a)
#pragma unroll
            for (int b = 0; b < 2; ++b)
#pragma unroll
                for (int m = 0; m < 4; ++m)
#pragma unroll
                    for (int n = 0; n < 2; ++n) acc[a][b][m][n] = (f32x4){0.f, 0.f, 0.f, 0.f};
        cur = nxt; cA = nA; cB = nB; ++ui;
        if constexpr (ALIGN_EPI) { if (wr == 1) PG8_BAR; }
    }
    PG8_WAIT_V(0);
    if constexpr (!ALIGN_EPI) { if (wr == 0) PG8_BAR; }
    PG8_BAR;
    if constexpr (Epi::AFTER_DRAIN) { E.fused(acc, cur, wr, wc, fr, fq, lds, wid, lane); S.done(cur); }
#undef PG8_SA
#undef PG8_SB
#undef PG8_STAGE
#undef PG8_LDA
#undef PG8_LDB
#undef PG8_MMA
#undef PG8_WAIT_V
#undef PG8_WAIT_L
#undef PG8_BAR
#undef PG8_SCHED
}
}

constexpr int NTOK = 32768, SEQ = 2048, DM = 1024, NLAYER = 4;
constexpr int INW = 8200;
constexpr int C_Q = 0, C_K = 512, C_V = 1024, C_F = 1536, C_SU = 1544, C_CONV = 2568, C_POOL = 3592, C_GATE = 4104;
constexpr int NPROJ = 7680;
constexpr int FFD = 2816, FFE = 3584, NEXP = 8;
constexpr int PMAX = 65536 + NEXP * 256;
constexpr float EPS = 1e-6f, LOG2E = 1.4426950408889634f;
constexpr int NWAVES = 8;

constexpr size_t MiB = 1u << 20;
constexpr size_t WS_CTL = 0, CTL_ZERO_BYTES = 1 * MiB;
constexpr size_t WS_LF = 1 * MiB;
constexpr size_t WS_RINFO = 2 * MiB;
constexpr size_t WS_ASG = 3 * MiB;
constexpr size_t WS_WMIX = 4 * MiB;
constexpr size_t WM_PROJ = WS_WMIX, WM_V = WM_PROJ + (size_t)NPROJ * 1024 * 2, WM_B = WM_V + 512 * 1024 * 2, WM_OUT = WM_B + (size_t)4096 * 512 * 2,
                 WM_PG = WM_OUT + (size_t)1024 * 1024 * 2, WM_SP = WM_PG + 4 * 128 * 128 * 2, WM_END = WM_SP + 8 * 128 * 128 * 2;
static_assert(WM_END <= 28 * MiB, "mixer weights");
constexpr size_t WS_H = 28 * MiB;
constexpr size_t WS_R = 92 * MiB;
constexpr size_t WS_Q = WS_R, WS_K = WS_Q + 32 * MiB, WS_VT = WS_K + 32 * MiB, WS_SUV = WS_VT + 32 * MiB, WS_CY = WS_SUV + 64 * MiB, WS_PIN = WS_CY + 32 * MiB,
                 WS_G = WS_PIN + 32 * MiB, WS_YS = WS_G + 256 * MiB, WS_MG = WS_YS + 128 * MiB, WS_MIX_END = WS_MG + 64 * MiB;
constexpr size_t WS_XS = WS_R;
constexpr size_t WS_WFFN = WS_XS + 132 * MiB;
constexpr size_t WF_GU = WS_WFFN, WF_D_DENSE = WF_GU + (size_t)2 * FFD * 1024 * 2, WF_D_MOE = WF_GU + (size_t)NEXP * 2 * FFE * 1024 * 2;
constexpr size_t WS_ACT = WS_WFFN + 168 * MiB;
constexpr size_t WS_END = WS_ACT + 462 * MiB;
static_assert(WF_D_MOE + (size_t)NEXP * 1024 * FFE * 2 <= WS_ACT && (size_t)PMAX * FFE * 2 <= 462 * MiB && (size_t)PMAX * 1024 * 2 <= 132 * MiB && WS_MIX_END <= WS_END, "d_ws map");
constexpr int CW_BAR = 4096;
constexpr int CW_CNT = 16384;

constexpr int RING_BYTES = 147456;
constexpr int MISC_OFF = RING_BYTES;
constexpr int LDS_BYTES = RING_BYTES + 256;

#define GAS __attribute__((address_space(1)))
#define LAS __attribute__((address_space(3)))
typedef unsigned short bf16_t;
typedef unsigned v4u __attribute__((ext_vector_type(4)));
typedef unsigned v2u __attribute__((ext_vector_type(2)));
typedef float f32x4 __attribute__((ext_vector_type(4)));
typedef float f32x16 __attribute__((ext_vector_type(16)));
typedef short bf16x8 __attribute__((ext_vector_type(8)));
typedef GAS unsigned gu32;
#define RLX_AGENT __ATOMIC_RELAXED, __HIP_MEMORY_SCOPE_AGENT
#define LDS_WAIT() asm volatile("s_waitcnt lgkmcnt(0)" ::: "memory")
typedef float f32x2_t __attribute__((ext_vector_type(2))); typedef __bf16 bf16x2_t __attribute__((ext_vector_type(2)));
__device__ __forceinline__ unsigned pk2(float lo, float hi) { f32x2_t v = {lo, hi}; bf16x2_t b = __builtin_convertvector(v, bf16x2_t); return __builtin_bit_cast(unsigned, b); }
__device__ __forceinline__ float blo(unsigned w) { return __uint_as_float(w << 16); }
__device__ __forceinline__ float bhi(unsigned w) { return __uint_as_float(w & 0xffff0000u); }
__device__ __forceinline__ float bf1(bf16_t b) { return __uint_as_float((unsigned)b << 16); }
__device__ __forceinline__ bf16_t f2bf(float f) { return (bf16_t)(pk2(f, 0.f) & 0xffffu); }
__device__ __forceinline__ float sigm(float x) { return __builtin_amdgcn_rcpf(1.0f + __builtin_amdgcn_exp2f(-LOG2E * x)); }
__device__ __forceinline__ float wave_sum(float v) {
#pragma unroll
    for (int o = 1; o < 64; o <<= 1) v += __shfl_xor(v, o);
    return v;
}
__device__ __forceinline__ int crow(int r, int hi) { return (r & 3) + 8 * (r >> 2) + 4 * hi; }
#define MFMA32(a, b, c) __builtin_amdgcn_mfma_f32_32x32x16_bf16((a), (b), (c), 0, 0, 0)

__device__ __forceinline__ void tr_item(const float* src, int ldn, int c0, int k0, bf16_t* dst, int ldk, int drow0, LAS float* scr, int lane) {
#pragma unroll 8
    for (int i = 0; i < 32; ++i) { const int kk = 2 * i + (lane >> 5); scr[kk * 33 + (lane & 31)] = src[(size_t)(k0 + kk) * ldn + c0 + (lane & 31)]; }
    LDS_WAIT(); asm volatile("" ::: "memory");
    const int c = lane & 7;
#pragma unroll
    for (int j = 0; j < 4; ++j) { const int n = (lane >> 3) + 8 * j; const LAS float* s = scr + (8 * c) * 33 + n;
        v4u o; o.x = pk2(s[0 * 33], s[1 * 33]); o.y = pk2(s[2 * 33], s[3 * 33]); o.z = pk2(s[4 * 33], s[5 * 33]); o.w = pk2(s[6 * 33], s[7 * 33]);
        *(v4u*)(dst + (size_t)(drow0 + n) * ldk + k0 + 8 * c) = o; }
    LDS_WAIT(); asm volatile("" ::: "memory");
}
__device__ __forceinline__ void tr_segment(const float* src, int ldn, int K, int c_begin, int ncols, bf16_t* dst, int drow_begin, int blk, LAS float* scr, int gw, int NGW, int lane, int& off) {
    const int nblk = ncols / 32, nitems = (K / 64) * nblk;
    int start = (gw - (off % NGW) + NGW) % NGW;
    for (int it = start; it < nitems; it += NGW) {
        const int kb = it / nblk, nb = it % nblk, n0 = nb * 32;
        const int drow0 = drow_begin + (blk ? (n0 / blk) * (2 * blk) + (n0 % blk) : n0);
        tr_item(src, ldn, c_begin + n0, kb * 64, dst, K, drow0, scr, lane);
    }
    off += nitems;
}

template <int MODE>
__device__ __forceinline__ void norm_rows(const float* xin, float* xout, bool write_x, const bf16_t* ycomb  , const float* gain, bf16_t* H,
                                          const float* w8, int ldw8, const float* b8, float* LF, int* ASG, gu32* cnt, int gw, int NGW, int lane) {
    f32x4 gv[4];
#pragma unroll
    for (int jj = 0; jj < 4; ++jj) gv[jj] = ((const f32x4*)gain)[64 * jj + lane];
    float wf[4][4][8];
    if (MODE != 1) {
#pragma unroll
        for (int jj = 0; jj < 4; ++jj)
#pragma unroll
            for (int i = 0; i < 4; ++i) { const float* wr = w8 + (size_t)(4 * lane + 256 * jj + i) * ldw8; const f32x4 a = *(const f32x4*)wr, b = *(const f32x4*)(wr + 4);
                wf[jj][i][0] = a[0]; wf[jj][i][1] = a[1]; wf[jj][i][2] = a[2]; wf[jj][i][3] = a[3]; wf[jj][i][4] = b[0]; wf[jj][i][5] = b[1]; wf[jj][i][6] = b[2]; wf[jj][i][7] = b[3]; }
    }
    int my_e = -1, my_row = 0, my_k = 0, nheld = 0; float my_g = 0.f;
    for (int row = gw; row < NTOK; row += NGW) {
        f32x4 v[4];
#pragma unroll
        for (int jj = 0; jj < 4; ++jj) v[jj] = ((const f32x4*)(xin + (size_t)row * DM))[64 * jj + lane];
        if (ycomb) {
#pragma unroll
            for (int jj = 0; jj < 4; ++jj) { const v2u a = ((const v2u*)(ycomb + (size_t)row * DM))[64 * jj + lane], b = ((const v2u*)(ycomb + ((size_t)NTOK + row) * DM))[64 * jj + lane];
                v[jj][0] += blo(a.x) + blo(b.x); v[jj][1] += bhi(a.x) + bhi(b.x); v[jj][2] += blo(a.y) + blo(b.y); v[jj][3] += bhi(a.y) + bhi(b.y); }
        }
        if (write_x) {
#pragma unroll
            for (int jj = 0; jj < 4; ++jj) ((f32x4*)(xout + (size_t)row * DM))[64 * jj + lane] = v[jj];
        }
        float ss = 0.f;
#pragma unroll
        for (int jj = 0; jj < 4; ++jj) ss += (v[jj][0] * v[jj][0] + v[jj][1] * v[jj][1]) + (v[jj][2] * v[jj][2] + v[jj][3] * v[jj][3]);
        const float r = __builtin_amdgcn_rsqf(wave_sum(ss) * (1.0f / DM) + EPS);
#pragma unroll
        for (int jj = 0; jj < 4; ++jj) { v[jj] = v[jj] * r * gv[jj]; v2u o; o.x = pk2(v[jj][0], v[jj][1]); o.y = pk2(v[jj][2], v[jj][3]); ((v2u*)(H + (size_t)row * DM))[64 * jj + lane] = o; }
        if (MODE != 1) {
            float fd[8];
#pragma unroll
            for (int j = 0; j < 8; ++j) { float s = 0.f;
#pragma unroll
                for (int jj = 0; jj < 4; ++jj)
#pragma unroll
                    for (int i = 0; i < 4; ++i) s += v[jj][i] * wf[jj][i][j];
                fd[j] = wave_sum(s); }
            if (MODE == 0) {
                float z = fd[0];
#pragma unroll
                for (int j = 1; j < 8; ++j) z = (lane == j) ? fd[j] : z;
                if (lane < 8) { z += b8[lane]; const float az = __builtin_fabsf(z);
                    const float ls = __builtin_fminf(z, 0.f) - __builtin_amdgcn_logf(1.0f + __builtin_amdgcn_exp2f(-LOG2E * az)) * 0.6931471805599453f;
                    LF[(size_t)row * 8 + lane] = ls; }
            } else {
                int i0 = 0; float v0 = fd[0];
#pragma unroll
                for (int j = 1; j < 8; ++j) if (fd[j] > v0) { v0 = fd[j]; i0 = j; }
                int i1 = -1; float v1 = -3.0e38f;
#pragma unroll
                for (int j = 0; j < 8; ++j) if (j != i0 && fd[j] > v1) { v1 = fd[j]; i1 = j; }
                const float g0 = __builtin_amdgcn_rcpf(1.0f + __builtin_amdgcn_exp2f(LOG2E * (v1 - v0))), g1 = 1.0f - g0;
                if (lane == 2 * nheld) { my_e = i0; my_g = g0; my_row = row; my_k = 0; }
                if (lane == 2 * nheld + 1) { my_e = i1; my_g = g1; my_row = row; my_k = 1; }
                ++nheld;
            }
        }
        if (MODE == 2 && (nheld == 32 || row + NGW >= NTOK)) {
            int pos = 0;
#pragma unroll
            for (int e = 0; e < 8; ++e) { const unsigned long long mk = __ballot(my_e == e);
                if (mk) { const int leader = __builtin_ctzll(mk); unsigned base = 0;
                    if (lane == leader) base = __hip_atomic_fetch_add(cnt + 64 * e, (unsigned)__builtin_popcountll(mk), RLX_AGENT);
                    base = __shfl(base, leader);
                    if (my_e == e) pos = (int)base + __builtin_popcountll(mk & ((1ull << lane) - 1ull)); } }
            if (my_e >= 0) { ASG[(size_t)(my_row * 2 + my_k) * 2] = (my_e << 24) | pos; ASG[(size_t)(my_row * 2 + my_k) * 2 + 1] = (int)__float_as_uint(my_g); }
            my_e = -1; nheld = 0;
        }
    }
}

constexpr int AT_KT = 0, AT_VT = 18432, AT_CK = 36864, AT_WT = 45056, AT_TS = 144;
__device__ __forceinline__ void attn_unit(LAS unsigned char* lds, int b, int h, int qb, const bf16_t* Qr, const bf16_t* Kr, const bf16_t* VT, const float* LF,
                                          const float* gq, const float* gk, bf16_t* O, int tid) {
    const int lane = tid & 63, wave = __builtin_amdgcn_readfirstlane(tid >> 6), r32 = lane & 31, hi = lane >> 5;
    const size_t rowbase = (size_t)b * SEQ;
    LAS float* CK = (LAS float*)(lds + AT_CK); LAS float* WT = (LAS float*)(lds + AT_WT);
    {
        float v0 = LF[(rowbase + 4 * tid + 0) * 8 + h], v1 = LF[(rowbase + 4 * tid + 1) * 8 + h], v2 = LF[(rowbase + 4 * tid + 2) * 8 + h], v3 = LF[(rowbase + 4 * tid + 3) * 8 + h];
        v1 += v0; v2 += v1; v3 += v2;
        float incl = v3;
#pragma unroll
        for (int o = 1; o < 64; o <<= 1) { const float n = __shfl_up(incl, o); if (lane >= o) incl += n; }
        if (lane == 63) WT[wave] = incl;
        __syncthreads();
        float base = 0.f;
        for (int w = 0; w < wave; ++w) base += WT[w];
        const float ex = base + incl - v3;
        *(LAS f32x4*)(CK + 4 * tid) = (f32x4){(ex + v0) * LOG2E, (ex + v1) * LOG2E, (ex + v2) * LOG2E, (ex + v3) * LOG2E};
        __syncthreads();
    }
    const int q_abs = qb * 256 + wave * 32 + r32;
    bf16x8 qf[4];
    {
        const bf16_t* qp = Qr + (rowbase + q_abs) * 512 + h * 64 + 8 * hi;
        v4u raw[4]; float ss = 0.f;
#pragma unroll
        for (int s = 0; s < 4; ++s) { raw[s] = *(const v4u*)(qp + 16 * s);
#pragma unroll
            for (int e = 0; e < 4; ++e) { const float a = blo(raw[s][e]), c = bhi(raw[s][e]); ss += a * a + c * c; } }
        ss += __shfl_xor(ss, 32);
        const float r = __builtin_amdgcn_rsqf(ss * (1.0f / 64.0f) + EPS) * (0.125f * LOG2E);
#pragma unroll
        for (int s = 0; s < 4; ++s) { const f32x4 g0 = *(const f32x4*)(gq + 16 * s + 8 * hi), g1 = *(const f32x4*)(gq + 16 * s + 8 * hi + 4); v4u o;
            o.x = pk2(blo(raw[s].x) * r * g0[0], bhi(raw[s].x) * r * g0[1]); o.y = pk2(blo(raw[s].y) * r * g0[2], bhi(raw[s].y) * r * g0[3]);
            o.z = pk2(blo(raw[s].z) * r * g1[0], bhi(raw[s].z) * r * g1[1]); o.w = pk2(blo(raw[s].w) * r * g1[2], bhi(raw[s].w) * r * g1[3]);
            qf[s] = __builtin_bit_cast(bf16x8, o); }
    }
    const float cq = CK[q_abs];
    const int NT = 4 * qb + 4;
    const int lkv = tid >> 3, lch = tid & 7;
    const bf16_t* kp = Kr + (rowbase + lkv) * 512 + h * 64 + 8 * lch;
    const bf16_t* vp = VT + (size_t)(h * 64 + lkv) * NTOK + rowbase + 8 * lch;
    const f32x4 gk0 = *(const f32x4*)(gk + 8 * lch), gk1 = *(const f32x4*)(gk + 8 * lch + 4);
    v4u kreg = *(const v4u*)kp, vreg = *(const v4u*)vp;
    f32x16 o0, o1;
#pragma unroll
    for (int i = 0; i < 16; ++i) { o0[i] = 0.f; o1[i] = 0.f; }
    float mrun = -1.0e30f, lrun = 0.f;
    const int qw_max = qb * 256 + wave * 32 + 31, qw_min = qb * 256 + wave * 32;
    for (int j = 0; j < NT; ++j) {
        const int buf = j & 1;
        {
            float f[8]; f[0] = blo(kreg.x); f[1] = bhi(kreg.x); f[2] = blo(kreg.y); f[3] = bhi(kreg.y); f[4] = blo(kreg.z); f[5] = bhi(kreg.z); f[6] = blo(kreg.w); f[7] = bhi(kreg.w);
            float ss = 0.f;
#pragma unroll
            for (int e = 0; e < 8; ++e) ss += f[e] * f[e];
            ss += __shfl_xor(ss, 1); ss += __shfl_xor(ss, 2); ss += __shfl_xor(ss, 4);
            const float r = __builtin_amdgcn_rsqf(ss * (1.0f / 64.0f) + EPS);
            v4u ko; ko.x = pk2(f[0] * r * gk0[0], f[1] * r * gk0[1]); ko.y = pk2(f[2] * r * gk0[2], f[3] * r * gk0[3]); ko.z = pk2(f[4] * r * gk1[0], f[5] * r * gk1[1]); ko.w = pk2(f[6] * r * gk1[2], f[7] * r * gk1[3]);
            *(LAS v4u*)(lds + AT_KT + buf * 9216 + lkv * AT_TS + lch * 16) = ko;
            *(LAS v4u*)(lds + AT_VT + buf * 9216 + lkv * AT_TS + lch * 16) = vreg;
        }
        __syncthreads();
        if (j + 1 < NT) { kreg = *(const v4u*)(kp + (size_t)(j + 1) * 64 * 512); vreg = *(const v4u*)(vp + (j + 1) * 64); }
        if (64 * j <= qw_max) {
            const LAS unsigned char* KT = lds + AT_KT + buf * 9216; const LAS unsigned char* VTL = lds + AT_VT + buf * 9216;
            f32x16 p0, p1;
#pragma unroll
            for (int i = 0; i < 16; ++i) { p0[i] = 0.f; p1[i] = 0.f; }
#pragma unroll
            for (int s = 0; s < 4; ++s) {
                const bf16x8 a0 = *(const LAS bf16x8*)(KT + r32 * AT_TS + (16 * s + 8 * hi) * 2);
                const bf16x8 a1 = *(const LAS bf16x8*)(KT + (32 + r32) * AT_TS + (16 * s + 8 * hi) * 2);
                p0 = MFMA32(a0, qf[s], p0); p1 = MFMA32(a1, qf[s], p1);
            }
            const int kvb = 64 * j;
#pragma unroll
            for (int g4 = 0; g4 < 4; ++g4) { const f32x4 c0 = *(const LAS f32x4*)(CK + kvb + 4 * hi + 8 * g4), c1 = *(const LAS f32x4*)(CK + kvb + 32 + 4 * hi + 8 * g4);
#pragma unroll
                for (int e = 0; e < 4; ++e) { p0[4 * g4 + e] += cq - c0[e]; p1[4 * g4 + e] += cq - c1[e]; } }
            if (kvb + 63 > qw_min) {
#pragma unroll
                for (int i = 0; i < 16; ++i) { const int kv = kvb + crow(i, hi); if (kv > q_abs) p0[i] = -1.0e30f; if (kv + 32 > q_abs) p1[i] = -1.0e30f; }
            }
            float mx = p0[0];
#pragma unroll
            for (int i = 1; i < 16; ++i) mx = __builtin_fmaxf(mx, p0[i]);
#pragma unroll
            for (int i = 0; i < 16; ++i) mx = __builtin_fmaxf(mx, p1[i]);
            mx = __builtin_fmaxf(mx, __shfl_xor(mx, 32));
            const float mnew = __builtin_fmaxf(mrun, mx), alpha = __builtin_amdgcn_exp2f(mrun - mnew); mrun = mnew;
            float ls = 0.f;
#pragma unroll
            for (int i = 0; i < 16; ++i) { p0[i] = __builtin_amdgcn_exp2f(p0[i] - mnew); p1[i] = __builtin_amdgcn_exp2f(p1[i] - mnew); ls += p0[i] + p1[i]; }
            lrun = lrun * alpha + ls;
#pragma unroll
            for (int i = 0; i < 16; ++i) { o0[i] *= alpha; o1[i] *= alpha; }
            bf16x8 pf[4];
            { v4u w;
              w.x = pk2(p0[0], p0[1]); w.y = pk2(p0[2], p0[3]); w.z = pk2(p0[4], p0[5]); w.w = pk2(p0[6], p0[7]); pf[0] = __builtin_bit_cast(bf16x8, w);
              w.x = pk2(p0[8], p0[9]); w.y = pk2(p0[10], p0[11]); w.z = pk2(p0[12], p0[13]); w.w = pk2(p0[14], p0[15]); pf[1] = __builtin_bit_cast(bf16x8, w);
              w.x = pk2(p1[0], p1[1]); w.y = pk2(p1[2], p1[3]); w.z = pk2(p1[4], p1[5]); w.w = pk2(p1[6], p1[7]); pf[2] = __builtin_bit_cast(bf16x8, w);
              w.x = pk2(p1[8], p1[9]); w.y = pk2(p1[10], p1[11]); w.z = pk2(p1[12], p1[13]); w.w = pk2(p1[14], p1[15]); pf[3] = __builtin_bit_cast(bf16x8, w); }
#pragma unroll
            for (int ks = 0; ks < 4; ++ks) {
                const v2u a0l = *(const LAS v2u*)(VTL + r32 * AT_TS + (16 * ks + 4 * hi) * 2), a0h = *(const LAS v2u*)(VTL + r32 * AT_TS + (16 * ks + 8 + 4 * hi) * 2);
                const v2u a1l = *(const LAS v2u*)(VTL + (32 + r32) * AT_TS + (16 * ks + 4 * hi) * 2), a1h = *(const LAS v2u*)(VTL + (32 + r32) * AT_TS + (16 * ks + 8 + 4 * hi) * 2);
                const v4u A0 = (v4u){a0l.x, a0l.y, a0h.x, a0h.y}, A1 = (v4u){a1l.x, a1l.y, a1h.x, a1h.y};
                o0 = MFMA32(__builtin_bit_cast(bf16x8, A0), pf[ks], o0); o1 = MFMA32(__builtin_bit_cast(bf16x8, A1), pf[ks], o1);
            }
        }
    }
    lrun += __shfl_xor(lrun, 32);
    const float inv = __builtin_amdgcn_rcpf(lrun);
    bf16_t* op = O + (rowbase + q_abs) * 512 + h * 64 + 4 * hi;
#pragma unroll
    for (int g4 = 0; g4 < 4; ++g4) {
        v2u w0, w1; w0.x = pk2(o0[4 * g4] * inv, o0[4 * g4 + 1] * inv); w0.y = pk2(o0[4 * g4 + 2] * inv, o0[4 * g4 + 3] * inv);
        w1.x = pk2(o1[4 * g4] * inv, o1[4 * g4 + 1] * inv); w1.y = pk2(o1[4 * g4 + 2] * inv, o1[4 * g4 + 3] * inv);
        *(v2u*)(op + 8 * g4) = w0; *(v2u*)(op + 32 + 8 * g4) = w1;
    }
    __syncthreads();
}

constexpr int SG_VT = 0, SG_VS = 272, SG_WB = 64 * 272, SG_PS = 8 * SG_WB;
__device__ __forceinline__ void sgu_unit(LAS unsigned char* lds, int chunk, const bf16_t* SUV, const float* gsgu, const bf16_t* Wsp, const float* bsp, bf16_t* O, int tid) {
    const int lane = tid & 63, g = __builtin_amdgcn_readfirstlane(tid >> 6), r32 = lane & 31, hi = lane >> 5;
    const size_t row0 = (size_t)chunk * 128;
    LAS float* PS = (LAS float*)(lds + SG_PS);
    LAS unsigned char* VTw = lds + SG_VT + g * SG_WB;
    const int c8 = lane & 7, rl = lane >> 3;
    v4u raw[16];
#pragma unroll
    for (int i = 0; i < 16; ++i) raw[i] = *(const v4u*)(SUV + (row0 + rl + 8 * i) * 1024 + 512 + g * 64 + 8 * c8);
#pragma unroll
    for (int i = 0; i < 16; ++i) { float ss = 0.f;
#pragma unroll
        for (int e = 0; e < 4; ++e) { const float a = blo(raw[i][e]), c = bhi(raw[i][e]); ss += a * a + c * c; }
        ss += __shfl_xor(ss, 1); ss += __shfl_xor(ss, 2); ss += __shfl_xor(ss, 4);
        if (c8 == 0) PS[(rl + 8 * i) * 8 + g] = ss; }
    __syncthreads();
    const f32x4 gs0 = *(const f32x4*)(gsgu + g * 64 + 8 * c8), gs1 = *(const f32x4*)(gsgu + g * 64 + 8 * c8 + 4);
#pragma unroll
    for (int i = 0; i < 16; ++i) { const int t = rl + 8 * i;
        const f32x4 pa = *(const LAS f32x4*)(PS + t * 8), pb = *(const LAS f32x4*)(PS + t * 8 + 4);
        const float r = __builtin_amdgcn_rsqf(((pa[0] + pa[1]) + (pa[2] + pa[3]) + (pb[0] + pb[1]) + (pb[2] + pb[3])) * (1.0f / 512.0f) + EPS);
        float f[8]; f[0] = blo(raw[i].x) * r * gs0[0]; f[1] = bhi(raw[i].x) * r * gs0[1]; f[2] = blo(raw[i].y) * r * gs0[2]; f[3] = bhi(raw[i].y) * r * gs0[3];
        f[4] = blo(raw[i].z) * r * gs1[0]; f[5] = bhi(raw[i].z) * r * gs1[1]; f[6] = blo(raw[i].w) * r * gs1[2]; f[7] = bhi(raw[i].w) * r * gs1[3];
#pragma unroll
        for (int e = 0; e < 8; ++e) *(LAS bf16_t*)(VTw + (8 * c8 + e) * SG_VS + t * 2) = f2bf(f[e]); }
    __syncthreads();
    const bf16_t* Wg = Wsp + (size_t)g * 128 * 128;
#pragma unroll 1
    for (int tb = 0; tb < 4; ++tb) {
        f32x16 a0, a1;
#pragma unroll
        for (int i = 0; i < 16; ++i) { a0[i] = 0.f; a1[i] = 0.f; }
        const int nks = 2 * (tb + 1);
        for (int ks = 0; ks < nks; ++ks) {
            const bf16x8 A = *(const bf16x8*)(Wg + (32 * tb + r32) * 128 + 16 * ks + 8 * hi);
            const bf16x8 B0 = *(const LAS bf16x8*)(VTw + r32 * SG_VS + (16 * ks + 8 * hi) * 2), B1 = *(const LAS bf16x8*)(VTw + (32 + r32) * SG_VS + (16 * ks + 8 * hi) * 2);
            a0 = MFMA32(A, B0, a0); a1 = MFMA32(A, B1, a1);
        }
#pragma unroll
        for (int i = 0; i < 16; ++i) { const int t = 32 * tb + crow(i, hi); const size_t row = row0 + t; const float bs = bsp[g * 128 + t];
            const float u0 = bf1(SUV[row * 1024 + g * 64 + r32]), u1 = bf1(SUV[row * 1024 + g * 64 + 32 + r32]);
            O[row * 512 + g * 64 + r32] = f2bf(u0 * (a0[i] + bs)); O[row * 512 + g * 64 + 32 + r32] = f2bf(u1 * (a1[i] + bs)); }
    }
    __syncthreads();
}

constexpr int CP_RS = 1040, CP_PS = 98304;
__device__ __forceinline__ void conv_unit(LAS unsigned char* lds, int tile, const bf16_t* CY, const float* wdw, const float* bdw, const float* gcv, bf16_t* Oc, int tid) {
    const int lane = tid & 63, wave = __builtin_amdgcn_readfirstlane(tid >> 6);
    const size_t row0 = (size_t)tile * 64; const int t0 = (tile * 64) % SEQ;
    LAS float* PS = (LAS float*)(lds + CP_PS);
    for (int idx = tid; idx < 94 * 64; idx += 512) { const int r = idx >> 6, ch = idx & 63; const int tt = t0 - 30 + r;
        v4u v = (v4u){0u, 0u, 0u, 0u}; if (tt >= 0) v = *(const v4u*)(CY + (row0 - 30 + r) * 512 + 8 * ch);
        *(LAS v4u*)(lds + r * CP_RS + ch * 16) = v; }
    float w[31];
#pragma unroll
    for (int j = 0; j < 31; ++j) w[j] = wdw[j * 512 + tid];
    const float bias = bdw[tid];
    __syncthreads();
#pragma unroll 1
    for (int tg = 0; tg < 8; ++tg) {
        float z8[8];
#pragma unroll
        for (int t = 0; t < 8; ++t) z8[t] = bias;
        const LAS unsigned char* col = lds + (8 * tg) * CP_RS + tid * 2;
        float yv[38];
#pragma unroll
        for (int i = 0; i < 38; ++i) yv[i] = bf1(*(const LAS bf16_t*)(col + i * CP_RS));
#pragma unroll
        for (int t = 0; t < 8; ++t)
#pragma unroll
            for (int j = 0; j < 31; ++j) z8[t] = __builtin_fmaf(w[j], yv[t + j], z8[t]);
#pragma unroll
        for (int t = 0; t < 8; ++t) *(LAS bf16_t*)(lds + (8 * tg + t) * CP_RS + tid * 2) = f2bf(z8[t]);
    }
    __syncthreads();
#pragma unroll
    for (int i = 0; i < 8; ++i) { const int t = 8 * wave + i; const v4u v = *(const LAS v4u*)(lds + t * CP_RS + lane * 16); float ss = 0.f;
#pragma unroll
        for (int e = 0; e < 4; ++e) { const float a = blo(v[e]), c = bhi(v[e]); ss += a * a + c * c; }
        ss = wave_sum(ss);
        if (lane == 0) PS[512 + t] = __builtin_amdgcn_rsqf(ss * (1.0f / 512.0f) + EPS); }
    __syncthreads();
    {
        const int ch8 = tid & 63, tr = tid >> 6;
        const f32x4 g0 = *(const f32x4*)(gcv + 8 * ch8), g1 = *(const f32x4*)(gcv + 8 * ch8 + 4);
#pragma unroll
        for (int i = 0; i < 8; ++i) { const int t = tr + 8 * i; const v4u v = *(const LAS v4u*)(lds + t * CP_RS + ch8 * 16); const float r = PS[512 + t];
            float f[8]; f[0] = blo(v.x) * r * g0[0]; f[1] = bhi(v.x) * r * g0[1]; f[2] = blo(v.y) * r * g0[2]; f[3] = bhi(v.y) * r * g0[3];
            f[4] = blo(v.z) * r * g1[0]; f[5] = bhi(v.z) * r * g1[1]; f[6] = blo(v.w) * r * g1[2]; f[7] = bhi(v.w) * r * g1[3];
#pragma unroll
            for (int e = 0; e < 8; ++e) f[e] *= sigm(f[e]);
            v4u o; o.x = pk2(f[0], f[1]); o.y = pk2(f[2], f[3]); o.z = pk2(f[4], f[5]); o.w = pk2(f[6], f[7]);
            *(v4u*)(Oc + (row0 + t) * 512 + 8 * ch8) = o; }
    }
    __syncthreads();
}
__device__ __forceinline__ void pool_unit(LAS unsigned char* lds, int tile, const bf16_t* PIN, const bf16_t* Wpg, const float* pls, bf16_t* Op, int tid) {
    const int lane = tid & 63, wave = __builtin_amdgcn_readfirstlane(tid >> 6), r32 = lane & 31, hi = lane >> 5;
    const size_t row0 = (size_t)tile * 64; const int t0 = (tile * 64) % SEQ;
    for (int idx = tid; idx < 79 * 64; idx += 512) { const int r = idx >> 6, ch = idx & 63; const int tt = t0 - 15 + r;
        v4u v = (v4u){0u, 0u, 0u, 0u}; if (tt >= 0) v = *(const v4u*)(PIN + (row0 - 15 + r) * 512 + 8 * ch);
        *(LAS v4u*)(lds + r * CP_RS + ch * 16) = v; }
    __syncthreads();
    {
        float pv[79];
#pragma unroll
        for (int i = 0; i < 79; ++i) pv[i] = bf1(*(const LAS bf16_t*)(lds + i * CP_RS + tid * 2));
        const bool first = (t0 == 0);
        const int wsel = wave >> 1;
#define POOL_W(W) { _Pragma("unroll") for (int t = 0; t < 64; ++t) { float s = 0.f; _Pragma("unroll") for (int j = 0; j < W; ++j) s += pv[t + 15 - j]; \
            const float inv = first ? (1.0f / (float)((t + 1) < W ? (t + 1) : W)) : (1.0f / (float)W); \
            *(LAS bf16_t*)(lds + t * CP_RS + tid * 2) = f2bf(s * inv - pv[t + 15]); } }
        if (wsel == 0) POOL_W(2) else if (wsel == 1) POOL_W(4) else if (wsel == 2) POOL_W(8) else POOL_W(16)
#undef POOL_W
    }
    __syncthreads();
    {
        const int g = wave >> 1, nh = wave & 1;
        f32x16 acc[2][2];
#pragma unroll
        for (int a = 0; a < 2; ++a)
#pragma unroll
            for (int c = 0; c < 2; ++c)
#pragma unroll
                for (int i = 0; i < 16; ++i) acc[a][c][i] = 0.f;
#pragma unroll
        for (int ks = 0; ks < 8; ++ks) {
            const bf16x8 A0 = *(const LAS bf16x8*)(lds + r32 * CP_RS + (g * 128 + 16 * ks + 8 * hi) * 2), A1 = *(const LAS bf16x8*)(lds + (32 + r32) * CP_RS + (g * 128 + 16 * ks + 8 * hi) * 2);
            const bf16x8 B0 = *(const bf16x8*)(Wpg + ((size_t)g * 128 + 64 * nh + r32) * 128 + 16 * ks + 8 * hi), B1 = *(const bf16x8*)(Wpg + ((size_t)g * 128 + 64 * nh + 32 + r32) * 128 + 16 * ks + 8 * hi);
            acc[0][0] = MFMA32(A0, B0, acc[0][0]); acc[0][1] = MFMA32(A0, B1, acc[0][1]); acc[1][0] = MFMA32(A1, B0, acc[1][0]); acc[1][1] = MFMA32(A1, B1, acc[1][1]);
        }
#pragma unroll
        for (int ct = 0; ct < 2; ++ct) { const int col = g * 128 + 64 * nh + 32 * ct + r32; const float sc = pls[col];
#pragma unroll
            for (int rt = 0; rt < 2; ++rt)
#pragma unroll
                for (int i = 0; i < 16; ++i) Op[(row0 + 32 * rt + crow(i, hi)) * 512 + col] = f2bf(acc[rt][ct][i] * sc); }
    }
    __syncthreads();
}

__device__ __forceinline__ void moe_offsets(const gu32* cnt, int (&pstart)[8], int (&tend)[8], int& T) {
    int acc = 0;
#pragma unroll
    for (int e = 0; e < 8; ++e) { const int c = (int)__hip_atomic_load(cnt + 64 * e, RLX_AGENT); pstart[e] = acc; acc += (c + 255) & ~255; tend[e] = acc >> 8; }
    T = acc >> 8;
}
__device__ __forceinline__ void moe_scatter(const gu32* cnt, const int* ASG, const bf16_t* H, bf16_t* XS, int* RINFO, int gw, int NGW, int lane, int tid, int blk, int nblk) {
    int pstart[8], tend[8], T; moe_offsets(cnt, pstart, tend, T);
    for (int e = blk; e < 8; e += nblk) { const int c = (int)__hip_atomic_load(cnt + 64 * e, RLX_AGENT); const int pe = (c + 255) & ~255;
        for (int r = c + tid; r < pe; r += 512) { RINFO[2 * (size_t)(pstart[e] + r)] = -1; RINFO[2 * (size_t)(pstart[e] + r) + 1] = 0; } }
    for (int a = gw; a < NTOK * 2; a += NGW) {
        const int w0 = ASG[2 * (size_t)a], gb = ASG[2 * (size_t)a + 1]; const int e = w0 >> 24, pos = w0 & 0xffffff;
        int ps = 0;
#pragma unroll
        for (int k = 0; k < 8; ++k) ps = (e == k) ? pstart[k] : ps;
        const size_t dest = (size_t)(ps + pos);
        if (lane == 0) { RINFO[2 * dest] = a; RINFO[2 * dest + 1] = gb; }
        const v4u* src = (const v4u*)(H + (size_t)(a >> 1) * DM); v4u* dst = (v4u*)(XS + dest * DM);
        dst[lane] = src[lane]; dst[64 + lane] = src[64 + lane];
    }
}
__device__ __forceinline__ void final_combine(float* xio, const bf16_t* Y, int gw, int NGW, int lane) {
    for (int row = gw; row < NTOK; row += NGW) {
#pragma unroll
        for (int jj = 0; jj < 4; ++jj) { f32x4 v = ((const f32x4*)(xio + (size_t)row * DM))[64 * jj + lane];
            const v2u a = ((const v2u*)(Y + (size_t)row * DM))[64 * jj + lane], b = ((const v2u*)(Y + ((size_t)NTOK + row) * DM))[64 * jj + lane];
            v[0] += blo(a.x) + blo(b.x); v[1] += bhi(a.x) + bhi(b.x); v[2] += blo(a.y) + blo(b.y); v[3] += bhi(a.y) + bhi(b.y);
            ((f32x4*)(xio + (size_t)row * DM))[64 * jj + lane] = v; }
    }
}
#define XB_TMO      128
#define XB_XCNT(j)  (256  + 64 * (j))
#define XB_XSUB(j)  (1280 + 64 * (j))
#define XB_XGEN(j)  (2304 + 64 * (j))
#define XB_TOP      3328
#define XB_TOPGEN   3392
#define XCD_BAR_WORDS 3456
#define XB_SPIN_CAP (1u << 18)

__device__ __forceinline__ unsigned xb_ld(unsigned* p)              { return __hip_atomic_load(p, __ATOMIC_RELAXED, __HIP_MEMORY_SCOPE_AGENT); }
__device__ __forceinline__ unsigned xb_add(unsigned* p, unsigned v) { return __hip_atomic_fetch_add(p, v, __ATOMIC_RELAXED, __HIP_MEMORY_SCOPE_AGENT); }
__device__ __forceinline__ unsigned xb_xcc_id() { return (unsigned)__builtin_amdgcn_s_getreg((3 << 11) | 20) & 0xFu; }
#define XB_SPIN(cond, bar) do { unsigned _sp = 0; while (cond) { __builtin_amdgcn_s_sleep(1); \
    if ((++_sp & 255u) == 0u) { if (xb_ld(&(bar)[XB_TMO])) break; if (_sp > XB_SPIN_CAP) { atomicAdd(&(bar)[XB_TMO], 1u); break; } } } } while (0)

struct XcdBarrier {
    unsigned* bar; unsigned x;
    volatile LAS unsigned* st;
};

__device__ __forceinline__ XcdBarrier xcd_barrier_post(unsigned* bar, volatile LAS unsigned* st) {
    XcdBarrier b; b.bar = bar; b.x = xb_xcc_id(); b.st = st;
    if (threadIdx.x == 0) (void)xb_add(&bar[XB_XCNT(b.x)], 1u);
    return b;
}
__device__ __forceinline__ void xcd_barrier_complete(unsigned* bar, unsigned x, unsigned& nloc, unsigned& nx) {
    const unsigned G = gridDim.x * gridDim.y * gridDim.z;
    unsigned sum, cnt, mine, sp = 0u;
    for (;;) {
        sum = 0u; cnt = 0u; mine = 0u;
#pragma unroll
        for (unsigned j = 0; j < 16; ++j) { const unsigned c = xb_ld(&bar[XB_XCNT(j)]); sum += c; cnt += (c > 0u) ? 1u : 0u; mine = (j == x) ? c : mine; }
        if (sum == G) break;
        __builtin_amdgcn_s_sleep(1);
        if ((++sp & 255u) == 0u) { if (xb_ld(&bar[XB_TMO])) break; if (sp > XB_SPIN_CAP) { atomicAdd(&bar[XB_TMO], 1u); break; } }
    }
    nloc = mine > 0u ? mine : 1u; nx = cnt > 0u ? cnt : 1u;
}

__device__ __forceinline__ void xcd_barrier(const XcdBarrier& b) {
    asm volatile("s_waitcnt vmcnt(0)" ::: "memory");
    __syncthreads();
    if (threadIdx.x == 0) {
        unsigned* bar = b.bar;
        __builtin_amdgcn_s_waitcnt(0);
        unsigned nloc = b.st[0], nx = b.st[1];
        if (nloc == 0u) { xcd_barrier_complete(bar, b.x, nloc, nx); b.st[0] = nloc; b.st[1] = nx; }
        const unsigned old = xb_add(&bar[XB_XSUB(b.x)], 1u);
        const unsigned gen = old / nloc;
        if (old + 1u == (gen + 1u) * nloc) {
            __builtin_amdgcn_fence(__ATOMIC_RELEASE, "agent");
            asm volatile("s_waitcnt vmcnt(0)" ::: "memory");
            const unsigned og = xb_add(&bar[XB_TOP], 1u);
            const unsigned tg = og / nx;
            if (og + 1u == (tg + 1u) * nx) xb_add(&bar[XB_TOPGEN], 1u);
            else XB_SPIN(xb_ld(&bar[XB_TOPGEN]) == tg, bar);
            __builtin_amdgcn_fence(__ATOMIC_ACQUIRE, "agent");
            xb_add(&bar[XB_XGEN(b.x)], 1u);
            asm volatile("s_waitcnt vmcnt(0)" ::: "memory");
        } else {
            XB_SPIN(xb_ld(&bar[XB_XGEN(b.x)]) == gen, bar);
            __builtin_amdgcn_fence(__ATOMIC_ACQUIRE, "agent");
            asm volatile("s_waitcnt vmcnt(0)" ::: "memory");
        }
    }
    __syncthreads();
}


struct Args {
    const float* in[25]; float* out; unsigned char* ws; int pad0, pad1;
};
typedef const Args __attribute__((address_space(4)))* KArgs;
enum { I_X = 0, I_GMIX, I_WIN, I_BF, I_GQ, I_GK, I_GSGU, I_WSP, I_BSP, I_WDW, I_BDW, I_GCONV, I_WPOOL, I_PSCALE, I_WBR, I_BGATE, I_WOUT, I_GFFN,
       I_WFG, I_WFU, I_WFD, I_WROUTER, I_WEG, I_WEU, I_WED };
__device__ __forceinline__ int opaque_v(int v) { asm volatile("" : "+v"(v)); return v; }
__device__ __forceinline__ KArgs kargs() { KArgs p = (KArgs)__builtin_amdgcn_kernarg_segment_ptr(); asm volatile("" : "+s"(p)); return p; }

#ifndef MK_ONLY
#define MK_ONLY -1
#endif
#define PH(n) (MK_ONLY < 0 || MK_ONLY == (n))
#ifndef MK_DUP
#define MK_DUP -1
#endif
#define DUP(n) for (int rep_ = 0; rep_ < ((MK_DUP == (n)) ? 2 : 1); ++rep_)

__global__ void __launch_bounds__(NWAVES * 64, 2) fwd_kernel(Args args_unused) {
    extern __shared__ __attribute__((aligned(16))) unsigned char lds_raw[];
    LAS unsigned char* lds = (LAS unsigned char*)lds_raw;
    const int tid = threadIdx.x, lane = tid & 63, wave = __builtin_amdgcn_readfirstlane(tid >> 6);
    const int G = gridDim.x, bx = blockIdx.x;
    const int gw = bx * NWAVES + wave, NGW = G * NWAVES;
    volatile LAS unsigned* MISC = (volatile LAS unsigned*)(lds + MISC_OFF);
    for (int u = tid; u < 64; u += NWAVES * 64) ((LAS unsigned*)(lds + MISC_OFF))[u] = 0u;
    __syncthreads();
    XcdBarrier bar;
    { KArgs ka = kargs(); bar = xcd_barrier_post((unsigned*)(ka->ws + WS_CTL) + CW_BAR, MISC + 8); }
#define GRID_BAR() do { XcdBarrier b_ = bar; asm volatile("" : "+s"(b_.bar), "+s"(b_.x)); xcd_barrier(b_); } while (0)
    LAS float* scr = (LAS float*)(lds + wave * 16384);

    for (int l = 0; l < NLAYER; ++l) {
        const bool moe = (l & 1) != 0; const int fi = l >> 1;
        if (PH(1)) {
            KArgs ka = kargs(); unsigned char* ws = ka->ws; float* xout = ka->out; const int lane = opaque_v(tid) & 63;
            bf16_t* Wproj = (bf16_t*)(ws + WM_PROJ);
            int off = 0;
            const float* win = ka->in[I_WIN] + (size_t)l * DM * INW;
            DUP(12) {
            tr_segment(win, INW, DM, C_Q, 512, Wproj, 0, 0, scr, gw, NGW, lane, off);
            tr_segment(win, INW, DM, C_K, 512, Wproj, 512, 0, scr, gw, NGW, lane, off);
            tr_segment(win, INW, DM, C_V, 512, (bf16_t*)(ws + WM_V), 0, 0, scr, gw, NGW, lane, off);
            tr_segment(win, INW, DM, C_SU, 1024, Wproj, 1024, 0, scr, gw, NGW, lane, off);
            tr_segment(win, INW, DM, C_CONV, 512, Wproj, 2048, 128, scr, gw, NGW, lane, off);
            tr_segment(win, INW, DM, C_CONV + 512, 512, Wproj, 2048 + 128, 128, scr, gw, NGW, lane, off);
            tr_segment(win, INW, DM, C_POOL, 512, Wproj, 3072, 0, scr, gw, NGW, lane, off);
            tr_segment(win, INW, DM, C_GATE, 4096, Wproj, 3584, 0, scr, gw, NGW, lane, off);
            for (int i = 0; i < 4; ++i) tr_segment(ka->in[I_WBR] + ((size_t)l * 4 + i) * 512 * 1024, 1024, 512, 0, 1024, (bf16_t*)(ws + WM_B) + (size_t)i * 1024 * 512, 0, 0, scr, gw, NGW, lane, off);
            tr_segment(ka->in[I_WOUT] + (size_t)l * 1024 * 1024, 1024, 1024, 0, 1024, (bf16_t*)(ws + WM_OUT), 0, 0, scr, gw, NGW, lane, off);
            for (int g = 0; g < 4; ++g) tr_segment(ka->in[I_WPOOL] + ((size_t)l * 4 + g) * 128 * 128, 128, 128, 0, 128, (bf16_t*)(ws + WM_PG) + (size_t)g * 128 * 128, 0, 0, scr, gw, NGW, lane, off);
            { const float* wsp = ka->in[I_WSP] + (size_t)l * 8 * 128 * 128; bf16_t* Wsp = (bf16_t*)(ws + WM_SP);
              for (int i = bx * 512 + opaque_v(tid); i < 8 * 128 * 128; i += G * 512) { const int t = (i >> 7) & 127, s = i & 127; Wsp[i] = (s <= t) ? f2bf(wsp[i]) : (bf16_t)0; } }
            }
            const float* xin = (l == 0) ? ka->in[I_X] : xout;
            const bf16_t* yc = (l > 0 && ((l - 1) & 1)) ? (const bf16_t*)(ws + WS_XS) : nullptr;
            for (int rep_ = 0; rep_ < ((MK_DUP == 13 && yc == nullptr) ? 2 : 1); ++rep_) norm_rows<0>(xin, xout, yc != nullptr, yc, ka->in[I_GMIX] + l * DM, (bf16_t*)(ws + WS_H), win + C_F, INW, ka->in[I_BF] + l * 8, (float*)(ws + WS_LF), nullptr, nullptr, gw, NGW, lane);
        }
        GRID_BAR();
        DUP(2) if (PH(2)) {
            KArgs ka = kargs(); unsigned char* ws = ka->ws;
            pg8::Gemm g{(bf16_t*)(ws + WS_H), (bf16_t*)(ws + WM_PROJ), NTOK, NPROJ, DM}; pg8::StaticOrder S; S.init(NTOK, NPROJ, G, bx);
            pg8::EpiProj E{ws, ka->in[I_BGATE] + (size_t)l * 4096, WS_Q, WS_K, WS_SUV, WS_CY, WS_PIN, WS_G};
            pg8::gemm_phase<pg8::EpiProj, pg8::StaticOrder, true, true>(lds, g, S, E);
        }
        DUP(2) if (PH(2)) {
            KArgs ka = kargs(); unsigned char* ws = ka->ws;
            pg8::Gemm g2{(bf16_t*)(ws + WM_V), (bf16_t*)(ws + WS_H), 512, NTOK, DM}; pg8::StaticOrder S2; S2.init(512, NTOK, G, bx);
            pg8::EpiBf16<0> E2{(bf16_t*)(ws + WS_VT), NTOK, nullptr, 0, 0, 1.f};
            pg8::gemm_phase<pg8::EpiBf16<0>, pg8::StaticOrder, true, true>(lds, g2, S2, E2);
        }
        GRID_BAR();
        DUP(3) if (PH(3)) {
#ifndef MK_NO_ATTN
            DUP(31) for (int i = 0;; ++i) {
                int bh, qb;
                if (G == 256) { if (i >= 4) break; bh = bx >> 1; const int s = (bx & 1); qb = (i == 0) ? s : (i == 1) ? 7 - s : (i == 2) ? 2 + s : 5 - s; }
                else { const int u = i * G + bx; if (u >= 1024) break; bh = u >> 3; qb = u & 7; }
                KArgs ka = kargs(); unsigned char* ws = ka->ws;
                attn_unit(lds, bh >> 3, bh & 7, qb, (const bf16_t*)(ws + WS_Q), (const bf16_t*)(ws + WS_K), (const bf16_t*)(ws + WS_VT), (const float*)(ws + WS_LF),
                          ka->in[I_GQ] + l * 64, ka->in[I_GK] + l * 64, (bf16_t*)(ws + WS_YS), opaque_v(tid));
            }
#endif
#ifndef MK_NO_SGU
            DUP(32) for (int c = bx; c < 256; c += G) {
                KArgs ka = kargs(); unsigned char* ws = ka->ws;
                sgu_unit(lds, c, (const bf16_t*)(ws + WS_SUV), ka->in[I_GSGU] + l * 512, (const bf16_t*)(ws + WM_SP), ka->in[I_BSP] + l * 8 * 128, (bf16_t*)(ws + WS_YS) + (size_t)NTOK * 512, opaque_v(tid));
            }
#endif
#ifndef MK_NO_CONV
            DUP(33) for (int t = bx; t < 512; t += G) {
                KArgs ka = kargs(); unsigned char* ws = ka->ws;
                conv_unit(lds, t, (const bf16_t*)(ws + WS_CY), ka->in[I_WDW] + (size_t)l * 31 * 512, ka->in[I_BDW] + l * 512, ka->in[I_GCONV] + l * 512, (bf16_t*)(ws + WS_YS) + (size_t)2 * NTOK * 512, opaque_v(tid));
                pool_unit(lds, t, (const bf16_t*)(ws + WS_PIN), (const bf16_t*)(ws + WM_PG), ka->in[I_PSCALE] + l * 512, (bf16_t*)(ws + WS_YS) + (size_t)3 * NTOK * 512, opaque_v(tid));
            }
#endif
        }
        GRID_BAR();
        DUP(4) if (PH(4)) {
            KArgs ka = kargs(); unsigned char* ws = ka->ws;
            pg8::Gemm g{(bf16_t*)(ws + WS_YS), (bf16_t*)(ws + WM_B), 4 * NTOK, 4096, 512}; pg8::MergeOrder S{G, bx};
            pg8::EpiMerge E{(bf16_t*)(ws + WS_G), (bf16_t*)(ws + WS_MG)};
            pg8::gemm_phase<pg8::EpiMerge, pg8::MergeOrder, true, true>(lds, g, S, E);
        }
        GRID_BAR();
        if (PH(5)) {
            KArgs ka = kargs(); unsigned char* ws = ka->ws; float* xout = ka->out;
            pg8::Gemm g{(bf16_t*)(ws + WS_MG), (bf16_t*)(ws + WM_OUT), NTOK, DM, DM}; pg8::StaticOrder S; S.init(NTOK, DM, G, bx);
            pg8::EpiResid E{(l == 0) ? ka->in[I_X] : xout, xout};
            pg8::gemm_phase<pg8::EpiResid, pg8::StaticOrder, true, true>(lds, g, S, E);
        }
        GRID_BAR();
        if (PH(6)) {
            KArgs ka = kargs(); unsigned char* ws = ka->ws; float* xout = ka->out; const int lane = opaque_v(tid) & 63;
            bf16_t* Wgu = (bf16_t*)(ws + WF_GU);
            int off = 0;
            DUP(14) if (!moe) {
                tr_segment(ka->in[I_WFG] + (size_t)fi * DM * FFD, FFD, DM, 0, FFD, Wgu, 0, 128, scr, gw, NGW, lane, off);
                tr_segment(ka->in[I_WFU] + (size_t)fi * DM * FFD, FFD, DM, 0, FFD, Wgu, 128, 128, scr, gw, NGW, lane, off);
                tr_segment(ka->in[I_WFD] + (size_t)fi * FFD * DM, DM, FFD, 0, DM, (bf16_t*)(ws + WF_D_DENSE), 0, 0, scr, gw, NGW, lane, off);
            } else {
                for (int e = 0; e < NEXP; ++e) {
                    tr_segment(ka->in[I_WEG] + ((size_t)fi * NEXP + e) * DM * FFE, FFE, DM, 0, FFE, Wgu + (size_t)e * 2 * FFE * DM, 0, 128, scr, gw, NGW, lane, off);
                    tr_segment(ka->in[I_WEU] + ((size_t)fi * NEXP + e) * DM * FFE, FFE, DM, 0, FFE, Wgu + (size_t)e * 2 * FFE * DM, 128, 128, scr, gw, NGW, lane, off);
                    tr_segment(ka->in[I_WED] + ((size_t)fi * NEXP + e) * FFE * DM, DM, FFE, 0, DM, (bf16_t*)(ws + WF_D_MOE) + (size_t)e * DM * FFE, 0, 0, scr, gw, NGW, lane, off);
                }
            }
            DUP(15) if (!moe) norm_rows<1>(xout, xout, false, nullptr, ka->in[I_GFFN] + l * DM, (bf16_t*)(ws + WS_H), nullptr, 0, nullptr, nullptr, nullptr, nullptr, gw, NGW, lane);
            else norm_rows<2>(xout, xout, false, nullptr, ka->in[I_GFFN] + l * DM, (bf16_t*)(ws + WS_H), ka->in[I_WROUTER] + (size_t)fi * DM * 8, 8, nullptr, nullptr, (int*)(ws + WS_ASG),
                             (gu32*)(ws + WS_CTL) + CW_CNT + fi * 1024, gw, NGW, lane);
        }
        GRID_BAR();
        if (!moe) {
            DUP(7) if (PH(7)) {
                KArgs ka = kargs(); unsigned char* ws = ka->ws;
                pg8::Gemm g{(bf16_t*)(ws + WS_H), (bf16_t*)(ws + WF_GU), NTOK, 2 * FFD, DM}; pg8::StaticOrder S; S.init(NTOK, 2 * FFD, G, bx);
                pg8::EpiSwiglu E{(bf16_t*)(ws + WS_ACT), FFD, 2 * FFD / 256};
                pg8::gemm_phase<pg8::EpiSwiglu, pg8::StaticOrder, true, true>(lds, g, S, E);
            }
            GRID_BAR();
            if (PH(8)) {
                KArgs ka = kargs(); unsigned char* ws = ka->ws; float* xout = ka->out;
                pg8::Gemm g{(bf16_t*)(ws + WS_ACT), (bf16_t*)(ws + WF_D_DENSE), NTOK, DM, FFD}; pg8::StaticOrder S; S.init(NTOK, DM, G, bx);
                pg8::EpiResid E{xout, xout};
                pg8::gemm_phase<pg8::EpiResid, pg8::StaticOrder, true, true>(lds, g, S, E);
            }
            GRID_BAR();
        } else {
            DUP(9) if (PH(9)) {
                KArgs ka = kargs(); unsigned char* ws = ka->ws;
                { const int t_ = opaque_v(tid); moe_scatter((gu32*)(ws + WS_CTL) + CW_CNT + fi * 1024, (const int*)(ws + WS_ASG), (const bf16_t*)(ws + WS_H), (bf16_t*)(ws + WS_XS), (int*)(ws + WS_RINFO), gw, NGW, t_ & 63, t_, bx, G); }
            }
            GRID_BAR();
            DUP(10) if (PH(10)) {
                KArgs ka = kargs(); unsigned char* ws = ka->ws;
                pg8::GroupedOrder S; S.G = G; S.c = bx; S.nct = 2 * FFE / 256; { int ps[8]; moe_offsets((gu32*)(ws + WS_CTL) + CW_CNT + fi * 1024, ps, S.tend, S.T); }
                pg8::Gemm g{(bf16_t*)(ws + WS_XS), (bf16_t*)(ws + WF_GU), PMAX, NEXP * 2 * FFE, DM};
                pg8::EpiSwiglu E{(bf16_t*)(ws + WS_ACT), FFE, 2 * FFE / 256};
                pg8::gemm_phase<pg8::EpiSwiglu, pg8::GroupedOrder, true, true>(lds, g, S, E);
            }
            GRID_BAR();
            DUP(11) if (PH(11)) {
                KArgs ka = kargs(); unsigned char* ws = ka->ws;
                pg8::GroupedOrder S; S.G = G; S.c = bx; S.nct = 4; { int ps[8]; moe_offsets((gu32*)(ws + WS_CTL) + CW_CNT + fi * 1024, ps, S.tend, S.T); }
                pg8::Gemm g{(bf16_t*)(ws + WS_ACT), (bf16_t*)(ws + WF_D_MOE), PMAX, NEXP * DM, FFE};
                pg8::EpiDownMoe E{(const int*)(ws + WS_RINFO), (bf16_t*)(ws + WS_XS)};
                pg8::gemm_phase<pg8::EpiDownMoe, pg8::GroupedOrder, true, true>(lds, g, S, E);
            }
            GRID_BAR();
        }
    }
    { KArgs ka = kargs(); final_combine(ka->out, (const bf16_t*)(ka->ws + WS_XS), gw, NGW, opaque_v(tid) & 63); }
}

extern "C" void kernel_launch(void* const* d_in, const int* in_sizes, int n_in, void* d_out, int out_size, void* d_ws, size_t ws_size, hipStream_t stream) {
    static int grid = 0;
    if (grid == 0) {
        if (n_in != 25 || in_sizes[0] != NTOK * DM || out_size != NTOK * DM || ws_size < WS_END) {
            fprintf(stderr, "kernel_launch: unexpected shapes / workspace (n_in %d, in0 %d, out %d, ws %zu < %zu)\n", n_in, n_in > 0 ? in_sizes[0] : -1, out_size, ws_size, (size_t)WS_END); grid = -1; return; }
        int dev = 0, cus = 0, per_cu = 0;
        if (hipGetDevice(&dev) != hipSuccess || hipDeviceGetAttribute(&cus, hipDeviceAttributeMultiprocessorCount, dev) != hipSuccess) { grid = -1; return; }
        if (hipFuncSetAttribute((const void*)fwd_kernel, hipFuncAttributeMaxDynamicSharedMemorySize, LDS_BYTES) != hipSuccess) { fprintf(stderr, "kernel_launch: hipFuncSetAttribute failed\n"); grid = -1; return; }
        if (hipOccupancyMaxActiveBlocksPerMultiprocessor(&per_cu, (const void*)fwd_kernel, NWAVES * 64, LDS_BYTES) != hipSuccess || per_cu < 1) { fprintf(stderr, "kernel_launch: occupancy query reports %d\n", per_cu); }
        (void)hipGetLastError();
        grid = cus;
    }
    if (grid < 0) return;
    if (hipMemsetAsync((char*)d_ws + WS_CTL, 0, CTL_ZERO_BYTES, stream) != hipSuccess) return;
    Args a{};
    for (int i = 0; i < 25; ++i) a.in[i] = (const float*)d_in[i];
    a.out = (float*)d_out; a.ws = (unsigned char*)d_ws;
    hipLaunchKernelGGL(fwd_kernel, dim3(grid), dim3(NWAVES * 64), LDS_BYTES, stream, a);
}
```

```cpp
#include <hip/hip_runtime.h>
#include <cstdio>
#include <cstdint>
#define F8_MASK 0xA
namespace pg8 {
#define PG8_LAS __attribute__((address_space(3)))
typedef unsigned short bf16_t;
typedef short bf16x8 __attribute__((ext_vector_type(8)));
typedef float f32x4 __attribute__((ext_vector_type(4)));
typedef unsigned u32x4 __attribute__((ext_vector_type(4)));
constexpr int BM = 256, BK = 64, HALF = 128, HTB = HALF * BK * 2  , STAGE_BYTES = 8 * HTB, NXCD = 8, WGM = 8;

__host__ __device__ __forceinline__ int lds_byte(int r, int c) { const int st = (r >> 4) * 2 + (c >> 5), rr = r & 15, cc = c & 31, ob = rr * 64 + cc * 2; return st * 1024 + (ob ^ (((ob >> 9) & 1) << 5)); }
__host__ __device__ __forceinline__ void stage_rc(int b, int& R, int& C) { const int st = b / 1024, sb = b % 1024, swz = sb ^ (((sb >> 9) & 1) << 5); R = (st >> 1) * 16 + swz / 64; C = (st & 1) * 32 + (swz % 64) / 2; }
__host__ __device__ __forceinline__ int perm32(int rho) { const int n = rho >> 4, i = rho & 15; return 8 * (i >> 2) + 4 * n + (i & 3); }

struct Unit { int pm, pn; };
struct Gemm { const bf16_t* A; const bf16_t* Bt; int M, N, K; };

struct StaticOrder {
    int nM, nN, nwg, G, c;
    __host__ __device__ void init(int M, int N, int G_, int c_) { nM = M / BM; nN = N / BM; nwg = nM * nN; G = G_; c = c_; }
    __host__ __device__ bool next(int i, Unit& u) const {
        const long L = (long)i * G + c; if (L >= nwg) return false;
        int wgid = (int)L; { const int q = nwg / NXCD, r = nwg % NXCD, xcd = wgid % NXCD, off = wgid / NXCD; wgid = (xcd < r ? xcd * (q + 1) : r * (q + 1) + (xcd - r) * q) + off; }
        const int nig = WGM * nN, gid = wgid / nig, fm = gid * WGM, gsz = (nM - fm) < WGM ? (nM - fm) : WGM;
        u.pm = fm + ((wgid % nig) % gsz); u.pn = (wgid % nig) / gsz; return true;
    }
    __device__ __forceinline__ void a_ready(const Unit&) const {}
    __device__ __forceinline__ void done(const Unit&) const {}
};

__device__ __forceinline__ unsigned cvt_pk_bf16(float lo, float hi) { unsigned r; asm volatile("v_cvt_pk_bf16_f32 %0, %1, %2" : "=v"(r) : "v"(lo), "v"(hi)); return r; }
typedef float f32x2 __attribute__((ext_vector_type(2)));
__device__ __forceinline__ f32x2 gelu_pk(f32x2 v) {
    const f32x2 av = __builtin_elementwise_abs(v), d = av * 0.2316418882f + 1.0f;
    f32x2 t; t.x = __builtin_amdgcn_rcpf(d.x); t.y = __builtin_amdgcn_rcpf(d.y);
    f32x2 q = t * 0.5307027145f + (-0.7265760135f); q = q * t + 0.7107068705f; q = q * t + (-0.142248368f); q = q * t + 0.127414796f; q = q * t;
    const f32x2 s = (v * v) * (-0.72134752044f);
    f32x2 e; e.x = __builtin_amdgcn_exp2f(s.x); e.y = __builtin_amdgcn_exp2f(s.y);
    const f32x2 m = v * (q * e), r = v - m;
    f32x2 o; o.x = v.x < 0.f ? m.x : r.x; o.y = v.y < 0.f ? m.y : r.y; return o;
}

template <int ACT  > struct EpiBf16 {
    static constexpr bool PERM = true, AFTER_DRAIN = false; static_assert(ACT == 0 || ACT == 1, "EpiBf16: ACT is 0 (none) or 1 (gelu_pk)");
    bf16_t* O; int ldc; const float* bias; int split_cols; size_t split_stride; float scale0;
    __device__ __forceinline__ void operator()(const f32x4 (&acc)[2][2][4][2], const Unit& u, int wr, int wc, int fr, int fq) const {
        const int row0 = u.pm * BM + wr * 64 + fr; int colt = u.pn * BM; bf16_t* base = O;
        float sc = 1.f; if (split_cols) { const int t = colt / split_cols; base += (size_t)t * split_stride; colt -= t * split_cols; if (t == 0) sc = scale0; }
        const int col0 = colt + wc * 32 + 8 * fq, bcol0 = u.pn * BM + wc * 32 + 8 * fq;
        f32x4 bv[2][2];
#pragma unroll
        for (int bj = 0; bj < 2; ++bj)
#pragma unroll
            for (int n = 0; n < 2; ++n) bv[bj][n] = bias ? *(const f32x4*)(bias + bcol0 + bj * HALF + 4 * n) : (f32x4){0.f, 0.f, 0.f, 0.f};
#pragma unroll
        for (int ai = 0; ai < 2; ++ai)
#pragma unroll
            for (int m = 0; m < 4; ++m) { bf16_t* rowp = base + (size_t)(row0 + ai * HALF + m * 16) * ldc + col0;
#pragma unroll
                for (int bj = 0; bj < 2; ++bj) { f32x4 v0 = acc[ai][bj][m][0] + bv[bj][0], v1 = acc[ai][bj][m][1] + bv[bj][1];
                    if (ACT == 1) { f32x2 a = gelu_pk((f32x2){v0[0], v0[1]}), b = gelu_pk((f32x2){v0[2], v0[3]}), c = gelu_pk((f32x2){v1[0], v1[1]}), d = gelu_pk((f32x2){v1[2], v1[3]});
                        v0 = (f32x4){a.x, a.y, b.x, b.y}; v1 = (f32x4){c.x, c.y, d.x, d.y}; }
                    v0 = v0 * sc; v1 = v1 * sc; u32x4 w; w.x = cvt_pk_bf16(v0[0], v0[1]); w.y = cvt_pk_bf16(v0[2], v0[3]); w.z = cvt_pk_bf16(v1[0], v1[1]); w.w = cvt_pk_bf16(v1[2], v1[3]);
                    *(u32x4*)(rowp + bj * HALF) = w; } }
    }
};


typedef unsigned u32x2 __attribute__((ext_vector_type(2)));
typedef int i32x8 __attribute__((ext_vector_type(8))); typedef int i32x4 __attribute__((ext_vector_type(4)));
__device__ __forceinline__ i32x8 cat8(bf16x8 a, bf16x8 b) { const i32x4 x = __builtin_bit_cast(i32x4, a), y = __builtin_bit_cast(i32x4, b); return __builtin_shufflevector(x, y, 0, 1, 2, 3, 4, 5, 6, 7); }
__device__ __forceinline__ unsigned pk4_fp8(float a, float b, float c, float d) {
    a = __builtin_fminf(__builtin_fmaxf(a, -448.f), 448.f); b = __builtin_fminf(__builtin_fmaxf(b, -448.f), 448.f); c = __builtin_fminf(__builtin_fmaxf(c, -448.f), 448.f); d = __builtin_fminf(__builtin_fmaxf(d, -448.f), 448.f);
    int w = 0; w = __builtin_amdgcn_cvt_pk_fp8_f32(a, b, w, false); w = __builtin_amdgcn_cvt_pk_fp8_f32(c, d, w, true); return (unsigned)w; }
__device__ __forceinline__ float fast_sigmoid(float x) { return __builtin_amdgcn_rcpf(1.0f + __builtin_amdgcn_exp2f(-1.4426950408889634f * x)); }
__device__ __forceinline__ float gelu_tanh(float x) {
    const float a = 1.5957691216057308f * (x + 0.044715f * x * x * x);
    return x * fast_sigmoid(a);
}
__device__ __forceinline__ float bf_lo(unsigned w) { return __uint_as_float(w << 16); }
__device__ __forceinline__ float bf_hi(unsigned w) { return __uint_as_float(w & 0xffff0000u); }
__device__ __forceinline__ u32x4 pack8(f32x4 v0, f32x4 v1) { u32x4 w; w.x = cvt_pk_bf16(v0[0], v0[1]); w.y = cvt_pk_bf16(v0[2], v0[3]); w.z = cvt_pk_bf16(v1[0], v1[1]); w.w = cvt_pk_bf16(v1[2], v1[3]); return w; }

struct EpiProj {
    static constexpr bool PERM = true, AFTER_DRAIN = false;
    unsigned char* ws; const float* bgate; size_t oQ, oK, oSUV, oCY, oPIN, oG;
    __device__ __forceinline__ void operator()(const f32x4 (&acc)[2][2][4][2], const Unit& u, int wr, int wc, int fr, int fq) const {
        const int row0 = u.pm * BM + wr * 64 + fr; const int pn = u.pn; const int cw = wc * 32 + 8 * fq;
        if (pn >= 8 && pn < 12) {
            bf16_t* base = (bf16_t*)(ws + oCY) + (pn - 8) * HALF + cw;
#pragma unroll
            for (int ai = 0; ai < 2; ++ai)
#pragma unroll
                for (int m = 0; m < 4; ++m) { bf16_t* rowp = base + (size_t)(row0 + ai * HALF + m * 16) * 512;
                    f32x4 v0 = acc[ai][0][m][0], v1 = acc[ai][0][m][1]; const f32x4 g0 = acc[ai][1][m][0], g1 = acc[ai][1][m][1];
#pragma unroll
                    for (int e = 0; e < 4; ++e) { v0[e] *= fast_sigmoid(g0[e]); v1[e] *= fast_sigmoid(g1[e]); }
                    *(u32x4*)rowp = pack8(v0, v1); }
        } else {
            size_t boff; int ld, colt, kind;
            if (pn < 2) { boff = oQ; ld = 512; colt = pn * BM; kind = 0; }
            else if (pn < 4) { boff = oK; ld = 512; colt = (pn - 2) * BM; kind = 0; }
            else if (pn < 8) { boff = oSUV; ld = 1024; colt = (pn - 4) * BM; kind = 1; }
            else if (pn < 14) { boff = oPIN; ld = 512; colt = (pn - 12) * BM; kind = 0; }
            else { boff = oG; ld = 4096; colt = (pn - 14) * BM; kind = 2; }
            bf16_t* base = (bf16_t*)(ws + boff) + colt + cw;
            f32x4 bv[2][2];
#pragma unroll
            for (int bj = 0; bj < 2; ++bj)
#pragma unroll
                for (int n = 0; n < 2; ++n) bv[bj][n] = (kind == 2) ? *(const f32x4*)(bgate + colt + cw + bj * HALF + 4 * n) : (f32x4){0.f, 0.f, 0.f, 0.f};
#pragma unroll
            for (int ai = 0; ai < 2; ++ai)
#pragma unroll
                for (int m = 0; m < 4; ++m) { bf16_t* rowp = base + (size_t)(row0 + ai * HALF + m * 16) * ld;
#pragma unroll
                    for (int bj = 0; bj < 2; ++bj) { f32x4 v0 = acc[ai][bj][m][0] + bv[bj][0], v1 = acc[ai][bj][m][1] + bv[bj][1];
                        if (kind == 2) {
#pragma unroll
                            for (int e = 0; e < 4; ++e) { v0[e] = fast_sigmoid(v0[e]); v1[e] = fast_sigmoid(v1[e]); }
                        } else if (kind == 1) {
#pragma unroll
                            for (int e = 0; e < 4; ++e) { v0[e] = gelu_tanh(v0[e]); v1[e] = gelu_tanh(v1[e]); } }
                        *(u32x4*)(rowp + bj * HALF) = pack8(v0, v1); } }
        }
    }
};

struct EpiMerge {
    static constexpr bool PERM = true, AFTER_DRAIN = false;
    const bf16_t* G; bf16_t* MG;
    __device__ __forceinline__ void operator()(const f32x4 (&acc)[2][2][4][2], const Unit& u, int wr, int wc, int fr, int fq) const {
        const int br = u.pn >> 2, ct = u.pn & 3, rt = u.pm - br * 128;
        const int row0 = rt * BM + wr * 64 + fr, col0 = ct * BM + wc * 32 + 8 * fq;
#pragma unroll
        for (int ai = 0; ai < 2; ++ai)
#pragma unroll
            for (int m = 0; m < 4; ++m) { const size_t row = (size_t)(row0 + ai * HALF + m * 16);
#pragma unroll
                for (int bj = 0; bj < 2; ++bj) { const int col = col0 + bj * HALF;
                    const u32x4 g = *(const u32x4*)(G + row * 4096 + br * 1024 + col);
                    f32x4 v0 = acc[ai][bj][m][0], v1 = acc[ai][bj][m][1];
                    v0[0] *= bf_lo(g.x); v0[1] *= bf_hi(g.x); v0[2] *= bf_lo(g.y); v0[3] *= bf_hi(g.y);
                    v1[0] *= bf_lo(g.z); v1[1] *= bf_hi(g.z); v1[2] *= bf_lo(g.w); v1[3] *= bf_hi(g.w);
                    bf16_t* mp = MG + row * 1024 + col;
                    if (br > 0) { const u32x4 o = *(const u32x4*)mp;
                        v0[0] += bf_lo(o.x); v0[1] += bf_hi(o.x); v0[2] += bf_lo(o.y); v0[3] += bf_hi(o.y);
                        v1[0] += bf_lo(o.z); v1[1] += bf_hi(o.z); v1[2] += bf_lo(o.w); v1[3] += bf_hi(o.w); }
                    *(u32x4*)mp = pack8(v0, v1); } }
    }
};
struct MergeOrder {
    int G, c;
    __device__ __forceinline__ bool next(int i, Unit& u) const {
        const int tl = (i >> 2) * G + c; if (tl >= 512) return false;
        const int br = i & 3, rt = tl >> 2, ct = tl & 3; u.pm = br * 128 + rt; u.pn = br * 4 + ct; return true;
    }
    __device__ __forceinline__ void a_ready(const Unit&) const {}
    __device__ __forceinline__ void done(const Unit&) const {}
};

struct EpiResid {
    static constexpr bool PERM = true, AFTER_DRAIN = false;
    const float* xin; float* xout; float sc;
    __device__ __forceinline__ void operator()(const f32x4 (&acc)[2][2][4][2], const Unit& u, int wr, int wc, int fr, int fq) const {
        const int row0 = u.pm * BM + wr * 64 + fr, col0 = u.pn * BM + wc * 32 + 8 * fq;
#pragma unroll
        for (int ai = 0; ai < 2; ++ai)
#pragma unroll
            for (int m = 0; m < 4; ++m) { const size_t off = (size_t)(row0 + ai * HALF + m * 16) * 1024 + col0;
#pragma unroll
                for (int bj = 0; bj < 2; ++bj) {
                    const f32x4 a = *(const f32x4*)(xin + off + bj * HALF), b = *(const f32x4*)(xin + off + bj * HALF + 4);
                    *(f32x4*)(xout + off + bj * HALF) = a + acc[ai][bj][m][0] * sc; *(f32x4*)(xout + off + bj * HALF + 4) = b + acc[ai][bj][m][1] * sc; } }
    }
};

struct EpiSwiglu {
    static constexpr bool PERM = true, AFTER_DRAIN = false;
    bf16_t* ACT; int ldc, nct;
    __device__ __forceinline__ void operator()(const f32x4 (&acc)[2][2][4][2], const Unit& u, int wr, int wc, int fr, int fq) const {
        const int row0 = u.pm * BM + wr * 64 + fr, col0 = (u.pn % nct) * HALF + wc * 32 + 8 * fq;
#pragma unroll
        for (int ai = 0; ai < 2; ++ai)
#pragma unroll
            for (int m = 0; m < 4; ++m) { bf16_t* rowp = ACT + (size_t)(row0 + ai * HALF + m * 16) * ldc + col0;
                const f32x4 g0 = acc[ai][0][m][0], g1 = acc[ai][0][m][1]; f32x4 v0 = acc[ai][1][m][0], v1 = acc[ai][1][m][1];
#pragma unroll
                for (int e = 0; e < 4; ++e) { v0[e] *= g0[e] * fast_sigmoid(g0[e]); v1[e] *= g1[e] * fast_sigmoid(g1[e]); }
                *(u32x4*)rowp = pack8(v0, v1); }
    }
};

struct EpiSwiglu8 {
    static constexpr bool PERM = true, AFTER_DRAIN = false;
    unsigned char* ACT; int ldc, nct; float sc;
    __device__ __forceinline__ void operator()(const f32x4 (&acc)[2][2][4][2], const Unit& u, int wr, int wc, int fr, int fq) const {
        const int row0 = u.pm * BM + wr * 64 + fr, col0 = (u.pn % nct) * HALF + wc * 32 + 8 * fq;
#pragma unroll
        for (int ai = 0; ai < 2; ++ai)
#pragma unroll
            for (int m = 0; m < 4; ++m) { unsigned char* rowp = ACT + (size_t)(row0 + ai * HALF + m * 16) * ldc + col0;
                const f32x4 g0 = acc[ai][0][m][0] * sc, g1 = acc[ai][0][m][1] * sc; f32x4 v0 = acc[ai][1][m][0] * sc, v1 = acc[ai][1][m][1] * sc;
#pragma unroll
                for (int e = 0; e < 4; ++e) { v0[e] *= g0[e] * fast_sigmoid(g0[e]); v1[e] *= g1[e] * fast_sigmoid(g1[e]); }
                u32x2 w; w.x = pk4_fp8(v0[0], v0[1], v0[2], v0[3]); w.y = pk4_fp8(v1[0], v1[1], v1[2], v1[3]);
                *(u32x2*)rowp = w; }
    }
};

struct EpiDownMoe {
    static constexpr bool PERM = true, AFTER_DRAIN = false;
    const int* rinfo; bf16_t* Y; float sc;
    __device__ __forceinline__ void operator()(const f32x4 (&acc)[2][2][4][2], const Unit& u, int wr, int wc, int fr, int fq) const {
        const int prow0 = u.pm * BM + wr * 64 + fr, col0 = (u.pn & 3) * BM + wc * 32 + 8 * fq;
#pragma unroll
        for (int ai = 0; ai < 2; ++ai)
#pragma unroll
            for (int m = 0; m < 4; ++m) { const int prow = prow0 + ai * HALF + m * 16;
                const u32x2 ri = *(const u32x2*)(rinfo + 2 * (size_t)prow); const int tokk = (int)ri.x; const float gt = __uint_as_float(ri.y) * sc;
                if (tokk >= 0) { bf16_t* rowp = Y + ((size_t)(tokk & 1) * 32768 + (size_t)(tokk >> 1)) * 1024 + col0;
#pragma unroll
                    for (int bj = 0; bj < 2; ++bj) *(u32x4*)(rowp + bj * HALF) = pack8(acc[ai][bj][m][0] * gt, acc[ai][bj][m][1] * gt); } }
    }
};
struct GroupedOrder {
    int G, c, nct, T; int tend[8];
    __device__ __forceinline__ bool next(int i, Unit& u) const {
        const int L = i * G + c; if (L >= T * nct) return false;
        const int nig = 8 * nct, grp = L / nig, w = L % nig, fm = grp * 8, gsz = (T - fm) < 8 ? (T - fm) : 8;
        const int rt = fm + w % gsz, ct = w / gsz; int e = 0;
#pragma unroll
        for (int k = 0; k < 7; ++k) e += (rt >= tend[k]) ? 1 : 0;
        u.pm = rt; u.pn = e * nct + ct; return true;
    }
    __device__ __forceinline__ void a_ready(const Unit&) const {}
    __device__ __forceinline__ void done(const Unit&) const {}
};
template <class Epi, class Sched, bool ALIGN_EPI = false, bool SP2 = false, bool F8 = false>
__device__ __forceinline__ void gemm_phase(PG8_LAS unsigned char* lds, const Gemm g, const Sched& S, const Epi& E) {
    int tid_l = threadIdx.x; asm volatile("" : "+v"(tid_l));
    const int tid = tid_l, wid = __builtin_amdgcn_readfirstlane(tid >> 6), lane = tid & 63, wr = wid >> 2, wc = wid & 3, fr = lane & 15, fq = lane >> 4;
    const int K = g.K, nt = K / BK;
    unsigned voffA[2], voffB[2];
#pragma unroll
    for (int i = 0; i < 2; ++i) { int R, C; stage_rc(tid * 16 + i * 8192, R, C); const int Rb = Epi::PERM ? ((R & ~31) + perm32(R & 31)) : R;
        voffA[i] = (unsigned)(R * K + C) * 2u; voffB[i] = (unsigned)(Rb * K + C) * 2u; }
    const size_t kstep = (size_t)(BK * 2);
    const size_t hstep = (size_t)HALF * K * 2;
    const size_t tstep = 2 * hstep;
    const unsigned ldsw = (unsigned)wid * 1024u;
    const int aoff = lds_byte(wr * 64 + fr, fq * 8), boff = lds_byte(wc * 32 + fr, fq * 8);
#define PG8_SA(b, h) (((b) * 2 + (h)) * HTB)
#define PG8_SB(b, h) ((4 + (b) * 2 + (h)) * HTB)
#define PG8_STAGE(bufoff, gbase, voff) do { _Pragma("unroll") for (int _i = 0; _i < 2; ++_i) \
        __builtin_amdgcn_global_load_lds((const unsigned*)((const char*)(gbase) + (voff)[_i]), (PG8_LAS unsigned*)(lds + (bufoff) + ldsw + _i * 8192), 16, 0, 0); } while (0)
#define PG8_LDA(dst, b, h) do { _Pragma("unroll") for (int m = 0; m < 4; ++m) _Pragma("unroll") for (int k = 0; k < 2; ++k) dst[m][k] = *(const PG8_LAS bf16x8*)(lds + PG8_SA(b, h) + aoff + m * 2048 + k * 1024); } while (0)
#define PG8_LDB(dst, b, h) do { _Pragma("unroll") for (int n = 0; n < 2; ++n) _Pragma("unroll") for (int k = 0; k < 2; ++k) dst[n][k] = *(const PG8_LAS bf16x8*)(lds + PG8_SB(b, h) + boff + n * 2048 + k * 1024); } while (0)
#define PG8_MMA(ai, bj, At, Bt) do { __builtin_amdgcn_s_setprio(1); if constexpr (F8) { _Pragma("unroll") for (int m = 0; m < 4; ++m) _Pragma("unroll") for (int n = 0; n < 2; ++n) \
        asm volatile("s_nop 1\n\tv_mfma_f32_16x16x128_f8f6f4 %0, %1, %2, %0" : "+v"(acc[ai][bj][m][n]) : "v"(cat8(Bt[n][0], Bt[n][1])), "v"(cat8(At[m][0], At[m][1]))); } \
        else { _Pragma("unroll") for (int m = 0; m < 4; ++m) _Pragma("unroll") for (int n = 0; n < 2; ++n) _Pragma("unroll") for (int k = 0; k < 2; ++k) \
        acc[ai][bj][m][n] = __builtin_amdgcn_mfma_f32_16x16x32_bf16(Bt[n][k], At[m][k], acc[ai][bj][m][n], 0, 0, 0); } __builtin_amdgcn_s_setprio(0); } while (0)
#define PG8_WAIT_V(n) asm volatile("s_waitcnt vmcnt(" #n ")" ::: "memory")
#define PG8_WAIT_L(n) asm volatile("s_waitcnt lgkmcnt(" #n ")" ::: "memory")
#define PG8_BAR __builtin_amdgcn_s_barrier()
#define PG8_SCHED __builtin_amdgcn_sched_barrier(0)
    Unit cur, nxt; int ui = 0;
    if (!S.next(0, cur)) return;
    f32x4 acc[2][2][4][2];
#pragma unroll
    for (int a = 0; a < 2; ++a)
#pragma unroll
        for (int b = 0; b < 2; ++b)
#pragma unroll
            for (int m = 0; m < 4; ++m)
#pragma unroll
                for (int n = 0; n < 2; ++n) acc[a][b][m][n] = (f32x4){0.f, 0.f, 0.f, 0.f};
    bf16x8 At[4][2], B0[2][2], B1[2][2];
    const char* cA = (const char*)g.A + (size_t)cur.pm * tstep; const char* cB = (const char*)g.Bt + (size_t)cur.pn * tstep;
    S.a_ready(cur);
    if constexpr (SP2) {
        PG8_STAGE(PG8_SB(0, 0), cB, voffB); PG8_STAGE(PG8_SB(0, 1), cB + hstep, voffB); PG8_STAGE(PG8_SA(0, 0), cA, voffA); PG8_STAGE(PG8_SA(0, 1), cA + hstep, voffA);
        if (wr == 1) PG8_BAR;
        PG8_WAIT_V(2); PG8_BAR;
        PG8_STAGE(PG8_SB(1, 0), cB + kstep, voffB); PG8_STAGE(PG8_SA(1, 0), cA + kstep, voffA); PG8_STAGE(PG8_SB(1, 1), cB + hstep + kstep, voffB);
        PG8_WAIT_V(6); PG8_BAR;
    } else {
        PG8_STAGE(PG8_SB(0, 0), cB, voffB); PG8_STAGE(PG8_SA(0, 0), cA, voffA); PG8_STAGE(PG8_SB(0, 1), cB + hstep, voffB); PG8_STAGE(PG8_SA(0, 1), cA + hstep, voffA);
        if (wr == 1) PG8_BAR;
        PG8_WAIT_V(4); PG8_BAR;
        PG8_STAGE(PG8_SB(1, 0), cB + kstep, voffB); PG8_STAGE(PG8_SA(1, 0), cA + kstep, voffA); PG8_STAGE(PG8_SB(1, 1), cB + hstep + kstep, voffB);
        PG8_WAIT_V(6); PG8_BAR;
    }
    for (;;) {
        const bool has_next = S.next(ui + 1, nxt);
        const char* nA = has_next ? (const char*)g.A + (size_t)nxt.pm * tstep : cA; const char* nB = has_next ? (const char*)g.Bt + (size_t)nxt.pn * tstep : cB;
        for (int t = 0; t < nt; t += 2) {
            const bool last = (t == nt - 2);
            const char* a1 = cA + (size_t)(t + 1) * kstep;
            const char* a2 = last ? nA : cA + (size_t)(t + 2) * kstep; const char* b2 = last ? nB : cB + (size_t)(t + 2) * kstep;
            const char* a3 = a2 + kstep; const char* b3 = b2 + kstep;
            if (last && has_next) S.a_ready(nxt);
            if constexpr (SP2) {
            PG8_LDB(B0, 0, 0); PG8_LDB(B1, 0, 1); PG8_SCHED; PG8_LDA(At, 0, 0); PG8_STAGE(PG8_SA(1, 1), a1 + hstep, voffA);
            PG8_WAIT_V(8); PG8_WAIT_L(0); PG8_BAR; PG8_MMA(0, 0, At, B0); PG8_MMA(0, 1, At, B1); PG8_BAR; PG8_SCHED;
            PG8_LDA(At, 0, 1); PG8_STAGE(PG8_SB(0, 0), b2, voffB); PG8_STAGE(PG8_SB(0, 1), b2 + hstep, voffB); PG8_STAGE(PG8_SA(0, 0), a2, voffA);
            PG8_WAIT_V(8); PG8_WAIT_L(0); PG8_BAR; PG8_MMA(1, 0, At, B0); PG8_MMA(1, 1, At, B1); PG8_BAR; PG8_SCHED;
            PG8_LDB(B0, 1, 0); PG8_LDB(B1, 1, 1); PG8_SCHED; PG8_LDA(At, 1, 0); PG8_STAGE(PG8_SA(0, 1), a2 + hstep, voffA);
            PG8_WAIT_V(8); PG8_WAIT_L(0); PG8_BAR; PG8_MMA(0, 0, At, B0); PG8_MMA(0, 1, At, B1); PG8_BAR; PG8_SCHED;
            PG8_LDA(At, 1, 1); PG8_STAGE(PG8_SB(1, 0), b3, voffB); PG8_STAGE(PG8_SB(1, 1), b3 + hstep, voffB); PG8_STAGE(PG8_SA(1, 0), a3, voffA);
            PG8_WAIT_V(8); PG8_WAIT_L(0); PG8_BAR; PG8_MMA(1, 0, At, B0); PG8_MMA(1, 1, At, B1); PG8_BAR; PG8_SCHED;
            } else {
            PG8_LDB(B0, 0, 0); PG8_SCHED; PG8_LDA(At, 0, 0); PG8_STAGE(PG8_SA(1, 1), a1 + hstep, voffA);
            PG8_WAIT_L(8); PG8_BAR; PG8_WAIT_L(0); PG8_MMA(0, 0, At, B0); PG8_BAR; PG8_SCHED;
            PG8_LDB(B1, 0, 1); PG8_STAGE(PG8_SB(0, 0), b2, voffB);
            PG8_BAR; PG8_WAIT_L(0); PG8_MMA(0, 1, At, B1); PG8_BAR;
            PG8_LDA(At, 0, 1); PG8_STAGE(PG8_SA(0, 0), a2, voffA);
            PG8_BAR; PG8_WAIT_L(0); PG8_MMA(1, 0, At, B0); PG8_BAR; PG8_SCHED;
            PG8_STAGE(PG8_SB(0, 1), b2 + hstep, voffB);
            PG8_WAIT_V(6); PG8_BAR; PG8_MMA(1, 1, At, B1); PG8_BAR;
            PG8_LDB(B0, 1, 0); PG8_SCHED; PG8_LDA(At, 1, 0); PG8_STAGE(PG8_SA(0, 1), a2 + hstep, voffA);
            PG8_WAIT_L(8); PG8_BAR; PG8_WAIT_L(0); PG8_MMA(0, 0, At, B0); PG8_BAR; PG8_SCHED;
            PG8_LDB(B1, 1, 1); PG8_STAGE(PG8_SB(1, 0), b3, voffB);
            PG8_BAR; PG8_WAIT_L(0); PG8_MMA(0, 1, At, B1); PG8_BAR;
            PG8_LDA(At, 1, 1); PG8_STAGE(PG8_SA(1, 0), a3, voffA);
            PG8_BAR; PG8_WAIT_L(0); PG8_MMA(1, 0, At, B0); PG8_BAR; PG8_SCHED;
            PG8_STAGE(PG8_SB(1, 1), b3 + hstep, voffB);
            PG8_WAIT_V(6); PG8_BAR; PG8_MMA(1, 1, At, B1); PG8_BAR;
            }
        }
        if constexpr (F8) asm volatile("s_nop 15\n\ts_nop 15" ::: "memory");
        if constexpr (ALIGN_EPI) { if (wr == 0) PG8_BAR; }
        if constexpr (!Epi::AFTER_DRAIN) { E(acc, cur, wr, wc, fr, fq); S.done(cur); }
        if (!has_next) break;
#pragma unroll
        for (int a = 0; a < 2; ++a)
#pragma unroll
            for (int b = 0; b < 2; ++b)
#pragma unroll
                for (int m = 0; m < 4; ++m)
#pragma unroll
                    for (int n = 0; n < 2; ++n) acc[a][b][m][n] = (f32x4){0.f, 0.f, 0.f, 0.f};
        cur = nxt; cA = nA; cB = nB; ++ui;
        if constexpr (ALIGN_EPI) { if (wr == 1) PG8_BAR; }
    }
    PG8_WAIT_V(0);
    if constexpr (!ALIGN_EPI) { if (wr == 0) PG8_BAR; }
    PG8_BAR;
    if constexpr (Epi::AFTER_DRAIN) { E.fused(acc, cur, wr, wc, fr, fq, lds, wid, lane); S.done(cur); }
#undef PG8_SA
#undef PG8_SB
#undef PG8_STAGE
#undef PG8_LDA
#undef PG8_LDB
#undef PG8_MMA
#undef PG8_WAIT_V
#undef PG8_WAIT_L
#undef PG8_BAR
#undef PG8_SCHED
}
}

constexpr int NTOK = 32768, SEQ = 2048, DM = 1024, NLAYER = 4;
constexpr int INW = 8200;
constexpr int C_Q = 0, C_K = 512, C_V = 1024, C_F = 1536, C_SU = 1544, C_CONV = 2568, C_POOL = 3592, C_GATE = 4104;
constexpr int NPROJ = 7680;
constexpr int FFD = 2816, FFE = 3584, NEXP = 8;
constexpr int PMAX = 65536 + NEXP * 256;
constexpr float EPS = 1e-6f, LOG2E = 1.4426950408889634f;
constexpr int NWAVES = 8;

constexpr size_t MiB = 1u << 20;
constexpr size_t WS_CTL = 0, CTL_ZERO_BYTES = 1 * MiB;
constexpr size_t WS_LF = 1 * MiB;
constexpr size_t WS_RINFO = 2 * MiB;
constexpr size_t WS_ASG = 3 * MiB;
constexpr size_t WS_WMIX = 4 * MiB;
constexpr size_t WM_PROJ = WS_WMIX, WM_V = WM_PROJ + (size_t)NPROJ * 1024 * 2, WM_B = WM_V + 512 * 1024 * 2, WM_OUT = WM_B + (size_t)4096 * 512 * 2,
                 WM_PG = WM_OUT + (size_t)1024 * 1024 * 2, WM_SP = WM_PG + 4 * 128 * 128 * 2, WM_END = WM_SP + 8 * 128 * 128 * 2;
static_assert(WM_END <= 28 * MiB, "mixer weights");
constexpr size_t WS_H = 28 * MiB;
constexpr size_t WS_R = 92 * MiB;
constexpr size_t WS_Q = WS_R, WS_K = WS_Q + 32 * MiB, WS_VT = WS_K + 32 * MiB, WS_SUV = WS_VT + 32 * MiB, WS_CY = WS_SUV + 64 * MiB, WS_PIN = WS_CY + 32 * MiB,
                 WS_G = WS_PIN + 32 * MiB, WS_YS = WS_G + 256 * MiB, WS_MG = WS_YS + 128 * MiB, WS_MIX_END = WS_MG + 64 * MiB;
constexpr size_t WS_XS = WS_R;
constexpr size_t WS_WFFN = WS_XS + 132 * MiB;
constexpr size_t WF_GU = WS_WFFN, WF_D_DENSE = WF_GU + (size_t)2 * FFD * 1024 * 2, WF_D_MOE = WF_GU + (size_t)NEXP * 2 * FFE * 1024 * 2;
constexpr size_t WS_ACT = WS_WFFN + 168 * MiB;
constexpr size_t WS_END = WS_ACT + 462 * MiB;
static_assert(WF_D_MOE + (size_t)NEXP * 1024 * FFE * 2 <= WS_ACT && (size_t)PMAX * FFE * 2 <= 462 * MiB && (size_t)PMAX * 1024 * 2 <= 132 * MiB && WS_MIX_END <= WS_END, "d_ws map");
constexpr int CW_BAR = 4096;
constexpr int CW_CNT = 16384;

constexpr int RING_BYTES = 147456;
constexpr int MISC_OFF = RING_BYTES;
constexpr int LDS_BYTES = RING_BYTES + 256;

#define GAS __attribute__((address_space(1)))
#define LAS __attribute__((address_space(3)))
typedef unsigned short bf16_t;
typedef unsigned v4u __attribute__((ext_vector_type(4)));
typedef unsigned v2u __attribute__((ext_vector_type(2)));
typedef float f32x4 __attribute__((ext_vector_type(4)));
typedef float f32x16 __attribute__((ext_vector_type(16)));
typedef short bf16x8 __attribute__((ext_vector_type(8)));
typedef GAS unsigned gu32;
#define RLX_AGENT __ATOMIC_RELAXED, __HIP_MEMORY_SCOPE_AGENT
#define LDS_WAIT() asm volatile("s_waitcnt lgkmcnt(0)" ::: "memory")
typedef float f32x2_t __attribute__((ext_vector_type(2))); typedef __bf16 bf16x2_t __attribute__((ext_vector_type(2)));
__device__ __forceinline__ unsigned pk2(float lo, float hi) { f32x2_t v = {lo, hi}; bf16x2_t b = __builtin_convertvector(v, bf16x2_t); return __builtin_bit_cast(unsigned, b); }
__device__ __forceinline__ float blo(unsigned w) { return __uint_as_float(w << 16); }
__device__ __forceinline__ float bhi(unsigned w) { return __uint_as_float(w & 0xffff0000u); }
__device__ __forceinline__ float bf1(bf16_t b) { return __uint_as_float((unsigned)b << 16); }
__device__ __forceinline__ bf16_t f2bf(float f) { return (bf16_t)(pk2(f, 0.f) & 0xffffu); }
__device__ __forceinline__ float sigm(float x) { return __builtin_amdgcn_rcpf(1.0f + __builtin_amdgcn_exp2f(-LOG2E * x)); }
__device__ __forceinline__ float wave_sum(float v) {
#pragma unroll
    for (int o = 1; o < 64; o <<= 1) v += __shfl_xor(v, o);
    return v;
}
__device__ __forceinline__ int crow(int r, int hi) { return (r & 3) + 8 * (r >> 2) + 4 * hi; }
#define MFMA32(a, b, c) __builtin_amdgcn_mfma_f32_32x32x16_bf16((a), (b), (c), 0, 0, 0)

__device__ __forceinline__ void tr_item(const float* src, int ldn, int c0, int k0, bf16_t* dst, int ldk, int drow0, LAS float* scr, int lane) {
#pragma unroll 8
    for (int i = 0; i < 32; ++i) { const int kk = 2 * i + (lane >> 5); scr[kk * 33 + (lane & 31)] = src[(size_t)(k0 + kk) * ldn + c0 + (lane & 31)]; }
    LDS_WAIT(); asm volatile("" ::: "memory");
    const int c = lane & 7;
#pragma unroll
    for (int j = 0; j < 4; ++j) { const int n = (lane >> 3) + 8 * j; const LAS float* s = scr + (8 * c) * 33 + n;
        v4u o; o.x = pk2(s[0 * 33], s[1 * 33]); o.y = pk2(s[2 * 33], s[3 * 33]); o.z = pk2(s[4 * 33], s[5 * 33]); o.w = pk2(s[6 * 33], s[7 * 33]);
        *(v4u*)(dst + (size_t)(drow0 + n) * ldk + k0 + 8 * c) = o; }
    LDS_WAIT(); asm volatile("" ::: "memory");
}
__device__ __forceinline__ unsigned pk4f8(float a, float b, float c, float d) {
    a = __builtin_fminf(__builtin_fmaxf(a, -448.f), 448.f); b = __builtin_fminf(__builtin_fmaxf(b, -448.f), 448.f); c = __builtin_fminf(__builtin_fmaxf(c, -448.f), 448.f); d = __builtin_fminf(__builtin_fmaxf(d, -448.f), 448.f);
    int w = 0; w = __builtin_amdgcn_cvt_pk_fp8_f32(a, b, w, false); w = __builtin_amdgcn_cvt_pk_fp8_f32(c, d, w, true); return (unsigned)w; }
__device__ __forceinline__ void tr_item8(const float* src, int ldn, int c0, int k0, unsigned char* dst, int ldk, int drow0, float scale, LAS float* scr, int lane) {
#pragma unroll 8
    for (int i = 0; i < 32; ++i) { const int kk = 2 * i + (lane >> 5); scr[kk * 33 + (lane & 31)] = src[(size_t)(k0 + kk) * ldn + c0 + (lane & 31)]; }
    LDS_WAIT(); asm volatile("" ::: "memory");
    const int c = lane & 7;
#pragma unroll
    for (int j = 0; j < 4; ++j) { const int n = (lane >> 3) + 8 * j; const LAS float* s = scr + (8 * c) * 33 + n;
        v2u o; o.x = pk4f8(s[0 * 33] * scale, s[1 * 33] * scale, s[2 * 33] * scale, s[3 * 33] * scale); o.y = pk4f8(s[4 * 33] * scale, s[5 * 33] * scale, s[6 * 33] * scale, s[7 * 33] * scale);
        *(v2u*)(dst + (size_t)(drow0 + n) * ldk + k0 + 8 * c) = o; }
    LDS_WAIT(); asm volatile("" ::: "memory");
}
__device__ __forceinline__ void tr_segment8(const float* src, int ldn, int K, int c_begin, int ncols, unsigned char* dst, int drow_begin, int blk, float scale, LAS float* scr, int gw, int NGW, int lane, int& off) {
    const int nblk = ncols / 32, nitems = (K / 64) * nblk;
    int start = (gw - (off % NGW) + NGW) % NGW;
    for (int it = start; it < nitems; it += NGW) {
        const int kb = it / nblk, nb = it % nblk, n0 = nb * 32;
        const int drow0 = drow_begin + (blk ? (n0 / blk) * (2 * blk) + (n0 % blk) : n0);
        tr_item8(src, ldn, c_begin + n0, kb * 64, dst, K, drow0, scale, scr, lane);
    }
    off += nitems;
}
__device__ __forceinline__ void tr_segment(const float* src, int ldn, int K, int c_begin, int ncols, bf16_t* dst, int drow_begin, int blk, LAS float* scr, int gw, int NGW, int lane, int& off) {
    const int nblk = ncols / 32, nitems = (K / 64) * nblk;
    int start = (gw - (off % NGW) + NGW) % NGW;
    for (int it = start; it < nitems; it += NGW) {
        const int kb = it / nblk, nb = it % nblk, n0 = nb * 32;
        const int drow0 = drow_begin + (blk ? (n0 / blk) * (2 * blk) + (n0 % blk) : n0);
        tr_item(src, ldn, c_begin + n0, kb * 64, dst, K, drow0, scr, lane);
    }
    off += nitems;
}

template <int MODE>
__device__ __forceinline__ void norm_rows(const float* xin, float* xout, bool write_x, const bf16_t* ycomb  , const float* gain, bf16_t* H, unsigned char* H8  ,
                                          const float* w8, int ldw8, const float* b8, float* LF, int* ASG, gu32* cnt, int gw, int NGW, int lane) {
    f32x4 gv[4];
#pragma unroll
    for (int jj = 0; jj < 4; ++jj) gv[jj] = ((const f32x4*)gain)[64 * jj + lane];
    float wf[4][4][8];
    if (MODE != 1) {
#pragma unroll
        for (int jj = 0; jj < 4; ++jj)
#pragma unroll
            for (int i = 0; i < 4; ++i) { const float* wr = w8 + (size_t)(4 * lane + 256 * jj + i) * ldw8; const f32x4 a = *(const f32x4*)wr, b = *(const f32x4*)(wr + 4);
                wf[jj][i][0] = a[0]; wf[jj][i][1] = a[1]; wf[jj][i][2] = a[2]; wf[jj][i][3] = a[3]; wf[jj][i][4] = b[0]; wf[jj][i][5] = b[1]; wf[jj][i][6] = b[2]; wf[jj][i][7] = b[3]; }
    }
    int my_e = -1, my_row = 0, my_k = 0, nheld = 0; float my_g = 0.f;
    for (int row = gw; row < NTOK; row += NGW) {
        f32x4 v[4];
#pragma unroll
        for (int jj = 0; jj < 4; ++jj) v[jj] = ((const f32x4*)(xin + (size_t)row * DM))[64 * jj + lane];
        if (ycomb) {
#pragma unroll
            for (int jj = 0; jj < 4; ++jj) { const v2u a = ((const v2u*)(ycomb + (size_t)row * DM))[64 * jj + lane], b = ((const v2u*)(ycomb + ((size_t)NTOK + row) * DM))[64 * jj + lane];
                v[jj][0] += blo(a.x) + blo(b.x); v[jj][1] += bhi(a.x) + bhi(b.x); v[jj][2] += blo(a.y) + blo(b.y); v[jj][3] += bhi(a.y) + bhi(b.y); }
        }
        if (write_x) {
#pragma unroll
            for (int jj = 0; jj < 4; ++jj) ((f32x4*)(xout + (size_t)row * DM))[64 * jj + lane] = v[jj];
        }
        float ss = 0.f;
#pragma unroll
        for (int jj = 0; jj < 4; ++jj) ss += (v[jj][0] * v[jj][0] + v[jj][1] * v[jj][1]) + (v[jj][2] * v[jj][2] + v[jj][3] * v[jj][3]);
        const float r = __builtin_amdgcn_rsqf(wave_sum(ss) * (1.0f / DM) + EPS);
#pragma unroll
        for (int jj = 0; jj < 4; ++jj) { v[jj] = v[jj] * r * gv[jj];
            if (H8) ((unsigned*)(H8 + (size_t)row * DM))[64 * jj + lane] = pk4f8(v[jj][0], v[jj][1], v[jj][2], v[jj][3]);
            else { v2u o; o.x = pk2(v[jj][0], v[jj][1]); o.y = pk2(v[jj][2], v[jj][3]); ((v2u*)(H + (size_t)row * DM))[64 * jj + lane] = o; } }
        if (MODE != 1) {
            float fd[8];
#pragma unroll
            for (int j = 0; j < 8; ++j) { float s = 0.f;
#pragma unroll
                for (int jj = 0; jj < 4; ++jj)
#pragma unroll
                    for (int i = 0; i < 4; ++i) s += v[jj][i] * wf[jj][i][j];
                fd[j] = wave_sum(s); }
            if (MODE == 0) {
                float z = fd[0];
#pragma unroll
                for (int j = 1; j < 8; ++j) z = (lane == j) ? fd[j] : z;
                if (lane < 8) { z += b8[lane]; const float az = __builtin_fabsf(z);
                    const float ls = __builtin_fminf(z, 0.f) - __builtin_amdgcn_logf(1.0f + __builtin_amdgcn_exp2f(-LOG2E * az)) * 0.6931471805599453f;
                    LF[(size_t)row * 8 + lane] = ls; }
            } else {
                int i0 = 0; float v0 = fd[0];
#pragma unroll
                for (int j = 1; j < 8; ++j) if (fd[j] > v0) { v0 = fd[j]; i0 = j; }
                int i1 = -1; float v1 = -3.0e38f;
#pragma unroll
                for (int j = 0; j < 8; ++j) if (j != i0 && fd[j] > v1) { v1 = fd[j]; i1 = j; }
                const float g0 = __builtin_amdgcn_rcpf(1.0f + __builtin_amdgcn_exp2f(LOG2E * (v1 - v0))), g1 = 1.0f - g0;
                if (lane == 2 * nheld) { my_e = i0; my_g = g0; my_row = row; my_k = 0; }
                if (lane == 2 * nheld + 1) { my_e = i1; my_g = g1; my_row = row; my_k = 1; }
                ++nheld;
            }
        }
        if (MODE == 2 && (nheld == 32 || row + NGW >= NTOK)) {
            int pos = 0;
#pragma unroll
            for (int e = 0; e < 8; ++e) { const unsigned long long mk = __ballot(my_e == e);
                if (mk) { const int leader = __builtin_ctzll(mk); unsigned base = 0;
                    if (lane == leader) base = __hip_atomic_fetch_add(cnt + 64 * e, (unsigned)__builtin_popcountll(mk), RLX_AGENT);
                    base = __shfl(base, leader);
                    if (my_e == e) pos = (int)base + __builtin_popcountll(mk & ((1ull << lane) - 1ull)); } }
            if (my_e >= 0) { ASG[(size_t)(my_row * 2 + my_k) * 2] = (my_e << 24) | pos; ASG[(size_t)(my_row * 2 + my_k) * 2 + 1] = (int)__float_as_uint(my_g); }
            my_e = -1; nheld = 0;
        }
    }
}

constexpr int AT_KT = 0, AT_VT = 18432, AT_CK = 36864, AT_WT = 45056, AT_TS = 144;
__device__ __forceinline__ void attn_unit(LAS unsigned char* lds, int b, int h, int qb, const bf16_t* Qr, const bf16_t* Kr, const bf16_t* VT, const float* LF,
                                          const float* gq, const float* gk, bf16_t* O, int tid) {
    const int lane = tid & 63, wave = __builtin_amdgcn_readfirstlane(tid >> 6), r32 = lane & 31, hi = lane >> 5;
    const size_t rowbase = (size_t)b * SEQ;
    LAS float* CK = (LAS float*)(lds + AT_CK); LAS float* WT = (LAS float*)(lds + AT_WT);
    {
        float v0 = LF[(rowbase + 4 * tid + 0) * 8 + h], v1 = LF[(rowbase + 4 * tid + 1) * 8 + h], v2 = LF[(rowbase + 4 * tid + 2) * 8 + h], v3 = LF[(rowbase + 4 * tid + 3) * 8 + h];
        v1 += v0; v2 += v1; v3 += v2;
        float incl = v3;
#pragma unroll
        for (int o = 1; o < 64; o <<= 1) { const float n = __shfl_up(incl, o); if (lane >= o) incl += n; }
        if (lane == 63) WT[wave] = incl;
        __syncthreads();
        float base = 0.f;
        for (int w = 0; w < wave; ++w) base += WT[w];
        const float ex = base + incl - v3;
        *(LAS f32x4*)(CK + 4 * tid) = (f32x4){(ex + v0) * LOG2E, (ex + v1) * LOG2E, (ex + v2) * LOG2E, (ex + v3) * LOG2E};
        __syncthreads();
    }
    const int q_abs = qb * 256 + wave * 32 + r32;
    bf16x8 qf[4];
    {
        const bf16_t* qp = Qr + (rowbase + q_abs) * 512 + h * 64 + 8 * hi;
        v4u raw[4]; float ss = 0.f;
#pragma unroll
        for (int s = 0; s < 4; ++s) { raw[s] = *(const v4u*)(qp + 16 * s);
#pragma unroll
            for (int e = 0; e < 4; ++e) { const float a = blo(raw[s][e]), c = bhi(raw[s][e]); ss += a * a + c * c; } }
        ss += __shfl_xor(ss, 32);
        const float r = __builtin_amdgcn_rsqf(ss * (1.0f / 64.0f) + EPS) * (0.125f * LOG2E);
#pragma unroll
        for (int s = 0; s < 4; ++s) { const f32x4 g0 = *(const f32x4*)(gq + 16 * s + 8 * hi), g1 = *(const f32x4*)(gq + 16 * s + 8 * hi + 4); v4u o;
            o.x = pk2(blo(raw[s].x) * r * g0[0], bhi(raw[s].x) * r * g0[1]); o.y = pk2(blo(raw[s].y) * r * g0[2], bhi(raw[s].y) * r * g0[3]);
            o.z = pk2(blo(raw[s].z) * r * g1[0], bhi(raw[s].z) * r * g1[1]); o.w = pk2(blo(raw[s].w) * r * g1[2], bhi(raw[s].w) * r * g1[3]);
            qf[s] = __builtin_bit_cast(bf16x8, o); }
    }
    const float cq = CK[q_abs];
    const int NT = 4 * qb + 4;
    const int lkv = tid >> 3, lch = tid & 7;
    const bf16_t* kp = Kr + (rowbase + lkv) * 512 + h * 64 + 8 * lch;
    const bf16_t* vp = VT + (size_t)(h * 64 + lkv) * NTOK + rowbase + 8 * lch;
    const f32x4 gk0 = *(const f32x4*)(gk + 8 * lch), gk1 = *(const f32x4*)(gk + 8 * lch + 4);
    v4u kreg = *(const v4u*)kp, vreg = *(const v4u*)vp;
    f32x16 o0, o1;
#pragma unroll
    for (int i = 0; i < 16; ++i) { o0[i] = 0.f; o1[i] = 0.f; }
    float mrun = -1.0e30f, lrun = 0.f;
    const int qw_max = qb * 256 + wave * 32 + 31, qw_min = qb * 256 + wave * 32;
    for (int j = 0; j < NT; ++j) {
        const int buf = j & 1;
        {
            float f[8]; f[0] = blo(kreg.x); f[1] = bhi(kreg.x); f[2] = blo(kreg.y); f[3] = bhi(kreg.y); f[4] = blo(kreg.z); f[5] = bhi(kreg.z); f[6] = blo(kreg.w); f[7] = bhi(kreg.w);
            float ss = 0.f;
#pragma unroll
            for (int e = 0; e < 8; ++e) ss += f[e] * f[e];
            ss += __shfl_xor(ss, 1); ss += __shfl_xor(ss, 2); ss += __shfl_xor(ss, 4);
            const float r = __builtin_amdgcn_rsqf(ss * (1.0f / 64.0f) + EPS);
            v4u ko; ko.x = pk2(f[0] * r * gk0[0], f[1] * r * gk0[1]); ko.y = pk2(f[2] * r * gk0[2], f[3] * r * gk0[3]); ko.z = pk2(f[4] * r * gk1[0], f[5] * r * gk1[1]); ko.w = pk2(f[6] * r * gk1[2], f[7] * r * gk1[3]);
            *(LAS v4u*)(lds + AT_KT + buf * 9216 + lkv * AT_TS + lch * 16) = ko;
            *(LAS v4u*)(lds + AT_VT + buf * 9216 + lkv * AT_TS + lch * 16) = vreg;
        }
        __syncthreads();
        if (j + 1 < NT) { kreg = *(const v4u*)(kp + (size_t)(j + 1) * 64 * 512); vreg = *(const v4u*)(vp + (j + 1) * 64); }
        if (64 * j <= qw_max) {
            const LAS unsigned char* KT = lds + AT_KT + buf * 9216; const LAS unsigned char* VTL = lds + AT_VT + buf * 9216;
            f32x16 p0, p1;
#pragma unroll
            for (int i = 0; i < 16; ++i) { p0[i] = 0.f; p1[i] = 0.f; }
#pragma unroll
            for (int s = 0; s < 4; ++s) {
                const bf16x8 a0 = *(const LAS bf16x8*)(KT + r32 * AT_TS + (16 * s + 8 * hi) * 2);
                const bf16x8 a1 = *(const LAS bf16x8*)(KT + (32 + r32) * AT_TS + (16 * s + 8 * hi) * 2);
                p0 = MFMA32(a0, qf[s], p0); p1 = MFMA32(a1, qf[s], p1);
            }
            const int kvb = 64 * j;
#pragma unroll
            for (int g4 = 0; g4 < 4; ++g4) { const f32x4 c0 = *(const LAS f32x4*)(CK + kvb + 4 * hi + 8 * g4), c1 = *(const LAS f32x4*)(CK + kvb + 32 + 4 * hi + 8 * g4);
#pragma unroll
                for (int e = 0; e < 4; ++e) { p0[4 * g4 + e] += cq - c0[e]; p1[4 * g4 + e] += cq - c1[e]; } }
            if (kvb + 63 > qw_min) {
#pragma unroll
                for (int i = 0; i < 16; ++i) { const int kv = kvb + crow(i, hi); if (kv > q_abs) p0[i] = -1.0e30f; if (kv + 32 > q_abs) p1[i] = -1.0e30f; }
            }
            float mx = p0[0];
#pragma unroll
            for (int i = 1; i < 16; ++i) mx = __builtin_fmaxf(mx, p0[i]);
#pragma unroll
            for (int i = 0; i < 16; ++i) mx = __builtin_fmaxf(mx, p1[i]);
            mx = __builtin_fmaxf(mx, __shfl_xor(mx, 32));
            const float mnew = __builtin_fmaxf(mrun, mx), alpha = __builtin_amdgcn_exp2f(mrun - mnew); mrun = mnew;
            float ls = 0.f;
#pragma unroll
            for (int i = 0; i < 16; ++i) { p0[i] = __builtin_amdgcn_exp2f(p0[i] - mnew); p1[i] = __builtin_amdgcn_exp2f(p1[i] - mnew); ls += p0[i] + p1[i]; }
            lrun = lrun * alpha + ls;
#pragma unroll
            for (int i = 0; i < 16; ++i) { o0[i] *= alpha; o1[i] *= alpha; }
            bf16x8 pf[4];
            { v4u w;
              w.x = pk2(p0[0], p0[1]); w.y = pk2(p0[2], p0[3]); w.z = pk2(p0[4], p0[5]); w.w = pk2(p0[6], p0[7]); pf[0] = __builtin_bit_cast(bf16x8, w);
              w.x = pk2(p0[8], p0[9]); w.y = pk2(p0[10], p0[11]); w.z = pk2(p0[12], p0[13]); w.w = pk2(p0[14], p0[15]); pf[1] = __builtin_bit_cast(bf16x8, w);
              w.x = pk2(p1[0], p1[1]); w.y = pk2(p1[2], p1[3]); w.z = pk2(p1[4], p1[5]); w.w = pk2(p1[6], p1[7]); pf[2] = __builtin_bit_cast(bf16x8, w);
              w.x = pk2(p1[8], p1[9]); w.y = pk2(p1[10], p1[11]); w.z = pk2(p1[12], p1[13]); w.w = pk2(p1[14], p1[15]); pf[3] = __builtin_bit_cast(bf16x8, w); }
#pragma unroll
            for (int ks = 0; ks < 4; ++ks) {
                const v2u a0l = *(const LAS v2u*)(VTL + r32 * AT_TS + (16 * ks + 4 * hi) * 2), a0h = *(const LAS v2u*)(VTL + r32 * AT_TS + (16 * ks + 8 + 4 * hi) * 2);
                const v2u a1l = *(const LAS v2u*)(VTL + (32 + r32) * AT_TS + (16 * ks + 4 * hi) * 2), a1h = *(const LAS v2u*)(VTL + (32 + r32) * AT_TS + (16 * ks + 8 + 4 * hi) * 2);
                const v4u A0 = (v4u){a0l.x, a0l.y, a0h.x, a0h.y}, A1 = (v4u){a1l.x, a1l.y, a1h.x, a1h.y};
                o0 = MFMA32(__builtin_bit_cast(bf16x8, A0), pf[ks], o0); o1 = MFMA32(__builtin_bit_cast(bf16x8, A1), pf[ks], o1);
            }
        }
    }
    lrun += __shfl_xor(lrun, 32);
    const float inv = __builtin_amdgcn_rcpf(lrun);
    bf16_t* op = O + (rowbase + q_abs) * 512 + h * 64 + 4 * hi;
#pragma unroll
    for (int g4 = 0; g4 < 4; ++g4) {
        v2u w0, w1; w0.x = pk2(o0[4 * g4] * inv, o0[4 * g4 + 1] * inv); w0.y = pk2(o0[4 * g4 + 2] * inv, o0[4 * g4 + 3] * inv);
        w1.x = pk2(o1[4 * g4] * inv, o1[4 * g4 + 1] * inv); w1.y = pk2(o1[4 * g4 + 2] * inv, o1[4 * g4 + 3] * inv);
        *(v2u*)(op + 8 * g4) = w0; *(v2u*)(op + 32 + 8 * g4) = w1;
    }
    __syncthreads();
}

constexpr int SG_VT = 0, SG_VS = 272, SG_WB = 64 * 272, SG_PS = 8 * SG_WB;
__device__ __forceinline__ void sgu_unit(LAS unsigned char* lds, int chunk, const bf16_t* SUV, const float* gsgu, const bf16_t* Wsp, const float* bsp, bf16_t* O, int tid) {
    const int lane = tid & 63, g = __builtin_amdgcn_readfirstlane(tid >> 6), r32 = lane & 31, hi = lane >> 5;
    const size_t row0 = (size_t)chunk * 128;
    LAS float* PS = (LAS float*)(lds + SG_PS);
    LAS unsigned char* VTw = lds + SG_VT + g * SG_WB;
    const int c8 = lane & 7, rl = lane >> 3;
    v4u raw[16];
#pragma unroll
    for (int i = 0; i < 16; ++i) raw[i] = *(const v4u*)(SUV + (row0 + rl + 8 * i) * 1024 + 512 + g * 64 + 8 * c8);
#pragma unroll
    for (int i = 0; i < 16; ++i) { float ss = 0.f;
#pragma unroll
        for (int e = 0; e < 4; ++e) { const float a = blo(raw[i][e]), c = bhi(raw[i][e]); ss += a * a + c * c; }
        ss += __shfl_xor(ss, 1); ss += __shfl_xor(ss, 2); ss += __shfl_xor(ss, 4);
        if (c8 == 0) PS[(rl + 8 * i) * 8 + g] = ss; }
    __syncthreads();
    const f32x4 gs0 = *(const f32x4*)(gsgu + g * 64 + 8 * c8), gs1 = *(const f32x4*)(gsgu + g * 64 + 8 * c8 + 4);
#pragma unroll
    for (int i = 0; i < 16; ++i) { const int t = rl + 8 * i;
        const f32x4 pa = *(const LAS f32x4*)(PS + t * 8), pb = *(const LAS f32x4*)(PS + t * 8 + 4);
        const float r = __builtin_amdgcn_rsqf(((pa[0] + pa[1]) + (pa[2] + pa[3]) + (pb[0] + pb[1]) + (pb[2] + pb[3])) * (1.0f / 512.0f) + EPS);
        float f[8]; f[0] = blo(raw[i].x) * r * gs0[0]; f[1] = bhi(raw[i].x) * r * gs0[1]; f[2] = blo(raw[i].y) * r * gs0[2]; f[3] = bhi(raw[i].y) * r * gs0[3];
        f[4] = blo(raw[i].z) * r * gs1[0]; f[5] = bhi(raw[i].z) * r * gs1[1]; f[6] = blo(raw[i].w) * r * gs1[2]; f[7] = bhi(raw[i].w) * r * gs1[3];
#pragma unroll
        for (int e = 0; e < 8; ++e) *(LAS bf16_t*)(VTw + (8 * c8 + e) * SG_VS + t * 2) = f2bf(f[e]); }
    __syncthreads();
    const bf16_t* Wg = Wsp + (size_t)g * 128 * 128;
#pragma unroll 1
    for (int tb = 0; tb < 4; ++tb) {
        f32x16 a0, a1;
#pragma unroll
        for (int i = 0; i < 16; ++i) { a0[i] = 0.f; a1[i] = 0.f; }
        const int nks = 2 * (tb + 1);
        for (int ks = 0; ks < nks; ++ks) {
            const bf16x8 A = *(const bf16x8*)(Wg + (32 * tb + r32) * 128 + 16 * ks + 8 * hi);
            const bf16x8 B0 = *(const LAS bf16x8*)(VTw + r32 * SG_VS + (16 * ks + 8 * hi) * 2), B1 = *(const LAS bf16x8*)(VTw + (32 + r32) * SG_VS + (16 * ks + 8 * hi) * 2);
            a0 = MFMA32(A, B0, a0); a1 = MFMA32(A, B1, a1);
        }
#pragma unroll
        for (int i = 0; i < 16; ++i) { const int t = 32 * tb + crow(i, hi); const size_t row = row0 + t; const float bs = bsp[g * 128 + t];
            const float u0 = bf1(SUV[row * 1024 + g * 64 + r32]), u1 = bf1(SUV[row * 1024 + g * 64 + 32 + r32]);
            O[row * 512 + g * 64 + r32] = f2bf(u0 * (a0[i] + bs)); O[row * 512 + g * 64 + 32 + r32] = f2bf(u1 * (a1[i] + bs)); }
    }
    __syncthreads();
}

constexpr int CP_RS = 1040, CP_PS = 98304;
__device__ __forceinline__ void conv_unit(LAS unsigned char* lds, int tile, const bf16_t* CY, const float* wdw, const float* bdw, const float* gcv, bf16_t* Oc, int tid) {
    const int lane = tid & 63, wave = __builtin_amdgcn_readfirstlane(tid >> 6);
    const size_t row0 = (size_t)tile * 64; const int t0 = (tile * 64) % SEQ;
    LAS float* PS = (LAS float*)(lds + CP_PS);
    for (int idx = tid; idx < 94 * 64; idx += 512) { const int r = idx >> 6, ch = idx & 63; const int tt = t0 - 30 + r;
        v4u v = (v4u){0u, 0u, 0u, 0u}; if (tt >= 0) v = *(const v4u*)(CY + (row0 - 30 + r) * 512 + 8 * ch);
        *(LAS v4u*)(lds + r * CP_RS + ch * 16) = v; }
    float w[31];
#pragma unroll
    for (int j = 0; j < 31; ++j) w[j] = wdw[j * 512 + tid];
    const float bias = bdw[tid];
    __syncthreads();
#pragma unroll 1
    for (int tg = 0; tg < 8; ++tg) {
        float z8[8];
#pragma unroll
        for (int t = 0; t < 8; ++t) z8[t] = bias;
        const LAS unsigned char* col = lds + (8 * tg) * CP_RS + tid * 2;
        float yv[38];
#pragma unroll
        for (int i = 0; i < 38; ++i) yv[i] = bf1(*(const LAS bf16_t*)(col + i * CP_RS));
#pragma unroll
        for (int t = 0; t < 8; ++t)
#pragma unroll
            for (int j = 0; j < 31; ++j) z8[t] = __builtin_fmaf(w[j], yv[t + j], z8[t]);
#pragma unroll
        for (int t = 0; t < 8; ++t) *(LAS bf16_t*)(lds + (8 * tg + t) * CP_RS + tid * 2) = f2bf(z8[t]);
    }
    __syncthreads();
#pragma unroll
    for (int i = 0; i < 8; ++i) { const int t = 8 * wave + i; const v4u v = *(const LAS v4u*)(lds + t * CP_RS + lane * 16); float ss = 0.f;
#pragma unroll
        for (int e = 0; e < 4; ++e) { const float a = blo(v[e]), c = bhi(v[e]); ss += a * a + c * c; }
        ss = wave_sum(ss);
        if (lane == 0) PS[512 + t] = __builtin_amdgcn_rsqf(ss * (1.0f / 512.0f) + EPS); }
    __syncthreads();
    {
        const int ch8 = tid & 63, tr = tid >> 6;
        const f32x4 g0 = *(const f32x4*)(gcv + 8 * ch8), g1 = *(const f32x4*)(gcv + 8 * ch8 + 4);
#pragma unroll
        for (int i = 0; i < 8; ++i) { const int t = tr + 8 * i; const v4u v = *(const LAS v4u*)(lds + t * CP_RS + ch8 * 16); const float r = PS[512 + t];
            float f[8]; f[0] = blo(v.x) * r * g0[0]; f[1] = bhi(v.x) * r * g0[1]; f[2] = blo(v.y) * r * g0[2]; f[3] = bhi(v.y) * r * g0[3];
            f[4] = blo(v.z) * r * g1[0]; f[5] = bhi(v.z) * r * g1[1]; f[6] = blo(v.w) * r * g1[2]; f[7] = bhi(v.w) * r * g1[3];
#pragma unroll
            for (int e = 0; e < 8; ++e) f[e] *= sigm(f[e]);
            v4u o; o.x = pk2(f[0], f[1]); o.y = pk2(f[2], f[3]); o.z = pk2(f[4], f[5]); o.w = pk2(f[6], f[7]);
            *(v4u*)(Oc + (row0 + t) * 512 + 8 * ch8) = o; }
    }
    __syncthreads();
}
__device__ __forceinline__ void pool_unit(LAS unsigned char* lds, int tile, const bf16_t* PIN, const bf16_t* Wpg, const float* pls, bf16_t* Op, int tid) {
    const int lane = tid & 63, wave = __builtin_amdgcn_readfirstlane(tid >> 6), r32 = lane & 31, hi = lane >> 5;
    const size_t row0 = (size_t)tile * 64; const int t0 = (tile * 64) % SEQ;
    for (int idx = tid; idx < 79 * 64; idx += 512) { const int r = idx >> 6, ch = idx & 63; const int tt = t0 - 15 + r;
        v4u v = (v4u){0u, 0u, 0u, 0u}; if (tt >= 0) v = *(const v4u*)(PIN + (row0 - 15 + r) * 512 + 8 * ch);
        *(LAS v4u*)(lds + r * CP_RS + ch * 16) = v; }
    __syncthreads();
    {
        float pv[79];
#pragma unroll
        for (int i = 0; i < 79; ++i) pv[i] = bf1(*(const LAS bf16_t*)(lds + i * CP_RS + tid * 2));
        const bool first = (t0 == 0);
        const int wsel = wave >> 1;
#define POOL_W(W) { _Pragma("unroll") for (int t = 0; t < 64; ++t) { float s = 0.f; _Pragma("unroll") for (int j = 0; j < W; ++j) s += pv[t + 15 - j]; \
            const float inv = first ? (1.0f / (float)((t + 1) < W ? (t + 1) : W)) : (1.0f / (float)W); \
            *(LAS bf16_t*)(lds + t * CP_RS + tid * 2) = f2bf(s * inv - pv[t + 15]); } }
        if (wsel == 0) POOL_W(2) else if (wsel == 1) POOL_W(4) else if (wsel == 2) POOL_W(8) else POOL_W(16)
#undef POOL_W
    }
    __syncthreads();
    {
        const int g = wave >> 1, nh = wave & 1;
        f32x16 acc[2][2];
#pragma unroll
        for (int a = 0; a < 2; ++a)
#pragma unroll
            for (int c = 0; c < 2; ++c)
#pragma unroll
                for (int i = 0; i < 16; ++i) acc[a][c][i] = 0.f;
#pragma unroll
        for (int ks = 0; ks < 8; ++ks) {
            const bf16x8 A0 = *(const LAS bf16x8*)(lds + r32 * CP_RS + (g * 128 + 16 * ks + 8 * hi) * 2), A1 = *(const LAS bf16x8*)(lds + (32 + r32) * CP_RS + (g * 128 + 16 * ks + 8 * hi) * 2);
            const bf16x8 B0 = *(const bf16x8*)(Wpg + ((size_t)g * 128 + 64 * nh + r32) * 128 + 16 * ks + 8 * hi), B1 = *(const bf16x8*)(Wpg + ((size_t)g * 128 + 64 * nh + 32 + r32) * 128 + 16 * ks + 8 * hi);
            acc[0][0] = MFMA32(A0, B0, acc[0][0]); acc[0][1] = MFMA32(A0, B1, acc[0][1]); acc[1][0] = MFMA32(A1, B0, acc[1][0]); acc[1][1] = MFMA32(A1, B1, acc[1][1]);
        }
#pragma unroll
        for (int ct = 0; ct < 2; ++ct) { const int col = g * 128 + 64 * nh + 32 * ct + r32; const float sc = pls[col];
#pragma unroll
            for (int rt = 0; rt < 2; ++rt)
#pragma unroll
                for (int i = 0; i < 16; ++i) Op[(row0 + 32 * rt + crow(i, hi)) * 512 + col] = f2bf(acc[rt][ct][i] * sc); }
    }
    __syncthreads();
}

__device__ __forceinline__ void moe_offsets(const gu32* cnt, int (&pstart)[8], int (&tend)[8], int& T) {
    int acc = 0;
#pragma unroll
    for (int e = 0; e < 8; ++e) { const int c = (int)__hip_atomic_load(cnt + 64 * e, RLX_AGENT); pstart[e] = acc; acc += (c + 255) & ~255; tend[e] = acc >> 8; }
    T = acc >> 8;
}
__device__ __forceinline__ void moe_scatter(const gu32* cnt, const int* ASG, const bf16_t* H, bf16_t* XS, int* RINFO, int gw, int NGW, int lane, int tid, int blk, int nblk, bool f8) {
    int pstart[8], tend[8], T; moe_offsets(cnt, pstart, tend, T);
    for (int e = blk; e < 8; e += nblk) { const int c = (int)__hip_atomic_load(cnt + 64 * e, RLX_AGENT); const int pe = (c + 255) & ~255;
        for (int r = c + tid; r < pe; r += 512) { RINFO[2 * (size_t)(pstart[e] + r)] = -1; RINFO[2 * (size_t)(pstart[e] + r) + 1] = 0; } }
    for (int a = gw; a < NTOK * 2; a += NGW) {
        const int w0 = ASG[2 * (size_t)a], gb = ASG[2 * (size_t)a + 1]; const int e = w0 >> 24, pos = w0 & 0xffffff;
        int ps = 0;
#pragma unroll
        for (int k = 0; k < 8; ++k) ps = (e == k) ? pstart[k] : ps;
        const size_t dest = (size_t)(ps + pos);
        if (lane == 0) { RINFO[2 * dest] = a; RINFO[2 * dest + 1] = gb; }
        if (f8) { const v4u* src = (const v4u*)((const unsigned char*)H + (size_t)(a >> 1) * DM); v4u* dst = (v4u*)((unsigned char*)XS + dest * DM); dst[lane] = src[lane]; }
        else { const v4u* src = (const v4u*)(H + (size_t)(a >> 1) * DM); v4u* dst = (v4u*)(XS + dest * DM); dst[lane] = src[lane]; dst[64 + lane] = src[64 + lane]; }
    }
}
__device__ __forceinline__ void final_combine(float* xio, const bf16_t* Y, int gw, int NGW, int lane) {
    for (int row = gw; row < NTOK; row += NGW) {
#pragma unroll
        for (int jj = 0; jj < 4; ++jj) { f32x4 v = ((const f32x4*)(xio + (size_t)row * DM))[64 * jj + lane];
            const v2u a = ((const v2u*)(Y + (size_t)row * DM))[64 * jj + lane], b = ((const v2u*)(Y + ((size_t)NTOK + row) * DM))[64 * jj + lane];
            v[0] += blo(a.x) + blo(b.x); v[1] += bhi(a.x) + bhi(b.x); v[2] += blo(a.y) + blo(b.y); v[3] += bhi(a.y) + bhi(b.y);
            ((f32x4*)(xio + (size_t)row * DM))[64 * jj + lane] = v; }
    }
}
#define XB_TMO      128
#define XB_XCNT(j)  (256  + 64 * (j))
#define XB_XSUB(j)  (1280 + 64 * (j))
#define XB_XGEN(j)  (2304 + 64 * (j))
#define XB_TOP      3328
#define XB_TOPGEN   3392
#define XCD_BAR_WORDS 3456
#define XB_SPIN_CAP (1u << 18)

__device__ __forceinline__ unsigned xb_ld(unsigned* p)              { return __hip_atomic_load(p, __ATOMIC_RELAXED, __HIP_MEMORY_SCOPE_AGENT); }
__device__ __forceinline__ unsigned xb_add(unsigned* p, unsigned v) { return __hip_atomic_fetch_add(p, v, __ATOMIC_RELAXED, __HIP_MEMORY_SCOPE_AGENT); }
__device__ __forceinline__ unsigned xb_xcc_id() { return (unsigned)__builtin_amdgcn_s_getreg((3 << 11) | 20) & 0xFu; }
#define XB_SPIN(cond, bar) do { unsigned _sp = 0; while (cond) { __builtin_amdgcn_s_sleep(1); \
    if ((++_sp & 255u) == 0u) { if (xb_ld(&(bar)[XB_TMO])) break; if (_sp > XB_SPIN_CAP) { atomicAdd(&(bar)[XB_TMO], 1u); break; } } } } while (0)

struct XcdBarrier {
    unsigned* bar; unsigned x;
    volatile LAS unsigned* st;
};

__device__ __forceinline__ XcdBarrier xcd_barrier_post(unsigned* bar, volatile LAS unsigned* st) {
    XcdBarrier b; b.bar = bar; b.x = xb_xcc_id(); b.st = st;
    if (threadIdx.x == 0) (void)xb_add(&bar[XB_XCNT(b.x)], 1u);
    return b;
}
__device__ __forceinline__ void xcd_barrier_complete(unsigned* bar, unsigned x, unsigned& nloc, unsigned& nx) {
    const unsigned G = gridDim.x * gridDim.y * gridDim.z;
    unsigned sum, cnt, mine, sp = 0u;
    for (;;) {
        sum = 0u; cnt = 0u; mine = 0u;
#pragma unroll
        for (unsigned j = 0; j < 16; ++j) { const unsigned c = xb_ld(&bar[XB_XCNT(j)]); sum += c; cnt += (c > 0u) ? 1u : 0u; mine = (j == x) ? c : mine; }
        if (sum == G) break;
        __builtin_amdgcn_s_sleep(1);
        if ((++sp & 255u) == 0u) { if (xb_ld(&bar[XB_TMO])) break; if (sp > XB_SPIN_CAP) { atomicAdd(&bar[XB_TMO], 1u); break; } }
    }
    nloc = mine > 0u ? mine : 1u; nx = cnt > 0u ? cnt : 1u;
}

__device__ __forceinline__ void xcd_barrier(const XcdBarrier& b) {
    asm volatile("s_waitcnt vmcnt(0)" ::: "memory");
    __syncthreads();
    if (threadIdx.x == 0) {
        unsigned* bar = b.bar;
        __builtin_amdgcn_s_waitcnt(0);
        unsigned nloc = b.st[0], nx = b.st[1];
        if (nloc == 0u) { xcd_barrier_complete(bar, b.x, nloc, nx); b.st[0] = nloc; b.st[1] = nx; }
        const unsigned old = xb_add(&bar[XB_XSUB(b.x)], 1u);
        const unsigned gen = old / nloc;
        if (old + 1u == (gen + 1u) * nloc) {
            __builtin_amdgcn_fence(__ATOMIC_RELEASE, "agent");
            asm volatile("s_waitcnt vmcnt(0)" ::: "memory");
            const unsigned og = xb_add(&bar[XB_TOP], 1u);
            const unsigned tg = og / nx;
            if (og + 1u == (tg + 1u) * nx) xb_add(&bar[XB_TOPGEN], 1u);
            else XB_SPIN(xb_ld(&bar[XB_TOPGEN]) == tg, bar);
            __builtin_amdgcn_fence(__ATOMIC_ACQUIRE, "agent");
            xb_add(&bar[XB_XGEN(b.x)], 1u);
            asm volatile("s_waitcnt vmcnt(0)" ::: "memory");
        } else {
            XB_SPIN(xb_ld(&bar[XB_XGEN(b.x)]) == gen, bar);
            __builtin_amdgcn_fence(__ATOMIC_ACQUIRE, "agent");
            asm volatile("s_waitcnt vmcnt(0)" ::: "memory");
        }
    }
    __syncthreads();
}


struct Args {
    const float* in[25]; float* out; unsigned char* ws; int pad0, pad1;
};
typedef const Args __attribute__((address_space(4)))* KArgs;
enum { I_X = 0, I_GMIX, I_WIN, I_BF, I_GQ, I_GK, I_GSGU, I_WSP, I_BSP, I_WDW, I_BDW, I_GCONV, I_WPOOL, I_PSCALE, I_WBR, I_BGATE, I_WOUT, I_GFFN,
       I_WFG, I_WFU, I_WFD, I_WROUTER, I_WEG, I_WEU, I_WED };
__device__ __forceinline__ int opaque_v(int v) { asm volatile("" : "+v"(v)); return v; }
__device__ __forceinline__ KArgs kargs() { KArgs p = (KArgs)__builtin_amdgcn_kernarg_segment_ptr(); asm volatile("" : "+s"(p)); return p; }

#ifndef F8_MASK
#define F8_MASK 0x8
#endif
constexpr float W8S_UP = 32.0f, W8S_DN = 64.0f;
#ifndef MK_ONLY
#define MK_ONLY -1
#endif
#define PH(n) (MK_ONLY < 0 || MK_ONLY == (n))
#ifndef MK_DUP
#define MK_DUP -1
#endif
#define DUP(n) for (int rep_ = 0; rep_ < ((MK_DUP == (n)) ? 2 : 1); ++rep_)

__global__ void __launch_bounds__(NWAVES * 64, 2) fwd_kernel(Args args_unused) {
    extern __shared__ __attribute__((aligned(16))) unsigned char lds_raw[];
    LAS unsigned char* lds = (LAS unsigned char*)lds_raw;
    const int tid = threadIdx.x, lane = tid & 63, wave = __builtin_amdgcn_readfirstlane(tid >> 6);
    const int G = gridDim.x, bx = blockIdx.x;
    const int gw = bx * NWAVES + wave, NGW = G * NWAVES;
    volatile LAS unsigned* MISC = (volatile LAS unsigned*)(lds + MISC_OFF);
    for (int u = tid; u < 64; u += NWAVES * 64) ((LAS unsigned*)(lds + MISC_OFF))[u] = 0u;
    __syncthreads();
    XcdBarrier bar;
    { KArgs ka = kargs(); bar = xcd_barrier_post((unsigned*)(ka->ws + WS_CTL) + CW_BAR, MISC + 8); }
#define GRID_BAR() do { XcdBarrier b_ = bar; asm volatile("" : "+s"(b_.bar), "+s"(b_.x)); xcd_barrier(b_); } while (0)
    LAS float* scr = (LAS float*)(lds + wave * 16384);

    for (int l = 0; l < NLAYER; ++l) {
        const bool moe = (l & 1) != 0; const int fi = l >> 1;
        if (PH(1)) {
            KArgs ka = kargs(); unsigned char* ws = ka->ws; float* xout = ka->out; const int lane = opaque_v(tid) & 63;
            bf16_t* Wproj = (bf16_t*)(ws + WM_PROJ);
            int off = 0;
            const float* win = ka->in[I_WIN] + (size_t)l * DM * INW;
            DUP(12) {
            tr_segment(win, INW, DM, C_Q, 512, Wproj, 0, 0, scr, gw, NGW, lane, off);
            tr_segment(win, INW, DM, C_K, 512, Wproj, 512, 0, scr, gw, NGW, lane, off);
            tr_segment(win, INW, DM, C_V, 512, (bf16_t*)(ws + WM_V), 0, 0, scr, gw, NGW, lane, off);
            tr_segment(win, INW, DM, C_SU, 1024, Wproj, 1024, 0, scr, gw, NGW, lane, off);
            tr_segment(win, INW, DM, C_CONV, 512, Wproj, 2048, 128, scr, gw, NGW, lane, off);
            tr_segment(win, INW, DM, C_CONV + 512, 512, Wproj, 2048 + 128, 128, scr, gw, NGW, lane, off);
            tr_segment(win, INW, DM, C_POOL, 512, Wproj, 3072, 0, scr, gw, NGW, lane, off);
            tr_segment(win, INW, DM, C_GATE, 4096, Wproj, 3584, 0, scr, gw, NGW, lane, off);
            for (int i = 0; i < 4; ++i) tr_segment(ka->in[I_WBR] + ((size_t)l * 4 + i) * 512 * 1024, 1024, 512, 0, 1024, (bf16_t*)(ws + WM_B) + (size_t)i * 1024 * 512, 0, 0, scr, gw, NGW, lane, off);
            tr_segment(ka->in[I_WOUT] + (size_t)l * 1024 * 1024, 1024, 1024, 0, 1024, (bf16_t*)(ws + WM_OUT), 0, 0, scr, gw, NGW, lane, off);
            for (int g = 0; g < 4; ++g) tr_segment(ka->in[I_WPOOL] + ((size_t)l * 4 + g) * 128 * 128, 128, 128, 0, 128, (bf16_t*)(ws + WM_PG) + (size_t)g * 128 * 128, 0, 0, scr, gw, NGW, lane, off);
            { const float* wsp = ka->in[I_WSP] + (size_t)l * 8 * 128 * 128; bf16_t* Wsp = (bf16_t*)(ws + WM_SP);
              for (int i = bx * 512 + opaque_v(tid); i < 8 * 128 * 128; i += G * 512) { const int t = (i >> 7) & 127, s = i & 127; Wsp[i] = (s <= t) ? f2bf(wsp[i]) : (bf16_t)0; } }
            }
            const float* xin = (l == 0) ? ka->in[I_X] : xout;
            const bf16_t* yc = (l > 0 && ((l - 1) & 1)) ? (const bf16_t*)(ws + WS_XS) : nullptr;
            for (int rep_ = 0; rep_ < ((MK_DUP == 13 && yc == nullptr) ? 2 : 1); ++rep_) norm_rows<0>(xin, xout, yc != nullptr, yc, ka->in[I_GMIX] + l * DM, (bf16_t*)(ws + WS_H), nullptr, win + C_F, INW, ka->in[I_BF] + l * 8, (float*)(ws + WS_LF), nullptr, nullptr, gw, NGW, lane);
        }
        GRID_BAR();
        DUP(2) if (PH(2)) {
            KArgs ka = kargs(); unsigned char* ws = ka->ws;
            pg8::Gemm g{(bf16_t*)(ws + WS_H), (bf16_t*)(ws + WM_PROJ), NTOK, NPROJ, DM}; pg8::StaticOrder S; S.init(NTOK, NPROJ, G, bx);
            pg8::EpiProj E{ws, ka->in[I_BGATE] + (size_t)l * 4096, WS_Q, WS_K, WS_SUV, WS_CY, WS_PIN, WS_G};
            pg8::gemm_phase<pg8::EpiProj, pg8::StaticOrder, true, true>(lds, g, S, E);
        }
        DUP(2) if (PH(2)) {
            KArgs ka = kargs(); unsigned char* ws = ka->ws;
            pg8::Gemm g2{(bf16_t*)(ws + WM_V), (bf16_t*)(ws + WS_H), 512, NTOK, DM}; pg8::StaticOrder S2; S2.init(512, NTOK, G, bx);
            pg8::EpiBf16<0> E2{(bf16_t*)(ws + WS_VT), NTOK, nullptr, 0, 0, 1.f};
            pg8::gemm_phase<pg8::EpiBf16<0>, pg8::StaticOrder, true, true>(lds, g2, S2, E2);
        }
        GRID_BAR();
        DUP(3) if (PH(3)) {
#ifndef MK_NO_ATTN
            DUP(31) for (int i = 0;; ++i) {
                int bh, qb;
                if (G == 256) { if (i >= 4) break; bh = bx >> 1; const int s = (bx & 1); qb = (i == 0) ? s : (i == 1) ? 7 - s : (i == 2) ? 2 + s : 5 - s; }
                else { const int u = i * G + bx; if (u >= 1024) break; bh = u >> 3; qb = u & 7; }
                KArgs ka = kargs(); unsigned char* ws = ka->ws;
                attn_unit(lds, bh >> 3, bh & 7, qb, (const bf16_t*)(ws + WS_Q), (const bf16_t*)(ws + WS_K), (const bf16_t*)(ws + WS_VT), (const float*)(ws + WS_LF),
                          ka->in[I_GQ] + l * 64, ka->in[I_GK] + l * 64, (bf16_t*)(ws + WS_YS), opaque_v(tid));
            }
#endif
#ifndef MK_NO_SGU
            DUP(32) for (int c = bx; c < 256; c += G) {
                KArgs ka = kargs(); unsigned char* ws = ka->ws;
                sgu_unit(lds, c, (const bf16_t*)(ws + WS_SUV), ka->in[I_GSGU] + l * 512, (const bf16_t*)(ws + WM_SP), ka->in[I_BSP] + l * 8 * 128, (bf16_t*)(ws + WS_YS) + (size_t)NTOK * 512, opaque_v(tid));
            }
#endif
#ifndef MK_NO_CONV
            DUP(33) for (int t = bx; t < 512; t += G) {
                KArgs ka = kargs(); unsigned char* ws = ka->ws;
                conv_unit(lds, t, (const bf16_t*)(ws + WS_CY), ka->in[I_WDW] + (size_t)l * 31 * 512, ka->in[I_BDW] + l * 512, ka->in[I_GCONV] + l * 512, (bf16_t*)(ws + WS_YS) + (size_t)2 * NTOK * 512, opaque_v(tid));
                pool_unit(lds, t, (const bf16_t*)(ws + WS_PIN), (const bf16_t*)(ws + WM_PG), ka->in[I_PSCALE] + l * 512, (bf16_t*)(ws + WS_YS) + (size_t)3 * NTOK * 512, opaque_v(tid));
            }
#endif
        }
        GRID_BAR();
        DUP(4) if (PH(4)) {
            KArgs ka = kargs(); unsigned char* ws = ka->ws;
            pg8::Gemm g{(bf16_t*)(ws + WS_YS), (bf16_t*)(ws + WM_B), 4 * NTOK, 4096, 512}; pg8::MergeOrder S{G, bx};
            pg8::EpiMerge E{(bf16_t*)(ws + WS_G), (bf16_t*)(ws + WS_MG)};
            pg8::gemm_phase<pg8::EpiMerge, pg8::MergeOrder, true, true>(lds, g, S, E);
        }
        GRID_BAR();
        if (PH(5)) {
            KArgs ka = kargs(); unsigned char* ws = ka->ws; float* xout = ka->out;
            pg8::Gemm g{(bf16_t*)(ws + WS_MG), (bf16_t*)(ws + WM_OUT), NTOK, DM, DM}; pg8::StaticOrder S; S.init(NTOK, DM, G, bx);
            pg8::EpiResid E{(l == 0) ? ka->in[I_X] : xout, xout, 1.0f};
            pg8::gemm_phase<pg8::EpiResid, pg8::StaticOrder, true, true>(lds, g, S, E);
        }
        GRID_BAR();
        const bool f8 = ((F8_MASK >> l) & 1) != 0;
        if (PH(6)) {
            KArgs ka = kargs(); unsigned char* ws = ka->ws; float* xout = ka->out; const int lane = opaque_v(tid) & 63;
            bf16_t* Wgu = (bf16_t*)(ws + WF_GU); unsigned char* Wgu8 = ws + WF_GU;
            int off = 0;
            DUP(14) if (!moe) {
                if (!f8) {
                    tr_segment(ka->in[I_WFG] + (size_t)fi * DM * FFD, FFD, DM, 0, FFD, Wgu, 0, 128, scr, gw, NGW, lane, off);
                    tr_segment(ka->in[I_WFU] + (size_t)fi * DM * FFD, FFD, DM, 0, FFD, Wgu, 128, 128, scr, gw, NGW, lane, off);
                    tr_segment(ka->in[I_WFD] + (size_t)fi * FFD * DM, DM, FFD, 0, DM, (bf16_t*)(ws + WF_D_DENSE), 0, 0, scr, gw, NGW, lane, off);
                } else {
                    tr_segment8(ka->in[I_WFG] + (size_t)fi * DM * FFD, FFD, DM, 0, FFD, Wgu8, 0, 128, W8S_UP, scr, gw, NGW, lane, off);
                    tr_segment8(ka->in[I_WFU] + (size_t)fi * DM * FFD, FFD, DM, 0, FFD, Wgu8, 128, 128, W8S_UP, scr, gw, NGW, lane, off);
                    tr_segment8(ka->in[I_WFD] + (size_t)fi * FFD * DM, DM, FFD, 0, DM, ws + WF_D_DENSE, 0, 0, W8S_DN, scr, gw, NGW, lane, off);
                }
            } else {
                for (int e = 0; e < NEXP; ++e) {
                    if (!f8) {
                        tr_segment(ka->in[I_WEG] + ((size_t)fi * NEXP + e) * DM * FFE, FFE, DM, 0, FFE, Wgu + (size_t)e * 2 * FFE * DM, 0, 128, scr, gw, NGW, lane, off);
                        tr_segment(ka->in[I_WEU] + ((size_t)fi * NEXP + e) * DM * FFE, FFE, DM, 0, FFE, Wgu + (size_t)e * 2 * FFE * DM, 128, 128, scr, gw, NGW, lane, off);
                        tr_segment(ka->in[I_WED] + ((size_t)fi * NEXP + e) * FFE * DM, DM, FFE, 0, DM, (bf16_t*)(ws + WF_D_MOE) + (size_t)e * DM * FFE, 0, 0, scr, gw, NGW, lane, off);
                    } else {
                        tr_segment8(ka->in[I_WEG] + ((size_t)fi * NEXP + e) * DM * FFE, FFE, DM, 0, FFE, Wgu8 + (size_t)e * 2 * FFE * DM, 0, 128, W8S_UP, scr, gw, NGW, lane, off);
                        tr_segment8(ka->in[I_WEU] + ((size_t)fi * NEXP + e) * DM * FFE, FFE, DM, 0, FFE, Wgu8 + (size_t)e * 2 * FFE * DM, 128, 128, W8S_UP, scr, gw, NGW, lane, off);
                        tr_segment8(ka->in[I_WED] + ((size_t)fi * NEXP + e) * FFE * DM, DM, FFE, 0, DM, ws + WF_D_MOE + (size_t)e * DM * FFE, 0, 0, W8S_DN, scr, gw, NGW, lane, off);
                    }
                }
            }
            unsigned char* H8 = f8 ? (ws + WS_H) : nullptr;
            DUP(15) if (!moe) norm_rows<1>(xout, xout, false, nullptr, ka->in[I_GFFN] + l * DM, (bf16_t*)(ws + WS_H), H8, nullptr, 0, nullptr, nullptr, nullptr, nullptr, gw, NGW, lane);
            else norm_rows<2>(xout, xout, false, nullptr, ka->in[I_GFFN] + l * DM, (bf16_t*)(ws + WS_H), H8, ka->in[I_WROUTER] + (size_t)fi * DM * 8, 8, nullptr, nullptr, (int*)(ws + WS_ASG),
                             (gu32*)(ws + WS_CTL) + CW_CNT + fi * 1024, gw, NGW, lane);
        }
        GRID_BAR();
        if (!moe) {
            DUP(7) if (PH(7)) {
                KArgs ka = kargs(); unsigned char* ws = ka->ws;
                if (!f8) {
                    pg8::Gemm g{(bf16_t*)(ws + WS_H), (bf16_t*)(ws + WF_GU), NTOK, 2 * FFD, DM}; pg8::StaticOrder S; S.init(NTOK, 2 * FFD, G, bx);
                    pg8::EpiSwiglu E{(bf16_t*)(ws + WS_ACT), FFD, 2 * FFD / 256};
                    pg8::gemm_phase<pg8::EpiSwiglu, pg8::StaticOrder, true, true>(lds, g, S, E);
                } else {
                    pg8::Gemm g{(bf16_t*)(ws + WS_H), (bf16_t*)(ws + WF_GU), NTOK, 2 * FFD, DM / 2}; pg8::StaticOrder S; S.init(NTOK, 2 * FFD, G, bx);
                    pg8::EpiSwiglu8 E{ws + WS_ACT, FFD, 2 * FFD / 256, 1.0f / W8S_UP};
                    pg8::gemm_phase<pg8::EpiSwiglu8, pg8::StaticOrder, true, true, true>(lds, g, S, E);
                }
            }
            GRID_BAR();
            if (PH(8)) {
                KArgs ka = kargs(); unsigned char* ws = ka->ws; float* xout = ka->out;
                if (!f8) {
                    pg8::Gemm g{(bf16_t*)(ws + WS_ACT), (bf16_t*)(ws + WF_D_DENSE), NTOK, DM, FFD}; pg8::StaticOrder S; S.init(NTOK, DM, G, bx);
                    pg8::EpiResid E{xout, xout, 1.0f};
                    pg8::gemm_phase<pg8::EpiResid, pg8::StaticOrder, true, true>(lds, g, S, E);
                } else {
                    pg8::Gemm g{(bf16_t*)(ws + WS_ACT), (bf16_t*)(ws + WF_D_DENSE), NTOK, DM, FFD / 2}; pg8::StaticOrder S; S.init(NTOK, DM, G, bx);
                    pg8::EpiResid E{xout, xout, 1.0f / W8S_DN};
                    pg8::gemm_phase<pg8::EpiResid, pg8::StaticOrder, true, true, true>(lds, g, S, E);
                }
            }
            GRID_BAR();
        } else {
            DUP(9) if (PH(9)) {
                KArgs ka = kargs(); unsigned char* ws = ka->ws;
                { const int t_ = opaque_v(tid); moe_scatter((gu32*)(ws + WS_CTL) + CW_CNT + fi * 1024, (const int*)(ws + WS_ASG), (const bf16_t*)(ws + WS_H), (bf16_t*)(ws + WS_XS), (int*)(ws + WS_RINFO), gw, NGW, t_ & 63, t_, bx, G, f8); }
            }
            GRID_BAR();
            DUP(10) if (PH(10)) {
                KArgs ka = kargs(); unsigned char* ws = ka->ws;
                pg8::GroupedOrder S; S.G = G; S.c = bx; S.nct = 2 * FFE / 256; { int ps[8]; moe_offsets((gu32*)(ws + WS_CTL) + CW_CNT + fi * 1024, ps, S.tend, S.T); }
                if (!f8) {
                    pg8::Gemm g{(bf16_t*)(ws + WS_XS), (bf16_t*)(ws + WF_GU), PMAX, NEXP * 2 * FFE, DM};
                    pg8::EpiSwiglu E{(bf16_t*)(ws + WS_ACT), FFE, 2 * FFE / 256};
                    pg8::gemm_phase<pg8::EpiSwiglu, pg8::GroupedOrder, true, true>(lds, g, S, E);
                } else {
                    pg8::Gemm g{(bf16_t*)(ws + WS_XS), (bf16_t*)(ws + WF_GU), PMAX, NEXP * 2 * FFE, DM / 2};
                    pg8::EpiSwiglu8 E{ws + WS_ACT, FFE, 2 * FFE / 256, 1.0f / W8S_UP};
                    pg8::gemm_phase<pg8::EpiSwiglu8, pg8::GroupedOrder, true, true, true>(lds, g, S, E);
                }
            }
            GRID_BAR();
            DUP(11) if (PH(11)) {
                KArgs ka = kargs(); unsigned char* ws = ka->ws;
                pg8::GroupedOrder S; S.G = G; S.c = bx; S.nct = 4; { int ps[8]; moe_offsets((gu32*)(ws + WS_CTL) + CW_CNT + fi * 1024, ps, S.tend, S.T); }
                if (!f8) {
                    pg8::Gemm g{(bf16_t*)(ws + WS_ACT), (bf16_t*)(ws + WF_D_MOE), PMAX, NEXP * DM, FFE};
                    pg8::EpiDownMoe E{(const int*)(ws + WS_RINFO), (bf16_t*)(ws + WS_XS), 1.0f};
                    pg8::gemm_phase<pg8::EpiDownMoe, pg8::GroupedOrder, true, true>(lds, g, S, E);
                } else {
                    pg8::Gemm g{(bf16_t*)(ws + WS_ACT), (bf16_t*)(ws + WF_D_MOE), PMAX, NEXP * DM, FFE / 2};
                    pg8::EpiDownMoe E{(const int*)(ws + WS_RINFO), (bf16_t*)(ws + WS_XS), 1.0f / W8S_DN};
                    pg8::gemm_phase<pg8::EpiDownMoe, pg8::GroupedOrder, true, true, true>(lds, g, S, E);
                }
            }
            GRID_BAR();
        }
    }
    { KArgs ka = kargs(); final_combine(ka->out, (const bf16_t*)(ka->ws + WS_XS), gw, NGW, opaque_v(tid) & 63); }
}

extern "C" void kernel_launch(void* const* d_in, const int* in_sizes, int n_in, void* d_out, int out_size, void* d_ws, size_t ws_size, hipStream_t stream) {
    static int grid = 0;
    if (grid == 0) {
        if (n_in != 25 || in_sizes[0] != NTOK * DM || out_size != NTOK * DM || ws_size < WS_END) {
            fprintf(stderr, "kernel_launch: unexpected shapes / workspace (n_in %d, in0 %d, out %d, ws %zu < %zu)\n", n_in, n_in > 0 ? in_sizes[0] : -1, out_size, ws_size, (size_t)WS_END); grid = -1; return; }
        int dev = 0, cus = 0, per_cu = 0;
        if (hipGetDevice(&dev) != hipSuccess || hipDeviceGetAttribute(&cus, hipDeviceAttributeMultiprocessorCount, dev) != hipSuccess) { grid = -1; return; }
        if (hipFuncSetAttribute((const void*)fwd_kernel, hipFuncAttributeMaxDynamicSharedMemorySize, LDS_BYTES) != hipSuccess) { fprintf(stderr, "kernel_launch: hipFuncSetAttribute failed\n"); grid = -1; return; }
        if (hipOccupancyMaxActiveBlocksPerMultiprocessor(&per_cu, (const void*)fwd_kernel, NWAVES * 64, LDS_BYTES) != hipSuccess || per_cu < 1) { fprintf(stderr, "kernel_launch: occupancy query reports %d\n", per_cu); }
        (void)hipGetLastError();
        grid = cus;
    }
    if (grid < 0) return;
    if (hipMemsetAsync((char*)d_ws + WS_CTL, 0, CTL_ZERO_BYTES, stream) != hipSuccess) return;
    Args a{};
    for (int i = 0; i < 25; ++i) a.in[i] = (const float*)d_in[i];
    a.out = (float*)d_out; a.ws = (unsigned char*)d_ws;
    hipLaunchKernelGGL(fwd_kernel, dim3(grid), dim3(NWAVES * 64), LDS_BYTES, stream, a);
}
```

```cpp
#include <hip/hip_runtime.h>
#include <cstdio>
#include <cstdint>
namespace pg8 {
#define PG8_LAS __attribute__((address_space(3)))
typedef unsigned short bf16_t;
typedef short bf16x8 __attribute__((ext_vector_type(8)));
typedef float f32x4 __attribute__((ext_vector_type(4)));
typedef unsigned u32x4 __attribute__((ext_vector_type(4)));
constexpr int BM = 256, BK = 64, HALF = 128, HTB = HALF * BK * 2  , STAGE_BYTES = 8 * HTB, NXCD = 8, WGM = 8;

__host__ __device__ __forceinline__ int lds_byte(int r, int c) { const int st = (r >> 4) * 2 + (c >> 5), rr = r & 15, cc = c & 31, ob = rr * 64 + cc * 2; return st * 1024 + (ob ^ (((ob >> 9) & 1) << 5)); }
__host__ __device__ __forceinline__ void stage_rc(int b, int& R, int& C) { const int st = b / 1024, sb = b % 1024, swz = sb ^ (((sb >> 9) & 1) << 5); R = (st >> 1) * 16 + swz / 64; C = (st & 1) * 32 + (swz % 64) / 2; }
__host__ __device__ __forceinline__ int perm32(int rho) { const int n = rho >> 4, i = rho & 15; return 8 * (i >> 2) + 4 * n + (i & 3); }

struct Unit { int pm, pn; };
struct Gemm { const bf16_t* A; const bf16_t* Bt; int M, N, K; };

struct StaticOrder {
    int nM, nN, nwg, G, c;
    __host__ __device__ void init(int M, int N, int G_, int c_) { nM = M / BM; nN = N / BM; nwg = nM * nN; G = G_; c = c_; }
    __host__ __device__ bool next(int i, Unit& u) const {
        const long L = (long)i * G + c; if (L >= nwg) return false;
        int wgid = (int)L; { const int q = nwg / NXCD, r = nwg % NXCD, xcd = wgid % NXCD, off = wgid / NXCD; wgid = (xcd < r ? xcd * (q + 1) : r * (q + 1) + (xcd - r) * q) + off; }
        const int nig = WGM * nN, gid = wgid / nig, fm = gid * WGM, gsz = (nM - fm) < WGM ? (nM - fm) : WGM;
        u.pm = fm + ((wgid % nig) % gsz); u.pn = (wgid % nig) / gsz; return true;
    }
    __device__ __forceinline__ void a_ready(const Unit&) const {}
    __device__ __forceinline__ void done(const Unit&) const {}
};

typedef float pg8_f32x2_t __attribute__((ext_vector_type(2))); typedef __bf16 pg8_bf16x2_t __attribute__((ext_vector_type(2)));
__device__ __forceinline__ unsigned cvt_pk_bf16(float lo, float hi) { pg8_f32x2_t v = {lo, hi}; pg8_bf16x2_t b = __builtin_convertvector(v, pg8_bf16x2_t); return __builtin_bit_cast(unsigned, b); }
typedef float f32x2 __attribute__((ext_vector_type(2)));
__device__ __forceinline__ f32x2 gelu_pk(f32x2 v) {
    const f32x2 av = __builtin_elementwise_abs(v), d = av * 0.2316418882f + 1.0f;
    f32x2 t; t.x = __builtin_amdgcn_rcpf(d.x); t.y = __builtin_amdgcn_rcpf(d.y);
    f32x2 q = t * 0.5307027145f + (-0.7265760135f); q = q * t + 0.7107068705f; q = q * t + (-0.142248368f); q = q * t + 0.127414796f; q = q * t;
    const f32x2 s = (v * v) * (-0.72134752044f);
    f32x2 e; e.x = __builtin_amdgcn_exp2f(s.x); e.y = __builtin_amdgcn_exp2f(s.y);
    const f32x2 m = v * (q * e), r = v - m;
    f32x2 o; o.x = v.x < 0.f ? m.x : r.x; o.y = v.y < 0.f ? m.y : r.y; return o;
}

template <int ACT  > struct EpiBf16 {
    static constexpr bool PERM = true, AFTER_DRAIN = false; static_assert(ACT == 0 || ACT == 1, "EpiBf16: ACT is 0 (none) or 1 (gelu_pk)");
    bf16_t* O; int ldc; const float* bias; int split_cols; size_t split_stride; float scale0;
    __device__ __forceinline__ void operator()(const f32x4 (&acc)[2][2][4][2], const Unit& u, int wr, int wc, int fr, int fq) const {
        const int row0 = u.pm * BM + wr * 64 + fr; int colt = u.pn * BM; bf16_t* base = O;
        float sc = 1.f; if (split_cols) { const int t = colt / split_cols; base += (size_t)t * split_stride; colt -= t * split_cols; if (t == 0) sc = scale0; }
        const int col0 = colt + wc * 32 + 8 * fq, bcol0 = u.pn * BM + wc * 32 + 8 * fq;
        f32x4 bv[2][2];
#pragma unroll
        for (int bj = 0; bj < 2; ++bj)
#pragma unroll
            for (int n = 0; n < 2; ++n) bv[bj][n] = bias ? *(const f32x4*)(bias + bcol0 + bj * HALF + 4 * n) : (f32x4){0.f, 0.f, 0.f, 0.f};
#pragma unroll
        for (int ai = 0; ai < 2; ++ai)
#pragma unroll
            for (int m = 0; m < 4; ++m) { bf16_t* rowp = base + (size_t)(row0 + ai * HALF + m * 16) * ldc + col0;
#pragma unroll
                for (int bj = 0; bj < 2; ++bj) { f32x4 v0 = acc[ai][bj][m][0] + bv[bj][0], v1 = acc[ai][bj][m][1] + bv[bj][1];
                    if (ACT == 1) { f32x2 a = gelu_pk((f32x2){v0[0], v0[1]}), b = gelu_pk((f32x2){v0[2], v0[3]}), c = gelu_pk((f32x2){v1[0], v1[1]}), d = gelu_pk((f32x2){v1[2], v1[3]});
                        v0 = (f32x4){a.x, a.y, b.x, b.y}; v1 = (f32x4){c.x, c.y, d.x, d.y}; }
                    v0 = v0 * sc; v1 = v1 * sc; u32x4 w; w.x = cvt_pk_bf16(v0[0], v0[1]); w.y = cvt_pk_bf16(v0[2], v0[3]); w.z = cvt_pk_bf16(v1[0], v1[1]); w.w = cvt_pk_bf16(v1[2], v1[3]);
                    *(u32x4*)(rowp + bj * HALF) = w; } }
    }
};


typedef unsigned u32x2 __attribute__((ext_vector_type(2)));
typedef int i32x8 __attribute__((ext_vector_type(8))); typedef int i32x4 __attribute__((ext_vector_type(4)));
__device__ __forceinline__ i32x8 cat8(bf16x8 a, bf16x8 b) { const i32x4 x = __builtin_bit_cast(i32x4, a), y = __builtin_bit_cast(i32x4, b); return __builtin_shufflevector(x, y, 0, 1, 2, 3, 4, 5, 6, 7); }
__device__ __forceinline__ unsigned pk4_fp8(float a, float b, float c, float d) {
    a = __builtin_fminf(__builtin_fmaxf(a, -448.f), 448.f); b = __builtin_fminf(__builtin_fmaxf(b, -448.f), 448.f); c = __builtin_fminf(__builtin_fmaxf(c, -448.f), 448.f); d = __builtin_fminf(__builtin_fmaxf(d, -448.f), 448.f);
    int w = 0; w = __builtin_amdgcn_cvt_pk_fp8_f32(a, b, w, false); w = __builtin_amdgcn_cvt_pk_fp8_f32(c, d, w, true); return (unsigned)w; }
__device__ __forceinline__ float fast_sigmoid(float x) { return __builtin_amdgcn_rcpf(1.0f + __builtin_amdgcn_exp2f(-1.4426950408889634f * x)); }
__device__ __forceinline__ f32x4 sigmoid4(f32x4 x) { f32x4 e = x * -1.4426950408889634f;
#pragma unroll
    for (int i = 0; i < 4; ++i) e[i] = __builtin_amdgcn_exp2f(e[i]);
    e = e + 1.0f;
#pragma unroll
    for (int i = 0; i < 4; ++i) e[i] = __builtin_amdgcn_rcpf(e[i]);
    return e; }
__device__ __forceinline__ f32x4 gelu_tanh4(f32x4 x) { const f32x4 a = x * (x * x * 0.044715f + 1.0f) * 1.5957691216057308f; return x * sigmoid4(a); }
__device__ __forceinline__ float gelu_tanh(float x) {
    const float a = 1.5957691216057308f * (x + 0.044715f * x * x * x);
    return x * fast_sigmoid(a);
}
__device__ __forceinline__ float bf_lo(unsigned w) { return __uint_as_float(w << 16); }
__device__ __forceinline__ float bf_hi(unsigned w) { return __uint_as_float(w & 0xffff0000u); }
__device__ __forceinline__ u32x4 pack8(f32x4 v0, f32x4 v1) { u32x4 w; w.x = cvt_pk_bf16(v0[0], v0[1]); w.y = cvt_pk_bf16(v0[2], v0[3]); w.z = cvt_pk_bf16(v1[0], v1[1]); w.w = cvt_pk_bf16(v1[2], v1[3]); return w; }

struct EpiProj {
    static constexpr bool PERM = true, AFTER_DRAIN = false;
    unsigned char* ws; size_t oQ, oK, oSUV, oCY, oPIN; const float* gq; const float* gk;
    __device__ __forceinline__ void operator()(const f32x4 (&acc)[2][2][4][2], const Unit& u, int wr, int wc, int fr, int fq) const {
        const int row0 = u.pm * BM + wr * 64 + fr; const int pn = u.pn; const int cw = wc * 32 + 8 * fq;
        if (pn >= 8 && pn < 12) {
            bf16_t* base = (bf16_t*)(ws + oCY) + (pn - 8) * HALF + cw;
#pragma unroll
            for (int ai = 0; ai < 2; ++ai)
#pragma unroll
                for (int m = 0; m < 4; ++m) { bf16_t* rowp = base + (size_t)(row0 + ai * HALF + m * 16) * 512;
                    f32x4 v0 = acc[ai][0][m][0], v1 = acc[ai][0][m][1]; const f32x4 g0 = acc[ai][1][m][0], g1 = acc[ai][1][m][1];
                    v0 = v0 * sigmoid4(g0); v1 = v1 * sigmoid4(g1);
                    *(u32x4*)rowp = pack8(v0, v1); }
        } else {
            if (pn < 4) {
                const bool isq = pn < 2; const float* gv = isq ? gq : gk; bf16_t* base = (bf16_t*)(ws + (isq ? oQ : oK)) + (pn & 1) * BM + wc * 64 + 8 * fq;
                f32x4 gg[2][2];
#pragma unroll
                for (int bj = 0; bj < 2; ++bj)
#pragma unroll
                    for (int n = 0; n < 2; ++n) gg[bj][n] = *(const f32x4*)(gv + 32 * bj + 8 * fq + 4 * n);
                const float post = isq ? 0.125f * 1.4426950408889634f : 1.0f;
#pragma unroll
                for (int ai = 0; ai < 2; ++ai)
#pragma unroll
                    for (int m = 0; m < 4; ++m) { float ss = 0.f;
#pragma unroll
                        for (int bj = 0; bj < 2; ++bj)
#pragma unroll
                            for (int n = 0; n < 2; ++n) { const f32x4 a = acc[ai][bj][m][n]; ss += (a[0] * a[0] + a[1] * a[1]) + (a[2] * a[2] + a[3] * a[3]); }
                        ss += __shfl_xor(ss, 16); ss += __shfl_xor(ss, 32);
                        const float r = __builtin_amdgcn_rsqf(ss * (1.0f / 64.0f) + 1e-6f) * post;
                        bf16_t* rowp = base + (size_t)(row0 + ai * HALF + m * 16) * 512;
#pragma unroll
                        for (int bj = 0; bj < 2; ++bj) *(u32x4*)(rowp + 32 * bj) = pack8(acc[ai][bj][m][0] * r * gg[bj][0], acc[ai][bj][m][1] * r * gg[bj][1]); }
                return;
            }
            size_t boff; int ld, colt, kind;
            if (pn < 8) { boff = oSUV; ld = 1024; colt = (pn - 4) * BM; kind = 1; }
            else { boff = oPIN; ld = 512; colt = (pn - 12) * BM; kind = 0; }
            bf16_t* base = (bf16_t*)(ws + boff) + colt + cw;
#pragma unroll
            for (int ai = 0; ai < 2; ++ai)
#pragma unroll
                for (int m = 0; m < 4; ++m) { bf16_t* rowp = base + (size_t)(row0 + ai * HALF + m * 16) * ld;
#pragma unroll
                    for (int bj = 0; bj < 2; ++bj) { f32x4 v0 = acc[ai][bj][m][0], v1 = acc[ai][bj][m][1];
                        if (kind == 1) { v0 = gelu_tanh4(v0); v1 = gelu_tanh4(v1); }
                        *(u32x4*)(rowp + bj * HALF) = pack8(v0, v1); } }
        }
    }
};
struct EpiProjI8 {
    static constexpr bool PERM = true, AFTER_DRAIN = false;
    unsigned char* ws; size_t oQ, oK, oSUV, oCY, oPIN; const float* gq; const float* gk; const float* rs; float wsc;
    __device__ __forceinline__ void operator()(const f32x4 (&acc)[2][2][4][2], const Unit& u, int wr, int wc, int fr, int fq) const {
        const int row0 = u.pm * BM + wr * 64 + fr; const int pn = u.pn; const int cw = wc * 32 + 8 * fq;
        float rsc[2][4];
#pragma unroll
        for (int ai = 0; ai < 2; ++ai)
#pragma unroll
            for (int m = 0; m < 4; ++m) rsc[ai][m] = rs[row0 + ai * HALF + m * 16] * wsc;
#define CV(A, S) (__builtin_convertvector(__builtin_bit_cast(i32x4, (A)), f32x4) * (S))
        if (pn >= 8 && pn < 12) {
            bf16_t* base = (bf16_t*)(ws + oCY) + (pn - 8) * HALF + cw;
#pragma unroll
            for (int ai = 0; ai < 2; ++ai)
#pragma unroll
                for (int m = 0; m < 4; ++m) { bf16_t* rowp = base + (size_t)(row0 + ai * HALF + m * 16) * 512;
                    const float sc = rsc[ai][m]; f32x4 v0 = CV(acc[ai][0][m][0], sc), v1 = CV(acc[ai][0][m][1], sc); const f32x4 g0 = CV(acc[ai][1][m][0], sc), g1 = CV(acc[ai][1][m][1], sc);
                    v0 = v0 * sigmoid4(g0); v1 = v1 * sigmoid4(g1);
                    *(u32x4*)rowp = pack8(v0, v1); }
        } else {
            if (pn < 4) {
                const bool isq = pn < 2; const float* gv = isq ? gq : gk; bf16_t* base = (bf16_t*)(ws + (isq ? oQ : oK)) + (pn & 1) * BM + wc * 64 + 8 * fq;
                f32x4 gg[2][2];
#pragma unroll
                for (int bj = 0; bj < 2; ++bj)
#pragma unroll
                    for (int n = 0; n < 2; ++n) gg[bj][n] = *(const f32x4*)(gv + 32 * bj + 8 * fq + 4 * n);
                const float post = isq ? 0.125f * 1.4426950408889634f : 1.0f;
#pragma unroll
                for (int ai = 0; ai < 2; ++ai)
#pragma unroll
                    for (int m = 0; m < 4; ++m) { float ss = 0.f; const float sc = rsc[ai][m]; f32x4 cv[2][2];
#pragma unroll
                        for (int bj = 0; bj < 2; ++bj)
#pragma unroll
                            for (int n = 0; n < 2; ++n) { const f32x4 a = CV(acc[ai][bj][m][n], sc); cv[bj][n] = a; ss += (a[0] * a[0] + a[1] * a[1]) + (a[2] * a[2] + a[3] * a[3]); }
                        ss += __shfl_xor(ss, 16); ss += __shfl_xor(ss, 32);
                        const float r = __builtin_amdgcn_rsqf(ss * (1.0f / 64.0f) + 1e-6f) * post;
                        bf16_t* rowp = base + (size_t)(row0 + ai * HALF + m * 16) * 512;
#pragma unroll
                        for (int bj = 0; bj < 2; ++bj) *(u32x4*)(rowp + 32 * bj) = pack8(cv[bj][0] * r * gg[bj][0], cv[bj][1] * r * gg[bj][1]); }
                return;
            }
            size_t boff; int ld, colt, kind;
            if (pn < 8) { boff = oSUV; ld = 1024; colt = (pn - 4) * BM; kind = 1; }
            else { boff = oPIN; ld = 512; colt = (pn - 12) * BM; kind = 0; }
            bf16_t* base = (bf16_t*)(ws + boff) + colt + cw;
#pragma unroll
            for (int ai = 0; ai < 2; ++ai)
#pragma unroll
                for (int m = 0; m < 4; ++m) { bf16_t* rowp = base + (size_t)(row0 + ai * HALF + m * 16) * ld;
#pragma unroll
                    for (int bj = 0; bj < 2; ++bj) { f32x4 v0 = CV(acc[ai][bj][m][0], rsc[ai][m]), v1 = CV(acc[ai][bj][m][1], rsc[ai][m]);
                        if (kind == 1) { v0 = gelu_tanh4(v0); v1 = gelu_tanh4(v1); }
                        *(u32x4*)(rowp + bj * HALF) = pack8(v0, v1); } }
        }
    }
#undef CV
};


struct EpiVtI8 {
    static constexpr bool PERM = true, AFTER_DRAIN = false;
    bf16_t* O; int ldc; const float* cs; float wsc; int karg_off, vmax_off;
    __device__ __forceinline__ void operator()(const f32x4 (&acc)[2][2][4][2], const Unit& u, int wr, int wc, int fr, int fq) const {
        const int row0 = u.pm * BM + wr * 64 + fr, col0 = u.pn * BM + wc * 32 + 8 * fq;
        float am = 0.f;
#pragma unroll
        for (int bj = 0; bj < 2; ++bj) {
            const f32x4 s0 = *(const f32x4*)(cs + col0 + bj * HALF) * wsc, s1 = *(const f32x4*)(cs + col0 + bj * HALF + 4) * wsc;
#pragma unroll
            for (int ai = 0; ai < 2; ++ai)
#pragma unroll
                for (int m = 0; m < 4; ++m) { const f32x4 v0 = __builtin_convertvector(__builtin_bit_cast(i32x4, acc[ai][bj][m][0]), f32x4) * s0, v1 = __builtin_convertvector(__builtin_bit_cast(i32x4, acc[ai][bj][m][1]), f32x4) * s1;
#pragma unroll
                    for (int e = 0; e < 4; ++e) am = __builtin_fmaxf(am, __builtin_fmaxf(__builtin_fabsf(v0[e]), __builtin_fabsf(v1[e])));
                    *(u32x4*)(O + (size_t)(row0 + ai * HALF + m * 16) * ldc + col0 + bj * HALF) = pack8(v0, v1); }
        }
#pragma unroll
        for (int o = 1; o < 64; o <<= 1) am = __builtin_fmaxf(am, __shfl_xor(am, o));
        am *= 1.00390625f;
        { const char __attribute__((address_space(4)))* kp = (const char __attribute__((address_space(4)))*)__builtin_amdgcn_kernarg_segment_ptr(); asm volatile("" : "+s"(kp));
          unsigned char* wsb = *(unsigned char* const __attribute__((address_space(4)))*)(kp + karg_off);
          if ((fr | fq) == 0) __hip_atomic_fetch_max((unsigned*)(wsb + vmax_off) + (u.pn >> 3), __float_as_uint(am), __ATOMIC_RELAXED, __HIP_MEMORY_SCOPE_AGENT); }
    }
};

struct EpiGate8 {
    static constexpr bool PERM = true, AFTER_DRAIN = false;
    bf16_t* G; const float* bgate; float sc;
    __device__ __forceinline__ void operator()(const f32x4 (&acc)[2][2][4][2], const Unit& u, int wr, int wc, int fr, int fq) const {
        const int row0 = u.pm * BM + wr * 64 + fr, col0 = u.pn * BM + wc * 32 + 8 * fq;
        f32x4 bv[2][2];
#pragma unroll
        for (int bj = 0; bj < 2; ++bj)
#pragma unroll
            for (int n = 0; n < 2; ++n) bv[bj][n] = *(const f32x4*)(bgate + col0 + bj * HALF + 4 * n);
#pragma unroll
        for (int ai = 0; ai < 2; ++ai)
#pragma unroll
            for (int m = 0; m < 4; ++m) { bf16_t* rowp = G + (size_t)(row0 + ai * HALF + m * 16) * 4096 + col0;
#pragma unroll
                for (int bj = 0; bj < 2; ++bj) { f32x4 v0 = acc[ai][bj][m][0] * sc + bv[bj][0], v1 = acc[ai][bj][m][1] * sc + bv[bj][1];
#pragma unroll
                    for (int e = 0; e < 4; ++e) { v0[e] = fast_sigmoid(v0[e]); v1[e] = fast_sigmoid(v1[e]); }
                    __builtin_nontemporal_store(pack8(v0, v1), (u32x4*)(rowp + bj * HALF)); } }
    }
};

struct EpiGateI8 {
    static constexpr bool PERM = true, AFTER_DRAIN = false;
    unsigned char* G; const float* bgate; const float* rs; float wsc;
    __device__ __forceinline__ void operator()(const f32x4 (&acc)[2][2][4][2], const Unit& u, int wr, int wc, int fr, int fq) const {
        const int row0 = u.pm * BM + wr * 64 + fr, col0 = u.pn * BM + wc * 32 + 8 * fq;
        f32x4 bv[2][2]; float rsc[2][4];
#pragma unroll
        for (int bj = 0; bj < 2; ++bj)
#pragma unroll
            for (int n = 0; n < 2; ++n) bv[bj][n] = *(const f32x4*)(bgate + col0 + bj * HALF + 4 * n) * -1.4426950408889634f;
#pragma unroll
        for (int ai = 0; ai < 2; ++ai)
#pragma unroll
            for (int m = 0; m < 4; ++m) rsc[ai][m] = rs[row0 + ai * HALF + m * 16] * (wsc * -1.4426950408889634f);
#pragma unroll
        for (int ai = 0; ai < 2; ++ai)
#pragma unroll
            for (int m = 0; m < 4; ++m) { unsigned char* rowp = G + (size_t)(row0 + ai * HALF + m * 16) * 4096 + col0; const float sc = rsc[ai][m];
#pragma unroll
                for (int bj = 0; bj < 2; ++bj) { const i32x4 a0 = __builtin_bit_cast(i32x4, acc[ai][bj][m][0]), a1 = __builtin_bit_cast(i32x4, acc[ai][bj][m][1]);
                    f32x4 v0 = __builtin_convertvector(a0, f32x4) * sc + bv[bj][0], v1 = __builtin_convertvector(a1, f32x4) * sc + bv[bj][1];
#pragma unroll
                    for (int e = 0; e < 4; ++e) { v0[e] = __builtin_amdgcn_exp2f(v0[e]); v1[e] = __builtin_amdgcn_exp2f(v1[e]); }
                    v0 = v0 * (1.0f / 255.0f) + (1.0f / 255.0f); v1 = v1 * (1.0f / 255.0f) + (1.0f / 255.0f);
#pragma unroll
                    for (int e = 0; e < 4; ++e) { v0[e] = __builtin_amdgcn_rcpf(v0[e]); v1[e] = __builtin_amdgcn_rcpf(v1[e]); }
                    unsigned p0 = 0u, p1 = 0u;
#pragma unroll
                    for (int e = 0; e < 4; ++e) { p0 = __builtin_amdgcn_cvt_pk_u8_f32(__builtin_rintf(v0[e]), e, p0); p1 = __builtin_amdgcn_cvt_pk_u8_f32(__builtin_rintf(v1[e]), e, p1); }
                    typedef unsigned u32x2_g __attribute__((ext_vector_type(2)));
                    *(u32x2_g*)(rowp + bj * HALF) = (u32x2_g){p0, p1}; } }
    }
};

struct EpiMerge {
    static constexpr bool PERM = true, AFTER_DRAIN = false;
    const bf16_t* G; bf16_t* MG;
    __device__ __forceinline__ void operator()(const f32x4 (&acc)[2][2][4][2], const Unit& u, int wr, int wc, int fr, int fq) const {
        const int br = u.pn >> 2, ct = u.pn & 3, rt = u.pm - br * 128;
        const int row0 = rt * BM + wr * 64 + fr, col0 = ct * BM + wc * 32 + 8 * fq;
#pragma unroll
        for (int ai = 0; ai < 2; ++ai) {
            u32x4 g[4][2], o[4][2];
#pragma unroll
            for (int m = 0; m < 4; ++m) { const size_t row = (size_t)(row0 + ai * HALF + m * 16);
#pragma unroll
                for (int bj = 0; bj < 2; ++bj) { const int col = col0 + bj * HALF;
                    g[m][bj] = *(const u32x4*)(G + row * 4096 + br * 1024 + col);
                    o[m][bj] = (br > 0) ? *(const u32x4*)(MG + row * 1024 + col) : (u32x4){0u, 0u, 0u, 0u}; } }
#pragma unroll
            for (int m = 0; m < 4; ++m) { const size_t row = (size_t)(row0 + ai * HALF + m * 16);
#pragma unroll
                for (int bj = 0; bj < 2; ++bj) { const int col = col0 + bj * HALF; const u32x4 gg = g[m][bj], oo = o[m][bj];
                    f32x4 v0 = acc[ai][bj][m][0], v1 = acc[ai][bj][m][1];
                    v0[0] = v0[0] * bf_lo(gg.x) + bf_lo(oo.x); v0[1] = v0[1] * bf_hi(gg.x) + bf_hi(oo.x); v0[2] = v0[2] * bf_lo(gg.y) + bf_lo(oo.y); v0[3] = v0[3] * bf_hi(gg.y) + bf_hi(oo.y);
                    v1[0] = v1[0] * bf_lo(gg.z) + bf_lo(oo.z); v1[1] = v1[1] * bf_hi(gg.z) + bf_hi(oo.z); v1[2] = v1[2] * bf_lo(gg.w) + bf_lo(oo.w); v1[3] = v1[3] * bf_hi(gg.w) + bf_hi(oo.w);
                    *(u32x4*)(MG + row * 1024 + col) = pack8(v0, v1); } }
        }
    }
};
struct EpiMerge2 {
    const unsigned char* G; bf16_t* MG; const float* rs; int rstride; float wsc;
    __device__ __forceinline__ void operator()(const f32x4 (&acc)[2][4][2], u32x4 (&mgp)[2][4], const Unit& u, int wr, int wc, int fr, int fq) const {
        const int br = u.pn >> 3, ct = u.pn & 7, rt = u.pm - br * 128;
        const int row0 = rt * BM + wr * 64 + fr, col0 = ct * HALF + wc * 32 + 8 * fq;
        typedef unsigned u32x2_g __attribute__((ext_vector_type(2)));
        u32x2_g g[2][4]; float rsc[2][4];
#pragma unroll
        for (int ai = 0; ai < 2; ++ai)
#pragma unroll
            for (int m = 0; m < 4; ++m) { g[ai][m] = *(const u32x2_g*)(G + (size_t)(row0 + ai * HALF + m * 16) * 4096 + br * 1024 + col0); rsc[ai][m] = rs[(size_t)br * rstride + row0 + ai * HALF + m * 16] * wsc; }
#pragma unroll
        for (int ai = 0; ai < 2; ++ai)
#pragma unroll
            for (int m = 0; m < 4; ++m) { const u32x2_g gg = g[ai][m]; f32x4 v0 = __builtin_convertvector(__builtin_bit_cast(i32x4, acc[ai][m][0]), f32x4) * rsc[ai][m], v1 = __builtin_convertvector(__builtin_bit_cast(i32x4, acc[ai][m][1]), f32x4) * rsc[ai][m];
                v0[0] *= (float)(gg.x & 255u); v0[1] *= (float)((gg.x >> 8) & 255u); v0[2] *= (float)((gg.x >> 16) & 255u); v0[3] *= (float)(gg.x >> 24);
                v1[0] *= (float)(gg.y & 255u); v1[1] *= (float)((gg.y >> 8) & 255u); v1[2] *= (float)((gg.y >> 16) & 255u); v1[3] *= (float)(gg.y >> 24);
                if (br != 0) { const u32x4 oo = mgp[ai][m];
                    v0[0] += bf_lo(oo.x); v0[1] += bf_hi(oo.x); v0[2] += bf_lo(oo.y); v0[3] += bf_hi(oo.y); v1[0] += bf_lo(oo.z); v1[1] += bf_hi(oo.z); v1[2] += bf_lo(oo.w); v1[3] += bf_hi(oo.w); }
                const u32x4 pk = pack8(v0, v1); mgp[ai][m] = pk;
                if (br == 3) *(u32x4*)(MG + (size_t)(row0 + ai * HALF + m * 16) * 1024 + col0) = pk; }
    }
};
struct MergeOrder2 {
    int G, c;
    __device__ __forceinline__ bool next(int i, Unit& u) const {
        const int tl = (i >> 2) * G + c; if (tl >= 1024) return false;
        const int br = i & 3, rt = tl >> 3, ct = tl & 7; u.pm = br * 128 + rt; u.pn = br * 8 + ct; return true;
    }
    __device__ __forceinline__ void a_ready(const Unit&) const {}
    __device__ __forceinline__ void done(const Unit&) const {}
};
struct MergeOrder {
    int G, c;
    __device__ __forceinline__ bool next(int i, Unit& u) const {
        const int tl = (i >> 2) * G + c; if (tl >= 512) return false;
        const int br = i & 3, rt = tl >> 2, ct = tl & 3; u.pm = br * 128 + rt; u.pn = br * 4 + ct; return true;
    }
    __device__ __forceinline__ void a_ready(const Unit&) const {}
    __device__ __forceinline__ void done(const Unit&) const {}
};

struct EpiResid {
    static constexpr bool PERM = true, AFTER_DRAIN = false;
    const float* xin32; const bf16_t* xin; bf16_t* xout; float sc;
    __device__ __forceinline__ void operator()(const f32x4 (&acc)[2][2][4][2], const Unit& u, int wr, int wc, int fr, int fq) const {
        const int row0 = u.pm * BM + wr * 64 + fr, col0 = u.pn * BM + wc * 32 + 8 * fq;
#pragma unroll
        for (int ai = 0; ai < 2; ++ai) {
            f32x4 a[4][2][2];
            if (xin32) {
#pragma unroll
                for (int m = 0; m < 4; ++m) { const size_t off = (size_t)(row0 + ai * HALF + m * 16) * 1024 + col0;
#pragma unroll
                    for (int bj = 0; bj < 2; ++bj) { a[m][bj][0] = *(const f32x4*)(xin32 + off + bj * HALF); a[m][bj][1] = *(const f32x4*)(xin32 + off + bj * HALF + 4); } }
            } else {
                u32x4 r[4][2];
#pragma unroll
                for (int m = 0; m < 4; ++m) { const size_t off = (size_t)(row0 + ai * HALF + m * 16) * 1024 + col0;
#pragma unroll
                    for (int bj = 0; bj < 2; ++bj) r[m][bj] = *(const u32x4*)(xin + off + bj * HALF); }
#pragma unroll
                for (int m = 0; m < 4; ++m)
#pragma unroll
                    for (int bj = 0; bj < 2; ++bj) { const u32x4 q = r[m][bj]; a[m][bj][0] = (f32x4){bf_lo(q.x), bf_hi(q.x), bf_lo(q.y), bf_hi(q.y)}; a[m][bj][1] = (f32x4){bf_lo(q.z), bf_hi(q.z), bf_lo(q.w), bf_hi(q.w)}; }
            }
#pragma unroll
            for (int m = 0; m < 4; ++m) { const size_t off = (size_t)(row0 + ai * HALF + m * 16) * 1024 + col0;
#pragma unroll
                for (int bj = 0; bj < 2; ++bj) *(u32x4*)(xout + off + bj * HALF) = pack8(a[m][bj][0] + acc[ai][bj][m][0] * sc, a[m][bj][1] + acc[ai][bj][m][1] * sc); }
        }
    }
};

struct EpiSwiglu {
    static constexpr bool PERM = true, AFTER_DRAIN = false;
    bf16_t* ACT; int ldc, nct;
    __device__ __forceinline__ void operator()(const f32x4 (&acc)[2][2][4][2], const Unit& u, int wr, int wc, int fr, int fq) const {
        const int row0 = u.pm * BM + wr * 64 + fr, col0 = (u.pn % nct) * HALF + wc * 32 + 8 * fq;
#pragma unroll
        for (int ai = 0; ai < 2; ++ai)
#pragma unroll
            for (int m = 0; m < 4; ++m) { bf16_t* rowp = ACT + (size_t)(row0 + ai * HALF + m * 16) * ldc + col0;
                const f32x4 g0 = acc[ai][0][m][0], g1 = acc[ai][0][m][1]; f32x4 v0 = acc[ai][1][m][0], v1 = acc[ai][1][m][1];
#pragma unroll
                for (int e = 0; e < 4; ++e) { v0[e] *= g0[e] * fast_sigmoid(g0[e]); v1[e] *= g1[e] * fast_sigmoid(g1[e]); }
                *(u32x4*)rowp = pack8(v0, v1); }
    }
};

struct EpiSwiglu8 {
    static constexpr bool PERM = true, AFTER_DRAIN = false;
    unsigned char* ACT; int ldc, nct; float sc;
    __device__ __forceinline__ void operator()(const f32x4 (&acc)[2][2][4][2], const Unit& u, int wr, int wc, int fr, int fq) const {
        const int row0 = u.pm * BM + wr * 64 + fr, col0 = (u.pn % nct) * HALF + wc * 32 + 8 * fq;
#pragma unroll
        for (int ai = 0; ai < 2; ++ai)
#pragma unroll
            for (int m = 0; m < 4; ++m) { unsigned char* rowp = ACT + (size_t)(row0 + ai * HALF + m * 16) * ldc + col0;
                const f32x4 g0 = acc[ai][0][m][0] * sc, g1 = acc[ai][0][m][1] * sc; f32x4 v0 = acc[ai][1][m][0] * sc, v1 = acc[ai][1][m][1] * sc;
#pragma unroll
                for (int e = 0; e < 4; ++e) { v0[e] *= g0[e] * fast_sigmoid(g0[e]); v1[e] *= g1[e] * fast_sigmoid(g1[e]); }
                u32x2 w; w.x = pk4_fp8(v0[0], v0[1], v0[2], v0[3]); w.y = pk4_fp8(v1[0], v1[1], v1[2], v1[3]);
                *(u32x2*)rowp = w; }
    }
};

struct EpiSwigluI8 {
    static constexpr bool PERM = true, AFTER_DRAIN = false;
    unsigned char* ACT8; bf16_t* ACTb; int ldc, nct; const float* rs; float wsc;
    __device__ __forceinline__ void operator()(const f32x4 (&acc)[2][2][4][2], const Unit& u, int wr, int wc, int fr, int fq) const {
        const int row0 = u.pm * BM + wr * 64 + fr, col0 = (u.pn % nct) * HALF + wc * 32 + 8 * fq;
        float rsc[2][4];
#pragma unroll
        for (int ai = 0; ai < 2; ++ai)
#pragma unroll
            for (int m = 0; m < 4; ++m) rsc[ai][m] = rs[row0 + ai * HALF + m * 16] * wsc;
#pragma unroll
        for (int ai = 0; ai < 2; ++ai)
#pragma unroll
            for (int m = 0; m < 4; ++m) { const size_t row = (size_t)(row0 + ai * HALF + m * 16); const float sc = rsc[ai][m];
                const i32x4 ga = __builtin_bit_cast(i32x4, acc[ai][0][m][0]), gb = __builtin_bit_cast(i32x4, acc[ai][0][m][1]), ua = __builtin_bit_cast(i32x4, acc[ai][1][m][0]), ub = __builtin_bit_cast(i32x4, acc[ai][1][m][1]);
                const f32x4 gaf = __builtin_convertvector(ga, f32x4), gbf = __builtin_convertvector(gb, f32x4), uaf = __builtin_convertvector(ua, f32x4), ubf = __builtin_convertvector(ub, f32x4);
                const float nsc = sc * -1.4426950408889634f, sc2 = sc * sc;
                f32x4 e0 = gaf * nsc, e1 = gbf * nsc;
#pragma unroll
                for (int e = 0; e < 4; ++e) { e0[e] = __builtin_amdgcn_exp2f(e0[e]); e1[e] = __builtin_amdgcn_exp2f(e1[e]); }
                e0 = e0 + 1.0f; e1 = e1 + 1.0f;
#pragma unroll
                for (int e = 0; e < 4; ++e) { e0[e] = __builtin_amdgcn_rcpf(e0[e]); e1[e] = __builtin_amdgcn_rcpf(e1[e]); }
                const f32x4 v0 = (uaf * gaf) * (e0 * sc2), v1 = (ubf * gbf) * (e1 * sc2);
                if (ACT8) { u32x2 w; w.x = pk4_fp8(v0[0], v0[1], v0[2], v0[3]); w.y = pk4_fp8(v1[0], v1[1], v1[2], v1[3]); *(u32x2*)(ACT8 + row * ldc + col0) = w; }
                else *(u32x4*)(ACTb + row * ldc + col0) = pack8(v0, v1); }
    }
};

struct EpiDownMoe {
    static constexpr bool PERM = true, AFTER_DRAIN = false;
    const int* rinfo; bf16_t* Y; float sc;
    __device__ __forceinline__ void operator()(const f32x4 (&acc)[2][2][4][2], const Unit& u, int wr, int wc, int fr, int fq) const {
        const int prow0 = u.pm * BM + wr * 64 + fr, col0 = (u.pn & 3) * BM + wc * 32 + 8 * fq;
        u32x2 rinf[2][4];
#pragma unroll
        for (int ai = 0; ai < 2; ++ai)
#pragma unroll
            for (int m = 0; m < 4; ++m) rinf[ai][m] = *(const u32x2*)(rinfo + 2 * (size_t)(prow0 + ai * HALF + m * 16));
#pragma unroll
        for (int ai = 0; ai < 2; ++ai)
#pragma unroll
            for (int m = 0; m < 4; ++m) {
                const u32x2 ri = rinf[ai][m]; const int tokk = (int)ri.x; const float gt = __uint_as_float(ri.y) * sc;
                if (tokk >= 0) { bf16_t* rowp = Y + ((size_t)(tokk & 1) * 32768 + (size_t)(tokk >> 1)) * 1024 + col0;
#pragma unroll
                    for (int bj = 0; bj < 2; ++bj) *(u32x4*)(rowp + bj * HALF) = pack8(acc[ai][bj][m][0] * gt, acc[ai][bj][m][1] * gt); } }
    }
};
struct GroupedOrder {
    int G, c, nct, T; int tend[8];
    __device__ __forceinline__ bool next(int i, Unit& u) const {
        const int L = i * G + c; if (L >= T * nct) return false;
        const int nig = 8 * nct, grp = L / nig, w = L % nig, fm = grp * 8, gsz = (T - fm) < 8 ? (T - fm) : 8;
        const int rt = fm + w % gsz, ct = w / gsz; int e = 0;
#pragma unroll
        for (int k = 0; k < 7; ++k) e += (rt >= tend[k]) ? 1 : 0;
        u.pm = rt; u.pn = e * nct + ct; return true;
    }
    __device__ __forceinline__ void a_ready(const Unit&) const {}
    __device__ __forceinline__ void done(const Unit&) const {}
};
template <class Epi, class Sched, bool ALIGN_EPI = false, bool SP2 = false, bool F8 = false, bool I8 = false>
__device__ __forceinline__ void gemm_phase(PG8_LAS unsigned char* lds, const Gemm g, const Sched& S, const Epi& E) {
    int tid_l = threadIdx.x; asm volatile("" : "+v"(tid_l));
    const int tid = tid_l, wid = __builtin_amdgcn_readfirstlane(tid >> 6), lane = tid & 63, wr = wid >> 2, wc = wid & 3, fr = lane & 15, fq = lane >> 4;
    const int K = g.K, nt = K / BK;
    unsigned voffA[2], voffB[2];
#pragma unroll
    for (int i = 0; i < 2; ++i) { int R, C; stage_rc(tid * 16 + i * 8192, R, C); const int Rb = Epi::PERM ? ((R & ~31) + perm32(R & 31)) : R;
        voffA[i] = (unsigned)(R * K + C) * 2u; voffB[i] = (unsigned)(Rb * K + C) * 2u; }
    const size_t kstep = (size_t)(BK * 2);
    const size_t hstep = (size_t)HALF * K * 2;
    const size_t tstep = 2 * hstep;
    const unsigned ldsw = (unsigned)wid * 1024u;
    const int aoff = lds_byte(wr * 64 + fr, fq * 8), boff = lds_byte(wc * 32 + fr, fq * 8);
#define PG8_SA(b, h) (((b) * 2 + (h)) * HTB)
#define PG8_SB(b, h) ((4 + (b) * 2 + (h)) * HTB)
#define PG8_STAGE(bufoff, gbase, voff) do { _Pragma("unroll") for (int _i = 0; _i < 2; ++_i) \
        __builtin_amdgcn_global_load_lds((const unsigned*)((const char*)(gbase) + (voff)[_i]), (PG8_LAS unsigned*)(lds + (bufoff) + ldsw + _i * 8192), 16, 0, 0); } while (0)
#define PG8_LDA(dst, b, h) do { _Pragma("unroll") for (int m = 0; m < 4; ++m) _Pragma("unroll") for (int k = 0; k < 2; ++k) dst[m][k] = *(const PG8_LAS bf16x8*)(lds + PG8_SA(b, h) + aoff + m * 2048 + k * 1024); } while (0)
#define PG8_LDB(dst, b, h) do { _Pragma("unroll") for (int n = 0; n < 2; ++n) _Pragma("unroll") for (int k = 0; k < 2; ++k) dst[n][k] = *(const PG8_LAS bf16x8*)(lds + PG8_SB(b, h) + boff + n * 2048 + k * 1024); } while (0)
#define PG8_MMA(ai, bj, At, Bt) do { __builtin_amdgcn_s_setprio(1); if constexpr (F8) { _Pragma("unroll") for (int m = 0; m < 4; ++m) _Pragma("unroll") for (int n = 0; n < 2; ++n) \
        asm volatile("s_nop 1\n\tv_mfma_f32_16x16x128_f8f6f4 %0, %1, %2, %0" : "+v"(acc[ai][bj][m][n]) : "v"(cat8(Bt[n][0], Bt[n][1])), "v"(cat8(At[m][0], At[m][1]))); } \
        else if constexpr (I8) { _Pragma("unroll") for (int m = 0; m < 4; ++m) _Pragma("unroll") for (int n = 0; n < 2; ++n) _Pragma("unroll") for (int k = 0; k < 2; ++k) \
        acc[ai][bj][m][n] = __builtin_bit_cast(f32x4, __builtin_amdgcn_mfma_i32_16x16x64_i8(__builtin_bit_cast(i32x4, Bt[n][k]), __builtin_bit_cast(i32x4, At[m][k]), __builtin_bit_cast(i32x4, acc[ai][bj][m][n]), 0, 0, 0)); } \
        else { _Pragma("unroll") for (int m = 0; m < 4; ++m) _Pragma("unroll") for (int n = 0; n < 2; ++n) _Pragma("unroll") for (int k = 0; k < 2; ++k) \
        acc[ai][bj][m][n] = __builtin_amdgcn_mfma_f32_16x16x32_bf16(Bt[n][k], At[m][k], acc[ai][bj][m][n], 0, 0, 0); } __builtin_amdgcn_s_setprio(0); } while (0)
#define PG8_WAIT_V(n) asm volatile("s_waitcnt vmcnt(" #n ")" ::: "memory")
#define PG8_WAIT_L(n) asm volatile("s_waitcnt lgkmcnt(" #n ")" ::: "memory")
#define PG8_BAR __builtin_amdgcn_s_barrier()
#define PG8_SCHED __builtin_amdgcn_sched_barrier(0)
    Unit cur, nxt; int ui = 0;
    if (!S.next(0, cur)) return;
    f32x4 acc[2][2][4][2];
#pragma unroll
    for (int a = 0; a < 2; ++a)
#pragma unroll
        for (int b = 0; b < 2; ++b)
#pragma unroll
            for (int m = 0; m < 4; ++m)
#pragma unroll
                for (int n = 0; n < 2; ++n) acc[a][b][m][n] = (f32x4){0.f, 0.f, 0.f, 0.f};
    bf16x8 At[4][2], B0[2][2], B1[2][2];
    const char* cA = (const char*)g.A + (size_t)cur.pm * tstep; const char* cB = (const char*)g.Bt + (size_t)cur.pn * tstep;
    S.a_ready(cur);
    if constexpr (SP2) {
        PG8_STAGE(PG8_SB(0, 0), cB, voffB); PG8_STAGE(PG8_SB(0, 1), cB + hstep, voffB); PG8_STAGE(PG8_SA(0, 0), cA, voffA); PG8_STAGE(PG8_SA(0, 1), cA + hstep, voffA);
        if (wr == 1) PG8_BAR;
        PG8_WAIT_V(2); PG8_BAR;
        PG8_STAGE(PG8_SB(1, 0), cB + kstep, voffB); PG8_STAGE(PG8_SA(1, 0), cA + kstep, voffA); PG8_STAGE(PG8_SB(1, 1), cB + hstep + kstep, voffB);
        PG8_WAIT_V(6); PG8_BAR;
    } else {
        PG8_STAGE(PG8_SB(0, 0), cB, voffB); PG8_STAGE(PG8_SA(0, 0), cA, voffA); PG8_STAGE(PG8_SB(0, 1), cB + hstep, voffB); PG8_STAGE(PG8_SA(0, 1), cA + hstep, voffA);
        if (wr == 1) PG8_BAR;
        PG8_WAIT_V(4); PG8_BAR;
        PG8_STAGE(PG8_SB(1, 0), cB + kstep, voffB); PG8_STAGE(PG8_SA(1, 0), cA + kstep, voffA); PG8_STAGE(PG8_SB(1, 1), cB + hstep + kstep, voffB);
        PG8_WAIT_V(6); PG8_BAR;
    }
    for (;;) {
        const bool has_next = S.next(ui + 1, nxt);
        const char* nA = has_next ? (const char*)g.A + (size_t)nxt.pm * tstep : cA; const char* nB = has_next ? (const char*)g.Bt + (size_t)nxt.pn * tstep : cB;
        for (int t = 0; t < nt; t += 2) {
            const bool last = (t == nt - 2);
            const char* a1 = cA + (size_t)(t + 1) * kstep;
            const char* a2 = last ? nA : cA + (size_t)(t + 2) * kstep; const char* b2 = last ? nB : cB + (size_t)(t + 2) * kstep;
            const char* a3 = a2 + kstep; const char* b3 = b2 + kstep;
            if (last && has_next) S.a_ready(nxt);
            if constexpr (SP2) {
            PG8_LDB(B0, 0, 0); PG8_LDB(B1, 0, 1); PG8_SCHED; PG8_LDA(At, 0, 0); PG8_STAGE(PG8_SA(1, 1), a1 + hstep, voffA);
            PG8_WAIT_V(8); PG8_WAIT_L(0); PG8_BAR; PG8_MMA(0, 0, At, B0); PG8_MMA(0, 1, At, B1); PG8_BAR; PG8_SCHED;
            PG8_LDA(At, 0, 1); PG8_STAGE(PG8_SB(0, 0), b2, voffB); PG8_STAGE(PG8_SB(0, 1), b2 + hstep, voffB); PG8_STAGE(PG8_SA(0, 0), a2, voffA);
            PG8_WAIT_V(8); PG8_WAIT_L(0); PG8_BAR; PG8_MMA(1, 0, At, B0); PG8_MMA(1, 1, At, B1); PG8_BAR; PG8_SCHED;
            PG8_LDB(B0, 1, 0); PG8_LDB(B1, 1, 1); PG8_SCHED; PG8_LDA(At, 1, 0); PG8_STAGE(PG8_SA(0, 1), a2 + hstep, voffA);
            PG8_WAIT_V(8); PG8_WAIT_L(0); PG8_BAR; PG8_MMA(0, 0, At, B0); PG8_MMA(0, 1, At, B1); PG8_BAR; PG8_SCHED;
            PG8_LDA(At, 1, 1); PG8_STAGE(PG8_SB(1, 0), b3, voffB); PG8_STAGE(PG8_SB(1, 1), b3 + hstep, voffB); PG8_STAGE(PG8_SA(1, 0), a3, voffA);
            PG8_WAIT_V(8); PG8_WAIT_L(0); PG8_BAR; PG8_MMA(1, 0, At, B0); PG8_MMA(1, 1, At, B1); PG8_BAR; PG8_SCHED;
            } else {
            PG8_LDB(B0, 0, 0); PG8_SCHED; PG8_LDA(At, 0, 0); PG8_STAGE(PG8_SA(1, 1), a1 + hstep, voffA);
            PG8_WAIT_L(8); PG8_BAR; PG8_WAIT_L(0); PG8_MMA(0, 0, At, B0); PG8_BAR; PG8_SCHED;
            PG8_LDB(B1, 0, 1); PG8_STAGE(PG8_SB(0, 0), b2, voffB);
            PG8_BAR; PG8_WAIT_L(0); PG8_MMA(0, 1, At, B1); PG8_BAR;
            PG8_LDA(At, 0, 1); PG8_STAGE(PG8_SA(0, 0), a2, voffA);
            PG8_BAR; PG8_WAIT_L(0); PG8_MMA(1, 0, At, B0); PG8_BAR; PG8_SCHED;
            PG8_STAGE(PG8_SB(0, 1), b2 + hstep, voffB);
            PG8_WAIT_V(6); PG8_BAR; PG8_MMA(1, 1, At, B1); PG8_BAR;
            PG8_LDB(B0, 1, 0); PG8_SCHED; PG8_LDA(At, 1, 0); PG8_STAGE(PG8_SA(0, 1), a2 + hstep, voffA);
            PG8_WAIT_L(8); PG8_BAR; PG8_WAIT_L(0); PG8_MMA(0, 0, At, B0); PG8_BAR; PG8_SCHED;
            PG8_LDB(B1, 1, 1); PG8_STAGE(PG8_SB(1, 0), b3, voffB);
            PG8_BAR; PG8_WAIT_L(0); PG8_MMA(0, 1, At, B1); PG8_BAR;
            PG8_LDA(At, 1, 1); PG8_STAGE(PG8_SA(1, 0), a3, voffA);
            PG8_BAR; PG8_WAIT_L(0); PG8_MMA(1, 0, At, B0); PG8_BAR; PG8_SCHED;
            PG8_STAGE(PG8_SB(1, 1), b3 + hstep, voffB);
            PG8_WAIT_V(6); PG8_BAR; PG8_MMA(1, 1, At, B1); PG8_BAR;
            }
        }
        if constexpr (F8) {
#define PG8_PIN8(a, b) asm volatile("" : "+v"(acc[a][b][0][0]), "+v"(acc[a][b][0][1]), "+v"(acc[a][b][1][0]), "+v"(acc[a][b][1][1]), "+v"(acc[a][b][2][0]), "+v"(acc[a][b][2][1]), "+v"(acc[a][b][3][0]), "+v"(acc[a][b][3][1]))
            asm volatile("s_nop 15\n\ts_nop 15" : "+v"(acc[0][0][0][0]), "+v"(acc[0][0][0][1]), "+v"(acc[0][0][1][0]), "+v"(acc[0][0][1][1]), "+v"(acc[0][0][2][0]), "+v"(acc[0][0][2][1]), "+v"(acc[0][0][3][0]), "+v"(acc[0][0][3][1]) :: "memory");
            PG8_PIN8(0, 1); PG8_PIN8(1, 0); PG8_PIN8(1, 1);
#undef PG8_PIN8
        }
        if constexpr (ALIGN_EPI) { if (wr == 0) PG8_BAR; }
        if constexpr (!Epi::AFTER_DRAIN) { E(acc, cur, wr, wc, fr, fq); S.done(cur); }
        if (!has_next) break;
#pragma unroll
        for (int a = 0; a < 2; ++a)
#pragma unroll
            for (int b = 0; b < 2; ++b)
#pragma unroll
                for (int m = 0; m < 4; ++m)
#pragma unroll
                    for (int n = 0; n < 2; ++n) acc[a][b][m][n] = (f32x4){0.f, 0.f, 0.f, 0.f};
        cur = nxt; cA = nA; cB = nB; ++ui;
        if constexpr (ALIGN_EPI) { if (wr == 1) PG8_BAR; }
    }
    PG8_WAIT_V(0);
    if constexpr (!ALIGN_EPI) { if (wr == 0) PG8_BAR; }
    PG8_BAR;
    if constexpr (Epi::AFTER_DRAIN) { E.fused(acc, cur, wr, wc, fr, fq, lds, wid, lane); S.done(cur); }
#undef PG8_SA
#undef PG8_SB
#undef PG8_STAGE
#undef PG8_LDA
#undef PG8_LDB
#undef PG8_MMA
#undef PG8_WAIT_V
#undef PG8_WAIT_L
#undef PG8_BAR
#undef PG8_SCHED
}

template <class Epi, class Sched, bool I8 = false>
__device__ __forceinline__ void gemm_phase_n1(PG8_LAS unsigned char* lds, const Gemm g, const Sched& S, const Epi& E) {
    int tid_l = threadIdx.x; asm volatile("" : "+v"(tid_l));
    const int tid = tid_l, wid = __builtin_amdgcn_readfirstlane(tid >> 6), lane = tid & 63, wr = wid >> 2, wc = wid & 3, fr = lane & 15, fq = lane >> 4;
    const int K = g.K, nt = K / BK;
    unsigned voffA[2], voffB[2];
#pragma unroll
    for (int i = 0; i < 2; ++i) { int R, C; stage_rc(tid * 16 + i * 8192, R, C); const int Rb = (R & ~31) + perm32(R & 31);
        voffA[i] = (unsigned)(R * K + C) * 2u; voffB[i] = (unsigned)(Rb * K + C) * 2u; }
    const size_t kstep = (size_t)(BK * 2);
    const size_t hstep = (size_t)HALF * K * 2;
    const size_t tstep = 2 * hstep;
    const unsigned ldsw = (unsigned)wid * 1024u;
    const int aoff = lds_byte(wr * 64 + fr, fq * 8), boff = lds_byte(wc * 32 + fr, fq * 8);
#define PG8_SA(b, h) (((b) * 2 + (h)) * HTB)
#define PG8_SB(b, h) ((4 + (b) * 2 + (h)) * HTB)
#define PG8_STAGE(bufoff, gbase, voff) do { _Pragma("unroll") for (int _i = 0; _i < 2; ++_i) \
        __builtin_amdgcn_global_load_lds((const unsigned*)((const char*)(gbase) + (voff)[_i]), (PG8_LAS unsigned*)(lds + (bufoff) + ldsw + _i * 8192), 16, 0, 0); } while (0)
#define PG8_LDA(dst, b, h) do { _Pragma("unroll") for (int m = 0; m < 4; ++m) _Pragma("unroll") for (int k = 0; k < 2; ++k) dst[m][k] = *(const PG8_LAS bf16x8*)(lds + PG8_SA(b, h) + aoff + m * 2048 + k * 1024); } while (0)
#define PG8_LDB(dst, b, h) do { _Pragma("unroll") for (int n = 0; n < 2; ++n) _Pragma("unroll") for (int k = 0; k < 2; ++k) dst[n][k] = *(const PG8_LAS bf16x8*)(lds + PG8_SB(b, h) + boff + n * 2048 + k * 1024); } while (0)
#define PG8_MMA1(ai, At, Bt) do { __builtin_amdgcn_s_setprio(1); _Pragma("unroll") for (int m = 0; m < 4; ++m) _Pragma("unroll") for (int n = 0; n < 2; ++n) _Pragma("unroll") for (int k = 0; k < 2; ++k) { \
        if constexpr (I8) acc[ai][m][n] = __builtin_bit_cast(f32x4, __builtin_amdgcn_mfma_i32_16x16x64_i8(__builtin_bit_cast(i32x4, Bt[n][k]), __builtin_bit_cast(i32x4, At[m][k]), __builtin_bit_cast(i32x4, acc[ai][m][n]), 0, 0, 0)); \
        else acc[ai][m][n] = __builtin_amdgcn_mfma_f32_16x16x32_bf16(Bt[n][k], At[m][k], acc[ai][m][n], 0, 0, 0); } __builtin_amdgcn_s_setprio(0); } while (0)
#define PG8_WAIT_V(n) asm volatile("s_waitcnt vmcnt(" #n ")" ::: "memory")
#define PG8_WAIT_L(n) asm volatile("s_waitcnt lgkmcnt(" #n ")" ::: "memory")
#define PG8_BAR __builtin_amdgcn_s_barrier()
#define PG8_SCHED __builtin_amdgcn_sched_barrier(0)
    Unit cur, nxt; int ui = 0;
    if (!S.next(0, cur)) return;
    f32x4 acc[2][4][2];
#pragma unroll
    for (int a = 0; a < 2; ++a)
#pragma unroll
        for (int m = 0; m < 4; ++m)
#pragma unroll
            for (int n = 0; n < 2; ++n) acc[a][m][n] = (f32x4){0.f, 0.f, 0.f, 0.f};
    bf16x8 At[4][2], B0[2][2];
    u32x4 xst[2][4];
#pragma unroll
    for (int a = 0; a < 2; ++a)
#pragma unroll
        for (int m = 0; m < 4; ++m) xst[a][m] = (u32x4){0u, 0u, 0u, 0u};
    const char* cA = (const char*)g.A + (size_t)cur.pm * tstep; const char* cB = (const char*)g.Bt + (size_t)cur.pn * hstep;
    S.a_ready(cur);
    PG8_STAGE(PG8_SB(0, 0), cB, voffB); PG8_STAGE(PG8_SA(0, 0), cA, voffA); PG8_STAGE(PG8_SA(0, 1), cA + hstep, voffA);
    if (wr == 1) PG8_BAR;
    PG8_WAIT_V(2); PG8_BAR;
    PG8_STAGE(PG8_SB(1, 0), cB + kstep, voffB); PG8_STAGE(PG8_SA(1, 0), cA + kstep, voffA);
    PG8_WAIT_V(4); PG8_BAR;
    for (;;) {
        const bool has_next = S.next(ui + 1, nxt);
        const char* nA = has_next ? (const char*)g.A + (size_t)nxt.pm * tstep : cA; const char* nB = has_next ? (const char*)g.Bt + (size_t)nxt.pn * hstep : cB;
        for (int t = 0; t < nt; t += 2) {
            const bool last = (t == nt - 2);
            const char* a1 = cA + (size_t)(t + 1) * kstep;
            const char* a2 = last ? nA : cA + (size_t)(t + 2) * kstep; const char* b2 = last ? nB : cB + (size_t)(t + 2) * kstep;
            const char* a3 = a2 + kstep; const char* b3 = b2 + kstep;
            if (last && has_next) S.a_ready(nxt);
            PG8_LDB(B0, 0, 0); PG8_SCHED; PG8_LDA(At, 0, 0); PG8_STAGE(PG8_SA(1, 1), a1 + hstep, voffA);
            PG8_WAIT_V(6); PG8_WAIT_L(0); PG8_BAR; PG8_MMA1(0, At, B0); PG8_BAR; PG8_SCHED;
            PG8_LDA(At, 0, 1); PG8_STAGE(PG8_SB(0, 0), b2, voffB); PG8_STAGE(PG8_SA(0, 0), a2, voffA);
            PG8_WAIT_V(6); PG8_WAIT_L(0); PG8_BAR; PG8_MMA1(1, At, B0); PG8_BAR; PG8_SCHED;
            PG8_LDB(B0, 1, 0); PG8_SCHED; PG8_LDA(At, 1, 0); PG8_STAGE(PG8_SA(0, 1), a2 + hstep, voffA);
            PG8_WAIT_V(6); PG8_WAIT_L(0); PG8_BAR; PG8_MMA1(0, At, B0); PG8_BAR; PG8_SCHED;
            PG8_LDA(At, 1, 1); PG8_STAGE(PG8_SB(1, 0), b3, voffB); PG8_STAGE(PG8_SA(1, 0), a3, voffA);
            PG8_WAIT_V(6); PG8_WAIT_L(0); PG8_BAR; PG8_MMA1(1, At, B0); PG8_BAR; PG8_SCHED;
        }
        if (wr == 0) PG8_BAR;
        E(acc, xst, cur, wr, wc, fr, fq); S.done(cur);
        if (!has_next) break;
#pragma unroll
        for (int a = 0; a < 2; ++a)
#pragma unroll
            for (int m = 0; m < 4; ++m)
#pragma unroll
                for (int n = 0; n < 2; ++n) acc[a][m][n] = (f32x4){0.f, 0.f, 0.f, 0.f};
        cur = nxt; cA = nA; cB = nB; ++ui;
        if (wr == 1) PG8_BAR;
    }
    PG8_WAIT_V(0);
    PG8_BAR;
#undef PG8_SA
#undef PG8_SB
#undef PG8_STAGE
#undef PG8_LDA
#undef PG8_LDB
#undef PG8_MMA1
#undef PG8_WAIT_V
#undef PG8_WAIT_L
#undef PG8_BAR
#undef PG8_SCHED
}

}

constexpr int NTOK = 32768, SEQ = 2048, DM = 1024, NLAYER = 4;
constexpr int INW = 8200;
constexpr int C_Q = 0, C_K = 512, C_V = 1024, C_F = 1536, C_SU = 1544, C_CONV = 2568, C_POOL = 3592, C_GATE = 4104;
constexpr int NPROJ = 3584;
constexpr int FFD = 2816, FFE = 3584, NEXP = 8;
constexpr int PMAX = 65536 + NEXP * 256;
constexpr float EPS = 1e-6f, LOG2E = 1.4426950408889634f;
constexpr int NWAVES = 8;

constexpr size_t MiB = 1u << 20;
constexpr size_t WS_CTL = 0, CTL_ZERO_BYTES = 1 * MiB;
constexpr size_t WS_LF = 1 * MiB;
constexpr size_t WS_RINFO = 2 * MiB;
constexpr size_t WS_HS2 = 3 * MiB + 640 * 1024;
constexpr size_t WS_XSS = 2 * MiB + 640 * 1024;
constexpr size_t WS_HS = 3 * MiB + 512 * 1024;
constexpr size_t WS_ASG = 3 * MiB;
constexpr size_t WS_WMIX = 4 * MiB;
constexpr size_t WM_PROJ = WS_WMIX, WM_G8 = WM_PROJ + (size_t)NPROJ * 1024 * 2  , WM_V = WM_G8 + (size_t)4096 * 1024, WM_B = WM_V + 512 * 1024 * 2, WM_OUT = WM_B + (size_t)4096 * 512 * 2,
                 WM_PG = WM_OUT + (size_t)1024 * 1024 * 2, WM_SP = WM_PG + 4 * 128 * 128 * 2, WM_END = WM_SP + 8 * 128 * 128 * 2;
static_assert(WM_END <= 28 * MiB, "mixer weights");
constexpr size_t WS_XB = 28 * MiB;
constexpr size_t WS_R = 92 * MiB;
constexpr size_t WS_Q = WS_R, WS_K = WS_Q + 32 * MiB, WS_VT = WS_K + 32 * MiB, WS_SUV = WS_VT + 32 * MiB, WS_CY = WS_SUV + 64 * MiB, WS_PIN = WS_CY + 32 * MiB,
                 WS_G = WS_PIN + 32 * MiB, WS_YS = WS_G + 256 * MiB, WS_MG = WS_YS + 128 * MiB, WS_MIX_END = WS_MG + 64 * MiB;
constexpr size_t WS_YSC = WS_YS + 64 * MiB;
constexpr size_t WS_XS = WS_R;
constexpr size_t WS_WFFN = WS_XS + 132 * MiB;
constexpr size_t WS_WF2 = WS_XS + 132 * MiB + 168 * MiB + 462 * MiB + 32 * MiB;
constexpr size_t WF_GU = WS_WF2, WF_D_DENSE = WF_GU + (size_t)2 * FFD * 1024 * 2, WF_D_MOE = WF_GU + (size_t)NEXP * 2 * FFE * 1024;
constexpr size_t WS_ACT = WS_WFFN + 168 * MiB;
constexpr size_t WS_H8 = WS_ACT + 462 * MiB;
constexpr size_t WS_H = WS_H8 + 32 * MiB + 112 * MiB;
constexpr size_t WS_END = WS_H + 32 * MiB;
static_assert(WS_WF2 == WS_H8 + 32 * MiB && WF_D_MOE + (size_t)NEXP * 1024 * FFE <= WS_END && WF_D_DENSE + (size_t)1024 * FFD * 2 <= WS_END, "FFN weight region");
static_assert((size_t)PMAX * FFE * 2 <= 462 * MiB && (size_t)PMAX * 1024 * 2 <= 132 * MiB && WS_MIX_END <= WS_END, "d_ws map");
constexpr int CW_BAR = 4096;
constexpr int CW_VMAX = 32768;
constexpr int CW_CNT = 16384;

constexpr int RING_BYTES = 147456;
constexpr int MISC_OFF = RING_BYTES;
constexpr int LDS_BYTES = RING_BYTES + 256;

#define GAS __attribute__((address_space(1)))
#define LAS __attribute__((address_space(3)))
typedef unsigned short bf16_t;
typedef unsigned v4u __attribute__((ext_vector_type(4)));
typedef unsigned v2u __attribute__((ext_vector_type(2)));
typedef float f32x4 __attribute__((ext_vector_type(4)));
typedef float f32x16 __attribute__((ext_vector_type(16)));
typedef short bf16x8 __attribute__((ext_vector_type(8)));
typedef GAS unsigned gu32;
#define RLX_AGENT __ATOMIC_RELAXED, __HIP_MEMORY_SCOPE_AGENT
#define LDS_WAIT() asm volatile("s_waitcnt lgkmcnt(0)" ::: "memory")
typedef float f32x2_t __attribute__((ext_vector_type(2))); typedef __bf16 bf16x2_t __attribute__((ext_vector_type(2)));
__device__ __forceinline__ unsigned pk2(float lo, float hi) { f32x2_t v = {lo, hi}; bf16x2_t b = __builtin_convertvector(v, bf16x2_t); return __builtin_bit_cast(unsigned, b); }
__device__ __forceinline__ float blo(unsigned w) { return __uint_as_float(w << 16); }
__device__ __forceinline__ float bhi(unsigned w) { return __uint_as_float(w & 0xffff0000u); }
__device__ __forceinline__ float bf1(bf16_t b) { return __uint_as_float((unsigned)b << 16); }
__device__ __forceinline__ bf16_t f2bf(float f) { return (bf16_t)(pk2(f, 0.f) & 0xffffu); }
__device__ __forceinline__ float sigm(float x) { return __builtin_amdgcn_rcpf(1.0f + __builtin_amdgcn_exp2f(-LOG2E * x)); }
__device__ __forceinline__ float wave_sum(float v) {
#pragma unroll
    for (int o = 1; o < 64; o <<= 1) v += __shfl_xor(v, o);
    return v;
}
__device__ __forceinline__ int crow(int r, int hi) { return (r & 3) + 8 * (r >> 2) + 4 * hi; }
#define MFMA32(a, b, c) __builtin_amdgcn_mfma_f32_32x32x16_bf16((a), (b), (c), 0, 0, 0)

__device__ __forceinline__ void tr_item(const float* src, int ldn, int c0, int k0, bf16_t* dst, int ldk, int drow0, LAS float* scr, int lane) {
    {
        f32x4 ld[8]; const int kr = lane >> 3, n4 = (lane & 7) * 4;
#pragma unroll
        for (int i = 0; i < 8; ++i) ld[i] = __builtin_nontemporal_load((const f32x4*)(src + (size_t)(k0 + 8 * i + kr) * ldn + c0 + n4));
#pragma unroll
        for (int i = 0; i < 8; ++i) { LAS float* d = scr + (8 * i + kr) * 33 + n4; d[0] = ld[i][0]; d[1] = ld[i][1]; d[2] = ld[i][2]; d[3] = ld[i][3]; }
    }
    LDS_WAIT(); asm volatile("" ::: "memory");
    const int c = lane & 7;
#pragma unroll
    for (int j = 0; j < 4; ++j) { const int n = (lane >> 3) + 8 * j; const LAS float* s = scr + (8 * c) * 33 + n;
        v4u o; o.x = pk2(s[0 * 33], s[1 * 33]); o.y = pk2(s[2 * 33], s[3 * 33]); o.z = pk2(s[4 * 33], s[5 * 33]); o.w = pk2(s[6 * 33], s[7 * 33]);
        *(v4u*)(dst + (size_t)(drow0 + n) * ldk + k0 + 8 * c) = o; }
    LDS_WAIT(); asm volatile("" ::: "memory");
}
__device__ __forceinline__ unsigned pk4f8(float a, float b, float c, float d) {
    a = __builtin_fminf(__builtin_fmaxf(a, -448.f), 448.f); b = __builtin_fminf(__builtin_fmaxf(b, -448.f), 448.f); c = __builtin_fminf(__builtin_fmaxf(c, -448.f), 448.f); d = __builtin_fminf(__builtin_fmaxf(d, -448.f), 448.f);
    int w = 0; w = __builtin_amdgcn_cvt_pk_fp8_f32(a, b, w, false); w = __builtin_amdgcn_cvt_pk_fp8_f32(c, d, w, true); return (unsigned)w; }
__device__ __forceinline__ unsigned pk4i8(float a, float b, float c, float d) {
    int qa = (int)__builtin_rintf(a), qb = (int)__builtin_rintf(b), qc = (int)__builtin_rintf(c), qd = (int)__builtin_rintf(d);
    qa = qa < -127 ? -127 : (qa > 127 ? 127 : qa); qb = qb < -127 ? -127 : (qb > 127 ? 127 : qb); qc = qc < -127 ? -127 : (qc > 127 ? 127 : qc); qd = qd < -127 ? -127 : (qd > 127 ? 127 : qd);
    return (unsigned)(qa & 255) | ((unsigned)(qb & 255) << 8) | ((unsigned)(qc & 255) << 16) | ((unsigned)(qd & 255) << 24); }
__device__ __forceinline__ v2u quant_row8(const float (&f)[8], float* scp, int lane) {
    float am = 0.f;
#pragma unroll
    for (int e = 0; e < 8; ++e) am = __builtin_fmaxf(am, __builtin_fabsf(f[e]));
#pragma unroll
    for (int o = 1; o < 64; o <<= 1) am = __builtin_fmaxf(am, __shfl_xor(am, o));
    am = __builtin_fmaxf(am, 1e-20f); const float qi = 127.0f / am; if (lane == 0) *scp = am * (1.0f / 127.0f);
    v2u o; o.x = pk4i8(f[0] * qi, f[1] * qi, f[2] * qi, f[3] * qi); o.y = pk4i8(f[4] * qi, f[5] * qi, f[6] * qi, f[7] * qi); return o;
}
__device__ __forceinline__ void quant_store8(const float (&f)[8][8], unsigned char* O, float* Osc, size_t row0, int tfirst, int tstep, int lane) {
    float am[8];
#pragma unroll
    for (int i = 0; i < 8; ++i) { am[i] = 0.f;
#pragma unroll
        for (int e = 0; e < 8; ++e) am[i] = __builtin_fmaxf(am[i], __builtin_fabsf(f[i][e])); }
#pragma unroll
    for (int o = 1; o < 64; o <<= 1)
#pragma unroll
        for (int i = 0; i < 8; ++i) am[i] = __builtin_fmaxf(am[i], __shfl_xor(am[i], o));
#pragma unroll
    for (int i = 0; i < 8; ++i) { const float a = __builtin_fmaxf(am[i], 1e-20f), qi = 127.0f / a; const size_t row = row0 + tfirst + tstep * i;
        if (lane == 0) Osc[row] = a * (1.0f / 127.0f);
        v2u o; o.x = pk4i8(f[i][0] * qi, f[i][1] * qi, f[i][2] * qi, f[i][3] * qi); o.y = pk4i8(f[i][4] * qi, f[i][5] * qi, f[i][6] * qi, f[i][7] * qi);
        *(v2u*)(O + row * 512 + 8 * lane) = o; }
}
template <bool I8Q = false>
__device__ __forceinline__ void tr_item8(const float* src, int ldn, int c0, int k0, unsigned char* dst, int ldk, int drow0, float scale, LAS float* scr, int lane) {
    {
        f32x4 ld[8]; const int kr = lane >> 3, n4 = (lane & 7) * 4;
#pragma unroll
        for (int i = 0; i < 8; ++i) ld[i] = __builtin_nontemporal_load((const f32x4*)(src + (size_t)(k0 + 8 * i + kr) * ldn + c0 + n4));
#pragma unroll
        for (int i = 0; i < 8; ++i) { LAS float* d = scr + (8 * i + kr) * 33 + n4; d[0] = ld[i][0]; d[1] = ld[i][1]; d[2] = ld[i][2]; d[3] = ld[i][3]; }
    }
    LDS_WAIT(); asm volatile("" ::: "memory");
    const int c = lane & 7;
#pragma unroll
    for (int j = 0; j < 4; ++j) { const int n = (lane >> 3) + 8 * j; const LAS float* s = scr + (8 * c) * 33 + n;
        v2u o; if (I8Q) { o.x = pk4i8(s[0 * 33] * scale, s[1 * 33] * scale, s[2 * 33] * scale, s[3 * 33] * scale); o.y = pk4i8(s[4 * 33] * scale, s[5 * 33] * scale, s[6 * 33] * scale, s[7 * 33] * scale); }
        else { o.x = pk4f8(s[0 * 33] * scale, s[1 * 33] * scale, s[2 * 33] * scale, s[3 * 33] * scale); o.y = pk4f8(s[4 * 33] * scale, s[5 * 33] * scale, s[6 * 33] * scale, s[7 * 33] * scale); }
        *(v2u*)(dst + (size_t)(drow0 + n) * ldk + k0 + 8 * c) = o; }
    LDS_WAIT(); asm volatile("" ::: "memory");
}
template <bool I8Q = false>
__device__ __forceinline__ void tr_segment8(const float* src, int ldn, int K, int c_begin, int ncols, unsigned char* dst, int drow_begin, int blk, float scale, LAS float* scr, int gw, int NGW, int lane, int& off) {
    const int nblk = ncols / 32, nitems = (K / 64) * nblk;
    int start = (gw - (off % NGW) + NGW) % NGW;
    for (int it = start; it < nitems; it += NGW) {
        const int kb = it / nblk, nb = it % nblk, n0 = nb * 32;
        const int drow0 = drow_begin + (blk < 0 ? (n0 & ~255) + 128 * ((n0 >> 5) & 1) + 32 * ((n0 >> 6) & 3) : (blk ? (n0 / blk) * (2 * blk) + (n0 % blk) : n0));
        tr_item8<I8Q>(src, ldn, c_begin + n0, kb * 64, dst, K, drow0, scale, scr, lane);
    }
    off += nitems;
}
__device__ __forceinline__ void tr_segment(const float* src, int ldn, int K, int c_begin, int ncols, bf16_t* dst, int drow_begin, int blk, LAS float* scr, int gw, int NGW, int lane, int& off) {
    const int nblk = ncols / 32, nitems = (K / 64) * nblk;
    int start = (gw - (off % NGW) + NGW) % NGW;
    for (int it = start; it < nitems; it += NGW) {
        const int kb = it / nblk, nb = it % nblk, n0 = nb * 32;
        const int drow0 = drow_begin + (blk < 0 ? (n0 & ~255) + 128 * ((n0 >> 5) & 1) + 32 * ((n0 >> 6) & 3)
                                              : (blk ? (n0 / blk) * (2 * blk) + (n0 % blk) : n0));
        tr_item(src, ldn, c_begin + n0, kb * 64, dst, K, drow0, scr, lane);
    }
    off += nitems;
}

struct PItem { const float* srcp; int ldn; unsigned char* dstp; int ldkb; float scale; int kind; };
__device__ __forceinline__ void pitem_load(const PItem& it, f32x4 (&ld)[8], int lane) {
    const int kr = lane >> 3, n4 = (lane & 7) * 4;
#pragma unroll
    for (int i = 0; i < 8; ++i) ld[i] = __builtin_nontemporal_load((const f32x4*)(it.srcp + (size_t)(8 * i + kr) * it.ldn + n4));
}
__device__ __forceinline__ void pitem_finish(const PItem& it, const f32x4 (&ld)[8], LAS float* scr, int lane) {
    const int kr = lane >> 3, n4 = (lane & 7) * 4;
#pragma unroll
    for (int i = 0; i < 8; ++i) { LAS float* d = scr + (8 * i + kr) * 33 + n4; d[0] = ld[i][0]; d[1] = ld[i][1]; d[2] = ld[i][2]; d[3] = ld[i][3]; }
    LDS_WAIT(); asm volatile("" ::: "memory");
    const int c = lane & 7;
#pragma unroll
    for (int j = 0; j < 4; ++j) { const int n = (lane >> 3) + 8 * j; const LAS float* sp = scr + (8 * c) * 33 + n;
        float v[8];
#pragma unroll
        for (int e = 0; e < 8; ++e) v[e] = sp[e * 33] * it.scale;
        if (it.kind == 2) { v2u o; o.x = pk4i8(v[0], v[1], v[2], v[3]); o.y = pk4i8(v[4], v[5], v[6], v[7]); *(v2u*)(it.dstp + (size_t)n * it.ldkb + 8 * c) = o; }
        else if (it.kind == 1) { v2u o; o.x = pk4f8(v[0], v[1], v[2], v[3]); o.y = pk4f8(v[4], v[5], v[6], v[7]); *(v2u*)(it.dstp + (size_t)n * it.ldkb + 8 * c) = o; }
        else { v4u o; o.x = pk2(v[0], v[1]); o.y = pk2(v[2], v[3]); o.z = pk2(v[4], v[5]); o.w = pk2(v[6], v[7]); *(v4u*)(it.dstp + (size_t)n * it.ldkb + 16 * c) = o; } }
    LDS_WAIT(); asm volatile("" ::: "memory");
}
__device__ __forceinline__ PItem ffn_item(int idx, bool moe, bool f8, const float* wg, const float* wu, const float* wd, unsigned char* Wgu, unsigned char* Wdn) {
    PItem it; const int FF = moe ? FFE : FFD, NI = moe ? 1792 : 1408;
    const int seg = idx / NI, local = idx - seg * NI, e = seg / 3, w = seg - 3 * e; const int esz = (w < 2 || f8) ? 1 : 2;
    if (w < 2) { const int nblk = FF / 32, kb = local / nblk, nb = local - kb * nblk, n0 = nb * 32, drow0 = (n0 >> 7) * 256 + (n0 & 127) + 128 * w;
        it.srcp = (w ? wu : wg) + (size_t)e * DM * FF + (size_t)(kb * 64) * FF + n0; it.ldn = FF;
        it.dstp = Wgu + ((size_t)e * 2 * FF * DM + (size_t)drow0 * DM + kb * 64) * esz; it.ldkb = DM * esz; it.scale = 1024.0f; it.kind = 2; }
    else { const int kb = local >> 5, nb = local & 31, n0 = nb * 32;
        it.srcp = wd + (size_t)e * FF * DM + (size_t)(kb * 64) * DM + n0; it.ldn = DM;
        it.dstp = Wdn + ((size_t)e * DM * FF + (size_t)n0 * FF + kb * 64) * esz; it.ldkb = FF * esz; it.scale = f8 ? 64.0f : 1.0f; it.kind = f8 ? 1 : 0; }
    return it;
}
__device__ __forceinline__ void ffn_prep(bool moe, bool f8, const float* wg, const float* wu, const float* wd, unsigned char* Wgu, unsigned char* Wdn, LAS float* scr, int gw, int NGW, int lane) {
    const int total = moe ? 24 * 1792 : 3 * 1408;
    f32x4 la[8], lb[8];
    int idx = gw; PItem cur, nxt;
    if (idx < total) { cur = ffn_item(idx, moe, f8, wg, wu, wd, Wgu, Wdn); pitem_load(cur, la, lane); }
    while (idx < total) {
        const int nidx = idx + NGW; const bool has = nidx < total;
        if (has) { nxt = ffn_item(nidx, moe, f8, wg, wu, wd, Wgu, Wdn); pitem_load(nxt, lb, lane); }
        pitem_finish(cur, la, scr, lane);
        if (has) {
#pragma unroll
            for (int i = 0; i < 8; ++i) la[i] = lb[i];
            cur = nxt; }
        idx = nidx;
    }
}

template <int MODE>
__device__ __forceinline__ void norm_rows(const float* xin32  , const bf16_t* xin, bf16_t* xout, bool write_x, const bf16_t* ycomb  , const float* gain, bf16_t* H, unsigned char* H8  , float* HS  ,
                                          const float* w8, int ldw8, const float* b8, float* LF, int* ASG, gu32* cnt, int gw, int NGW, int lane) {
    f32x4 gv[4];
#pragma unroll
    for (int jj = 0; jj < 4; ++jj) gv[jj] = ((const f32x4*)gain)[64 * jj + lane];
    float wf[4][4][8];
    if (MODE != 1) {
#pragma unroll
        for (int jj = 0; jj < 4; ++jj)
#pragma unroll
            for (int i = 0; i < 4; ++i) { const float* wr = w8 + (size_t)(4 * lane + 256 * jj + i) * ldw8; const f32x4 a = *(const f32x4*)wr, b = *(const f32x4*)(wr + 4);
                wf[jj][i][0] = a[0]; wf[jj][i][1] = a[1]; wf[jj][i][2] = a[2]; wf[jj][i][3] = a[3]; wf[jj][i][4] = b[0]; wf[jj][i][5] = b[1]; wf[jj][i][6] = b[2]; wf[jj][i][7] = b[3]; }
    }
    int my_e = -1, my_row = 0, my_k = 0, nheld = 0; float my_g = 0.f;
    f32x4 vn[4]; v2u vb[4];
    if (gw < NTOK) {
        if (xin32) {
#pragma unroll
            for (int jj = 0; jj < 4; ++jj) vn[jj] = ((const f32x4*)(xin32 + (size_t)gw * DM))[64 * jj + lane];
        } else {
#pragma unroll
            for (int jj = 0; jj < 4; ++jj) vb[jj] = ((const v2u*)(xin + (size_t)gw * DM))[64 * jj + lane];
        }
    }
    for (int row = gw; row < NTOK; row += NGW) {
        f32x4 v[4];
        if (xin32) {
#pragma unroll
            for (int jj = 0; jj < 4; ++jj) v[jj] = vn[jj];
        } else {
#pragma unroll
            for (int jj = 0; jj < 4; ++jj) v[jj] = (f32x4){blo(vb[jj].x), bhi(vb[jj].x), blo(vb[jj].y), bhi(vb[jj].y)};
        }
        if (row + NGW < NTOK) {
            if (xin32) {
#pragma unroll
                for (int jj = 0; jj < 4; ++jj) vn[jj] = ((const f32x4*)(xin32 + (size_t)(row + NGW) * DM))[64 * jj + lane];
            } else {
#pragma unroll
                for (int jj = 0; jj < 4; ++jj) vb[jj] = ((const v2u*)(xin + (size_t)(row + NGW) * DM))[64 * jj + lane];
            }
        }
        if (ycomb) {
#pragma unroll
            for (int jj = 0; jj < 4; ++jj) { const v2u a = ((const v2u*)(ycomb + (size_t)row * DM))[64 * jj + lane], b = ((const v2u*)(ycomb + ((size_t)NTOK + row) * DM))[64 * jj + lane];
                v[jj][0] += blo(a.x) + blo(b.x); v[jj][1] += bhi(a.x) + bhi(b.x); v[jj][2] += blo(a.y) + blo(b.y); v[jj][3] += bhi(a.y) + bhi(b.y); }
        }
        if (write_x) {
#pragma unroll
            for (int jj = 0; jj < 4; ++jj) { v2u o; o.x = pk2(v[jj][0], v[jj][1]); o.y = pk2(v[jj][2], v[jj][3]); ((v2u*)(xout + (size_t)row * DM))[64 * jj + lane] = o;
                v[jj] = (f32x4){blo(o.x), bhi(o.x), blo(o.y), bhi(o.y)}; }
        }
        float ss = 0.f;
#pragma unroll
        for (int jj = 0; jj < 4; ++jj) ss += (v[jj][0] * v[jj][0] + v[jj][1] * v[jj][1]) + (v[jj][2] * v[jj][2] + v[jj][3] * v[jj][3]);
        const float r = __builtin_amdgcn_rsqf(wave_sum(ss) * (1.0f / DM) + EPS);
#pragma unroll
        for (int jj = 0; jj < 4; ++jj) v[jj] = v[jj] * r * gv[jj];
        float qinv = 1.0f;
        if (HS) { float am = 0.f;
#pragma unroll
            for (int jj = 0; jj < 4; ++jj) am = __builtin_fmaxf(__builtin_fmaxf(am, __builtin_fmaxf(__builtin_fabsf(v[jj][0]), __builtin_fabsf(v[jj][1]))), __builtin_fmaxf(__builtin_fabsf(v[jj][2]), __builtin_fabsf(v[jj][3])));
#pragma unroll
            for (int o = 1; o < 64; o <<= 1) am = __builtin_fmaxf(am, __shfl_xor(am, o));
            am = __builtin_fmaxf(am, 1e-20f); qinv = 127.0f / am; if (lane == 0) HS[row] = am * (1.0f / 127.0f); }
#pragma unroll
        for (int jj = 0; jj < 4; ++jj) {
            if (H8 && HS) ((unsigned*)(H8 + (size_t)row * DM))[64 * jj + lane] = pk4i8(v[jj][0] * qinv, v[jj][1] * qinv, v[jj][2] * qinv, v[jj][3] * qinv);
            else if (H8) ((unsigned*)(H8 + (size_t)row * DM))[64 * jj + lane] = pk4f8(v[jj][0], v[jj][1], v[jj][2], v[jj][3]);
            if (H) { v2u o; o.x = pk2(v[jj][0], v[jj][1]); o.y = pk2(v[jj][2], v[jj][3]); ((v2u*)(H + (size_t)row * DM))[64 * jj + lane] = o; } }
        if (MODE != 1) {
            float ps[8];
#pragma unroll
            for (int j = 0; j < 8; ++j) { float s = 0.f;
#pragma unroll
                for (int jj = 0; jj < 4; ++jj)
#pragma unroll
                    for (int i = 0; i < 4; ++i) s += v[jj][i] * wf[jj][i][j];
                ps[j] = s; }
#define RS_STEP(HH) { const bool up = (lane & HH) != 0; _Pragma("unroll") for (int i = 0; i < HH; ++i) { const float keep = up ? ps[i + HH] : ps[i]; const float send = up ? ps[i] : ps[i + HH]; ps[i] = keep + __shfl_xor(send, HH); } }
            RS_STEP(4) RS_STEP(2) RS_STEP(1)
#undef RS_STEP
            float z = ps[0]; z += __shfl_xor(z, 8); z += __shfl_xor(z, 16); z += __shfl_xor(z, 32);
            if (MODE == 0) {
                if (lane < 8) { z += b8[lane]; const float az = __builtin_fabsf(z);
                    const float ls = __builtin_fminf(z, 0.f) - __builtin_amdgcn_logf(1.0f + __builtin_amdgcn_exp2f(-LOG2E * az)) * 0.6931471805599453f;
                    LF[(size_t)row * 8 + lane] = ls; }
            } else {
                float fd[8];
#pragma unroll
                for (int j = 0; j < 8; ++j) fd[j] = __shfl(z, j);
                int i0 = 0; float v0 = fd[0];
#pragma unroll
                for (int j = 1; j < 8; ++j) if (fd[j] > v0) { v0 = fd[j]; i0 = j; }
                int i1 = -1; float v1 = -3.0e38f;
#pragma unroll
                for (int j = 0; j < 8; ++j) if (j != i0 && fd[j] > v1) { v1 = fd[j]; i1 = j; }
                const float g0 = __builtin_amdgcn_rcpf(1.0f + __builtin_amdgcn_exp2f(LOG2E * (v1 - v0))), g1 = 1.0f - g0;
                if (lane == 2 * nheld) { my_e = i0; my_g = g0; my_row = row; my_k = 0; }
                if (lane == 2 * nheld + 1) { my_e = i1; my_g = g1; my_row = row; my_k = 1; }
                ++nheld;
            }
        }
        if (MODE == 2 && (nheld == 32 || row + NGW >= NTOK)) {
            int pos = 0;
#pragma unroll
            for (int e = 0; e < 8; ++e) { const unsigned long long mk = __ballot(my_e == e);
                if (mk) { const int leader = __builtin_ctzll(mk); unsigned base = 0;
                    if (lane == leader) base = __hip_atomic_fetch_add(cnt + 64 * e, (unsigned)__builtin_popcountll(mk), RLX_AGENT);
                    base = __shfl(base, leader);
                    if (my_e == e) pos = (int)base + __builtin_popcountll(mk & ((1ull << lane) - 1ull)); } }
            if (my_e >= 0) { ASG[(size_t)(my_row * 2 + my_k) * 2] = (my_e << 24) | pos; ASG[(size_t)(my_row * 2 + my_k) * 2 + 1] = (int)__float_as_uint(my_g); }
            my_e = -1; nheld = 0;
        }
    }
}

constexpr int AT_KT = 0, AT_VT = 18432, AT_CK = 36864, AT_WT = 45056, AT_TS = 144, AT_QS = 49152  ;
__device__ __forceinline__ void attn_unit(LAS unsigned char* lds, int b, int h, int qb, const bf16_t* Qr, const bf16_t* Kr, const bf16_t* VT, const float* LF,
                                          const float* gq, const float* gk, bf16_t* O, int tid) {
    const int lane = tid & 63, wave = __builtin_amdgcn_readfirstlane(tid >> 6), r32 = lane & 31, hi = lane >> 5;
    const size_t rowbase = (size_t)b * SEQ;
    LAS float* CK = (LAS float*)(lds + AT_CK); LAS float* WT = (LAS float*)(lds + AT_WT);
    {
        float v0 = LF[(rowbase + 4 * tid + 0) * 8 + h], v1 = LF[(rowbase + 4 * tid + 1) * 8 + h], v2 = LF[(rowbase + 4 * tid + 2) * 8 + h], v3 = LF[(rowbase + 4 * tid + 3) * 8 + h];
        v1 += v0; v2 += v1; v3 += v2;
        float incl = v3;
#pragma unroll
        for (int o = 1; o < 64; o <<= 1) { const float n = __shfl_up(incl, o); if (lane >= o) incl += n; }
        if (lane == 63) WT[wave] = incl;
        __syncthreads();
        float base = 0.f;
        for (int w = 0; w < wave; ++w) base += WT[w];
        const float ex = base + incl - v3;
        *(LAS f32x4*)(CK + 4 * tid) = (f32x4){(ex + v0) * -LOG2E, (ex + v1) * -LOG2E, (ex + v2) * -LOG2E, (ex + v3) * -LOG2E};
        __syncthreads();
    }
    const int q_abs = qb * 256 + wave * 32 + r32;
    bf16x8 qf[4];
    {
        const bf16_t* qp = Qr + (rowbase + q_abs) * 512 + h * 64 + 8 * hi;
#pragma unroll
        for (int s = 0; s < 4; ++s) qf[s] = *(const bf16x8*)(qp + 16 * s);
    }
    const int NT = 4 * qb + 4;
    const int lkv = tid >> 3, lch = tid & 7;
    const bf16_t* kp = Kr + (rowbase + lkv) * 512 + h * 64 + 8 * lch;
    const bf16_t* vp = VT + (size_t)(h * 64 + lkv) * NTOK + rowbase + 8 * lch;
    v4u kreg = *(const v4u*)kp, vreg = *(const v4u*)vp;
    f32x16 o0, o1;
#pragma unroll
    for (int i = 0; i < 16; ++i) { o0[i] = 0.f; o1[i] = 0.f; }
    float mrun = -1.0e30f, lrun = 0.f;
    const int qw_max = qb * 256 + wave * 32 + 31, qw_min = qb * 256 + wave * 32;
    for (int j = 0; j < NT; ++j) {
        const int buf = j & 1;
        *(LAS v4u*)(lds + AT_KT + buf * 9216 + lkv * AT_TS + lch * 16) = kreg;
        *(LAS v4u*)(lds + AT_VT + buf * 9216 + lkv * AT_TS + lch * 16) = vreg;
        __syncthreads();
        if (j + 1 < NT) { kreg = *(const v4u*)(kp + (size_t)(j + 1) * 64 * 512); vreg = *(const v4u*)(vp + (j + 1) * 64); }
        if (64 * j <= qw_max) {
            const LAS unsigned char* KT = lds + AT_KT + buf * 9216; const LAS unsigned char* VTL = lds + AT_VT + buf * 9216;
            f32x16 p0, p1;
            const int kvb = 64 * j;
#pragma unroll
            for (int g4 = 0; g4 < 4; ++g4) { const f32x4 c0 = *(const LAS f32x4*)(CK + kvb + 4 * hi + 8 * g4), c1 = *(const LAS f32x4*)(CK + kvb + 32 + 4 * hi + 8 * g4);
#pragma unroll
                for (int e = 0; e < 4; ++e) { p0[4 * g4 + e] = c0[e]; p1[4 * g4 + e] = c1[e]; } }
#pragma unroll
            for (int s = 0; s < 4; ++s) {
                const bf16x8 a0 = *(const LAS bf16x8*)(KT + r32 * AT_TS + (16 * s + 8 * hi) * 2);
                const bf16x8 a1 = *(const LAS bf16x8*)(KT + (32 + r32) * AT_TS + (16 * s + 8 * hi) * 2);
                p0 = MFMA32(a0, qf[s], p0); p1 = MFMA32(a1, qf[s], p1);
            }
            if (kvb + 63 > qw_min) {
#pragma unroll
                for (int i = 0; i < 16; ++i) { const int kv = kvb + crow(i, hi); if (kv > q_abs) p0[i] = -1.0e30f; if (kv + 32 > q_abs) p1[i] = -1.0e30f; }
            }
            float mx = p0[0];
#pragma unroll
            for (int i = 1; i < 16; ++i) mx = __builtin_fmaxf(mx, p0[i]);
#pragma unroll
            for (int i = 0; i < 16; ++i) mx = __builtin_fmaxf(mx, p1[i]);
            mx = __builtin_fmaxf(mx, __shfl_xor(mx, 32));
            const float mnew = __builtin_fmaxf(mrun, mx), alpha = __builtin_amdgcn_exp2f(mrun - mnew); mrun = mnew;
            float ls = 0.f;
#pragma unroll
            for (int i = 0; i < 16; ++i) { p0[i] = __builtin_amdgcn_exp2f(p0[i] - mnew); p1[i] = __builtin_amdgcn_exp2f(p1[i] - mnew); ls += p0[i] + p1[i]; }
            lrun = lrun * alpha + ls;
            if (__any(alpha != 1.0f)) {
#pragma unroll
                for (int i = 0; i < 16; ++i) { o0[i] *= alpha; o1[i] *= alpha; }
            }
            bf16x8 pf[4];
            { v4u w;
              w.x = pk2(p0[0], p0[1]); w.y = pk2(p0[2], p0[3]); w.z = pk2(p0[4], p0[5]); w.w = pk2(p0[6], p0[7]); pf[0] = __builtin_bit_cast(bf16x8, w);
              w.x = pk2(p0[8], p0[9]); w.y = pk2(p0[10], p0[11]); w.z = pk2(p0[12], p0[13]); w.w = pk2(p0[14], p0[15]); pf[1] = __builtin_bit_cast(bf16x8, w);
              w.x = pk2(p1[0], p1[1]); w.y = pk2(p1[2], p1[3]); w.z = pk2(p1[4], p1[5]); w.w = pk2(p1[6], p1[7]); pf[2] = __builtin_bit_cast(bf16x8, w);
              w.x = pk2(p1[8], p1[9]); w.y = pk2(p1[10], p1[11]); w.z = pk2(p1[12], p1[13]); w.w = pk2(p1[14], p1[15]); pf[3] = __builtin_bit_cast(bf16x8, w); }
#pragma unroll
            for (int ks = 0; ks < 4; ++ks) {
                const v2u a0l = *(const LAS v2u*)(VTL + r32 * AT_TS + (16 * ks + 4 * hi) * 2), a0h = *(const LAS v2u*)(VTL + r32 * AT_TS + (16 * ks + 8 + 4 * hi) * 2);
                const v2u a1l = *(const LAS v2u*)(VTL + (32 + r32) * AT_TS + (16 * ks + 4 * hi) * 2), a1h = *(const LAS v2u*)(VTL + (32 + r32) * AT_TS + (16 * ks + 8 + 4 * hi) * 2);
                const v4u A0 = (v4u){a0l.x, a0l.y, a0h.x, a0h.y}, A1 = (v4u){a1l.x, a1l.y, a1h.x, a1h.y};
                o0 = MFMA32(__builtin_bit_cast(bf16x8, A0), pf[ks], o0); o1 = MFMA32(__builtin_bit_cast(bf16x8, A1), pf[ks], o1);
            }
        }
    }
    lrun += __shfl_xor(lrun, 32);
    const float inv = __builtin_amdgcn_rcpf(lrun);
    bf16_t* op = O + (rowbase + q_abs) * 512 + h * 64 + 4 * hi;
#pragma unroll
    for (int g4 = 0; g4 < 4; ++g4) {
        v2u w0, w1; w0.x = pk2(o0[4 * g4] * inv, o0[4 * g4 + 1] * inv); w0.y = pk2(o0[4 * g4 + 2] * inv, o0[4 * g4 + 3] * inv);
        w1.x = pk2(o1[4 * g4] * inv, o1[4 * g4 + 1] * inv); w1.y = pk2(o1[4 * g4 + 2] * inv, o1[4 * g4 + 3] * inv);
        *(v2u*)(op + 8 * g4) = w0; *(v2u*)(op + 32 + 8 * g4) = w1;
    }
    __syncthreads();
}


__device__ __forceinline__ void attn_unit2(LAS unsigned char* lds, int b, int h, int qb, const bf16_t* Qr, const bf16_t* Kr, const bf16_t* VT, const float* LF, const float* gq, const float* gk, unsigned char* O, float* Osc, const unsigned* vmaxp, int tid) {
    const int lane = tid & 63, wave = __builtin_amdgcn_readfirstlane(tid >> 6), r32 = lane & 31, hi = lane >> 5;
    const size_t rowbase = (size_t)b * SEQ;
    LAS float* CK = (LAS float*)(lds + AT_CK); LAS float* WT = (LAS float*)(lds + AT_WT);
    {
        float v0 = LF[(rowbase + 4 * tid + 0) * 8 + h], v1 = LF[(rowbase + 4 * tid + 1) * 8 + h], v2 = LF[(rowbase + 4 * tid + 2) * 8 + h], v3 = LF[(rowbase + 4 * tid + 3) * 8 + h];
        v1 += v0; v2 += v1; v3 += v2;
        float incl = v3;
#pragma unroll
        for (int o = 1; o < 64; o <<= 1) { const float n = __shfl_up(incl, o); if (lane >= o) incl += n; }
        if (lane == 63) WT[wave] = incl;
        __syncthreads();
        float base = 0.f;
        for (int w = 0; w < wave; ++w) base += WT[w];
        const float ex = base + incl - v3;
        *(LAS f32x4*)(CK + 4 * tid) = (f32x4){(ex + v0) * -LOG2E, (ex + v1) * -LOG2E, (ex + v2) * -LOG2E, (ex + v3) * -LOG2E};
        __syncthreads();
    }
    const int qw0 = qb * 512 + wave * 64;
    const int qa0 = qw0 + r32, qa1 = qw0 + 32 + r32;
    LAS unsigned char* qimg = lds + AT_QS + wave * 8192 + lane * 16;
    {
        const bf16_t* qp = Qr + (rowbase + qa0) * 512 + h * 64 + 8 * hi;
        bf16x8 q0[4], q1[4];
#pragma unroll
        for (int s = 0; s < 4; ++s) { q0[s] = *(const bf16x8*)(qp + 16 * s); q1[s] = *(const bf16x8*)(qp + 32 * 512 + 16 * s); }
#pragma unroll
        for (int s = 0; s < 4; ++s) { *(LAS bf16x8*)(qimg + s * 1024) = q0[s]; *(LAS bf16x8*)(qimg + (4 + s) * 1024) = q1[s]; }
    }
    float MBf;
    { float a = __builtin_fabsf(gq[lane]), c = __builtin_fabsf(gk[lane]);
#pragma unroll
      for (int o = 1; o < 64; o <<= 1) { a = __builtin_fmaxf(a, __shfl_xor(a, o)); c = __builtin_fmaxf(c, __shfl_xor(c, o)); }
      MBf = 0.125f * LOG2E * 64.0f * 1.02f * a * c; }
    const bool fixed = __builtin_amdgcn_readfirstlane(__float_as_uint(MBf)) < __float_as_uint(40.0f);
    const int NT = 8 * qb + 8;
    const int lkv = tid >> 3, lch = tid & 7;
    const bf16_t* kp = Kr + (rowbase + lkv) * 512 + h * 64 + 8 * lch;
    const bf16_t* vp = VT + (size_t)(h * 64 + lkv) * NTOK + rowbase + 8 * lch;
#define AT2_CAT16(A, B, C, D) __builtin_shufflevector(__builtin_shufflevector(A, B, 0, 1, 2, 3, 4, 5, 6, 7), __builtin_shufflevector(C, D, 0, 1, 2, 3, 4, 5, 6, 7), 0, 1, 2, 3, 4, 5, 6, 7, 8, 9, 10, 11, 12, 13, 14, 15)
#define AT2_QK(P0, P1, QF) { \
            { const LAS f32x4* cp = (const LAS f32x4*)(CK + kvb + 4 * hi); P0 = AT2_CAT16(cp[0], cp[2], cp[4], cp[6]); P1 = AT2_CAT16(cp[8], cp[10], cp[12], cp[14]); } \
            bf16x8 kfa[4], kfb[4]; \
            _Pragma("unroll") for (int s = 0; s < 4; ++s) { kfa[s] = *(const LAS bf16x8*)(KT + r32 * AT_TS + (16 * s + 8 * hi) * 2); kfb[s] = *(const LAS bf16x8*)(KT + (32 + r32) * AT_TS + (16 * s + 8 * hi) * 2); } \
            bf16x8 qfr[4]; _Pragma("unroll") for (int s = 0; s < 4; ++s) qfr[s] = *(const LAS bf16x8*)(qimg + (4 * (QF) + s) * 1024); \
            __builtin_amdgcn_sched_barrier(0); \
            _Pragma("unroll") for (int s = 0; s < 4; ++s) { P0 = MFMA32(kfa[s], qfr[s], P0); P1 = MFMA32(kfb[s], qfr[s], P1); } }
#define AT2_MASK(P0, P1, QA) { if (kvb + 63 > (QA) - r32) { _Pragma("unroll") for (int i = 0; i < 16; ++i) { const int kv = kvb + crow(i, hi); if (kv > (QA)) P0[i] = -1.0e30f; if (kv + 32 > (QA)) P1[i] = -1.0e30f; } } }
    float rta, rtb;
    if (fixed) { rta = -CK[qb * 512 + wave * 64 + r32] - MBf; rtb = -CK[qb * 512 + wave * 64 + 32 + r32] - MBf; }
    else {
        float mxa = -1.0e30f, mxb = -1.0e30f;
        v4u kr = *(const v4u*)kp;
        for (int j = 0; j < NT; ++j) {
            const int buf = j & 1;
            *(LAS v4u*)(lds + AT_KT + buf * 9216 + lkv * AT_TS + lch * 16) = kr;
            __syncthreads();
            if (j + 1 < NT) kr = *(const v4u*)(kp + (size_t)(j + 1) * 64 * 512);
            const int kvb = 64 * j;
            if (kvb <= qw0 + 63) {
                const LAS unsigned char* KT = lds + AT_KT + buf * 9216;
                if (kvb <= qw0 + 31) { f32x16 p0, p1; AT2_QK(p0, p1, 0) AT2_MASK(p0, p1, qa0)
#pragma unroll
                    for (int i = 0; i < 16; ++i) mxa = __builtin_fmaxf(mxa, __builtin_fmaxf(p0[i], p1[i])); }
                { f32x16 p0, p1; AT2_QK(p0, p1, 1) AT2_MASK(p0, p1, qa1)
#pragma unroll
                    for (int i = 0; i < 16; ++i) mxb = __builtin_fmaxf(mxb, __builtin_fmaxf(p0[i], p1[i])); }
            }
        }
        __syncthreads();
        mxa = __builtin_fmaxf(mxa, __shfl_xor(mxa, 32)); mxb = __builtin_fmaxf(mxb, __shfl_xor(mxb, 32));
        rta = -mxa; rtb = -mxb;
    }
    v4u kreg = *(const v4u*)kp, vreg = *(const v4u*)vp;
    f32x16 oa0, oa1, ob0, ob1;
#pragma unroll
    for (int i = 0; i < 16; ++i) { oa0[i] = 0.f; oa1[i] = 0.f; ob0[i] = 0.f; ob1[i] = 0.f; }
    float l0 = 0.f, l1 = 0.f;
    for (int j = 0; j < NT; ++j) {
        const int buf = j & 1;
        *(LAS v4u*)(lds + AT_KT + buf * 9216 + lkv * AT_TS + lch * 16) = kreg;
        *(LAS v4u*)(lds + AT_VT + buf * 9216 + lkv * AT_TS + lch * 16) = vreg;
        __syncthreads();
        if (j + 1 < NT) { kreg = *(const v4u*)(kp + (size_t)(j + 1) * 64 * 512); vreg = *(const v4u*)(vp + (j + 1) * 64); }
        const int kvb = 64 * j;
        if (kvb <= qw0 + 63) {
            const LAS unsigned char* KT = lds + AT_KT + buf * 9216; const LAS unsigned char* VTL = lds + AT_VT + buf * 9216;
            const bool act0 = kvb <= qw0 + 31;
            bf16x8 pfa[4], pfb[4];
#define AT2_SOFTMAX(P0, P1, QA, RT, LR, PF) { \
            AT2_MASK(P0, P1, QA) \
            { P0 += (RT); P1 += (RT);        \
              _Pragma("unroll") for (int i = 0; i < 16; ++i) { P0[i] = __builtin_amdgcn_exp2f(P0[i]); P1[i] = __builtin_amdgcn_exp2f(P1[i]); } \
              f32x2_t ls2 = {0.f, 0.f};        \
              _Pragma("unroll") for (int i = 0; i < 8; ++i) ls2 += (f32x2_t){P0[2 * i], P0[2 * i + 1]} + (f32x2_t){P1[2 * i], P1[2 * i + 1]}; \
              LR += ls2[0] + ls2[1]; } \
            { v4u w; \
              w.x = pk2(P0[0], P0[1]); w.y = pk2(P0[2], P0[3]); w.z = pk2(P0[4], P0[5]); w.w = pk2(P0[6], P0[7]); PF[0] = __builtin_bit_cast(bf16x8, w); \
              w.x = pk2(P0[8], P0[9]); w.y = pk2(P0[10], P0[11]); w.z = pk2(P0[12], P0[13]); w.w = pk2(P0[14], P0[15]); PF[1] = __builtin_bit_cast(bf16x8, w); \
              w.x = pk2(P1[0], P1[1]); w.y = pk2(P1[2], P1[3]); w.z = pk2(P1[4], P1[5]); w.w = pk2(P1[6], P1[7]); PF[2] = __builtin_bit_cast(bf16x8, w); \
              w.x = pk2(P1[8], P1[9]); w.y = pk2(P1[10], P1[11]); w.z = pk2(P1[12], P1[13]); w.w = pk2(P1[14], P1[15]); PF[3] = __builtin_bit_cast(bf16x8, w); } }
            if (act0) { f32x16 pa0, pa1; AT2_QK(pa0, pa1, 0) AT2_SOFTMAX(pa0, pa1, qa0, rta, l0, pfa) }
            { f32x16 pb0, pb1; AT2_QK(pb0, pb1, 1) AT2_SOFTMAX(pb0, pb1, qa1, rtb, l1, pfb) }
#undef AT2_SOFTMAX
#pragma unroll
            for (int kg = 0; kg < 2; ++kg) {
                bf16x8 VA0[2], VA1[2];
#pragma unroll
                for (int k2 = 0; k2 < 2; ++k2) { const int ks = 2 * kg + k2;
                    const v2u a0l = *(const LAS v2u*)(VTL + r32 * AT_TS + (16 * ks + 4 * hi) * 2), a0h = *(const LAS v2u*)(VTL + r32 * AT_TS + (16 * ks + 8 + 4 * hi) * 2);
                    const v2u a1l = *(const LAS v2u*)(VTL + (32 + r32) * AT_TS + (16 * ks + 4 * hi) * 2), a1h = *(const LAS v2u*)(VTL + (32 + r32) * AT_TS + (16 * ks + 8 + 4 * hi) * 2);
                    VA0[k2] = __builtin_bit_cast(bf16x8, ((v4u){a0l.x, a0l.y, a0h.x, a0h.y})); VA1[k2] = __builtin_bit_cast(bf16x8, ((v4u){a1l.x, a1l.y, a1h.x, a1h.y})); }
                __builtin_amdgcn_sched_barrier(0);
#pragma unroll
                for (int k2 = 0; k2 < 2; ++k2) { const int ks = 2 * kg + k2;
                    if (act0) { oa0 = MFMA32(VA0[k2], pfa[ks], oa0); oa1 = MFMA32(VA1[k2], pfa[ks], oa1); }
                    ob0 = MFMA32(VA0[k2], pfb[ks], ob0); ob1 = MFMA32(VA1[k2], pfb[ks], ob1); }
            }
        }
    }
#undef AT2_MASK
#undef AT2_QK
#undef AT2_CAT16
    l0 += __shfl_xor(l0, 32); l1 += __shfl_xor(l1, 32);
    const float vm = __builtin_fmaxf(__uint_as_float(__hip_atomic_load(vmaxp, __ATOMIC_RELAXED, __HIP_MEMORY_SCOPE_AGENT)), 1e-20f), qsc = 127.0f / vm;
    const float inv0 = __builtin_amdgcn_rcpf(l0) * qsc, inv1 = __builtin_amdgcn_rcpf(l1) * qsc;
    unsigned char* op0 = O + (rowbase + qa0) * 512 + h * 64 + 4 * hi; unsigned char* op1 = op0 + 32 * 512;
#pragma unroll
    for (int g4 = 0; g4 < 4; ++g4) {
        *(unsigned*)(op0 + 8 * g4) = pk4i8(oa0[4 * g4] * inv0, oa0[4 * g4 + 1] * inv0, oa0[4 * g4 + 2] * inv0, oa0[4 * g4 + 3] * inv0);
        *(unsigned*)(op0 + 32 + 8 * g4) = pk4i8(oa1[4 * g4] * inv0, oa1[4 * g4 + 1] * inv0, oa1[4 * g4 + 2] * inv0, oa1[4 * g4 + 3] * inv0);
        *(unsigned*)(op1 + 8 * g4) = pk4i8(ob0[4 * g4] * inv1, ob0[4 * g4 + 1] * inv1, ob0[4 * g4 + 2] * inv1, ob0[4 * g4 + 3] * inv1);
        *(unsigned*)(op1 + 32 + 8 * g4) = pk4i8(ob1[4 * g4] * inv1, ob1[4 * g4 + 1] * inv1, ob1[4 * g4 + 2] * inv1, ob1[4 * g4 + 3] * inv1);
    }
    if (h == 0 && hi == 0) { Osc[rowbase + qa0] = vm * (1.0f / 127.0f); Osc[rowbase + qa1] = vm * (1.0f / 127.0f); }
    __syncthreads();
}

constexpr int SG_VT = 0, SG_VS = 272, SG_WB = 64 * 272, SG_PS = 8 * SG_WB;
__device__ __forceinline__ void sgu_unit(LAS unsigned char* lds, int chunk, const bf16_t* SUV, const float* gsgu, const bf16_t* Wsp, const float* bsp, unsigned char* O, float* Osc, int tid) {
    const int lane = tid & 63, g = __builtin_amdgcn_readfirstlane(tid >> 6), r32 = lane & 31, hi = lane >> 5;
    const size_t row0 = (size_t)chunk * 128;
    LAS float* PS = (LAS float*)(lds + SG_PS);
    LAS unsigned char* VTw = lds + SG_VT + g * SG_WB;
    const int c8 = lane & 7, rl = lane >> 3;
    v4u raw[16];
#pragma unroll
    for (int i = 0; i < 16; ++i) raw[i] = *(const v4u*)(SUV + (row0 + rl + 8 * i) * 1024 + 512 + g * 64 + 8 * c8);
#pragma unroll
    for (int i = 0; i < 16; ++i) { float ss = 0.f;
#pragma unroll
        for (int e = 0; e < 4; ++e) { const float a = blo(raw[i][e]), c = bhi(raw[i][e]); ss += a * a + c * c; }
        ss += __shfl_xor(ss, 1); ss += __shfl_xor(ss, 2); ss += __shfl_xor(ss, 4);
        if (c8 == 0) PS[(rl + 8 * i) * 8 + g] = ss; }
    __syncthreads();
    const f32x4 gs0 = *(const f32x4*)(gsgu + g * 64 + 8 * c8), gs1 = *(const f32x4*)(gsgu + g * 64 + 8 * c8 + 4);
#pragma unroll
    for (int i = 0; i < 16; ++i) { const int t = rl + 8 * i;
        const f32x4 pa = *(const LAS f32x4*)(PS + t * 8), pb = *(const LAS f32x4*)(PS + t * 8 + 4);
        const float r = __builtin_amdgcn_rsqf(((pa[0] + pa[1]) + (pa[2] + pa[3]) + (pb[0] + pb[1]) + (pb[2] + pb[3])) * (1.0f / 512.0f) + EPS);
        float f[8]; f[0] = blo(raw[i].x) * r * gs0[0]; f[1] = bhi(raw[i].x) * r * gs0[1]; f[2] = blo(raw[i].y) * r * gs0[2]; f[3] = bhi(raw[i].y) * r * gs0[3];
        f[4] = blo(raw[i].z) * r * gs1[0]; f[5] = bhi(raw[i].z) * r * gs1[1]; f[6] = blo(raw[i].w) * r * gs1[2]; f[7] = bhi(raw[i].w) * r * gs1[3];
#pragma unroll
        for (int e = 0; e < 8; ++e) *(LAS bf16_t*)(VTw + (8 * c8 + e) * SG_VS + t * 2) = f2bf(f[e]); }
    __syncthreads();
    const bf16_t* Wg = Wsp + (size_t)g * 128 * 128;
    unsigned res[4][16];
#pragma unroll
    for (int tb = 0; tb < 4; ++tb) {
        f32x16 a0, a1;
#pragma unroll
        for (int i = 0; i < 16; ++i) { a0[i] = 0.f; a1[i] = 0.f; }
        const int nks = 2 * (tb + 1);
        bf16x8 Af[8];
#pragma unroll
        for (int ks = 0; ks < 8; ++ks) if (ks < nks) Af[ks] = *(const bf16x8*)(Wg + (32 * tb + r32) * 128 + 16 * ks + 8 * hi);
#pragma unroll
        for (int ks = 0; ks < 8; ++ks) { if (ks >= nks) break;
            const bf16x8 A = Af[ks];
            const bf16x8 B0 = *(const LAS bf16x8*)(VTw + r32 * SG_VS + (16 * ks + 8 * hi) * 2), B1 = *(const LAS bf16x8*)(VTw + (32 + r32) * SG_VS + (16 * ks + 8 * hi) * 2);
            a0 = MFMA32(A, B0, a0); a1 = MFMA32(A, B1, a1);
        }
        float bsv[16];
#pragma unroll
        for (int i = 0; i < 16; ++i) bsv[i] = bsp[g * 128 + 32 * tb + crow(i, hi)];
#pragma unroll
        for (int i = 0; i < 16; ++i) res[tb][i] = pk2(a0[i] + bsv[i], a1[i] + bsv[i]);
    }
    v4u ur[16];
#pragma unroll
    for (int i = 0; i < 16; ++i) ur[i] = *(const v4u*)(SUV + (row0 + 16 * g + i) * 1024 + 8 * lane);
    __syncthreads();
#pragma unroll
    for (int tb = 0; tb < 4; ++tb)
#pragma unroll
        for (int i = 0; i < 16; ++i) { const int t = 32 * tb + crow(i, hi);
            *(LAS bf16_t*)(lds + t * 1040 + (g * 64 + r32) * 2) = (bf16_t)(res[tb][i] & 0xffffu); *(LAS bf16_t*)(lds + t * 1040 + (g * 64 + 32 + r32) * 2) = (bf16_t)(res[tb][i] >> 16); }
    __syncthreads();
#pragma unroll
    for (int hb = 0; hb < 2; ++hb) { float f[8][8];
#pragma unroll
        for (int i = 0; i < 8; ++i) { const int t = 16 * g + 8 * hb + i; const v4u v = *(const LAS v4u*)(lds + t * 1040 + lane * 16); const v4u u = ur[8 * hb + i];
            f[i][0] = blo(v.x) * blo(u.x); f[i][1] = bhi(v.x) * bhi(u.x); f[i][2] = blo(v.y) * blo(u.y); f[i][3] = bhi(v.y) * bhi(u.y);
            f[i][4] = blo(v.z) * blo(u.z); f[i][5] = bhi(v.z) * bhi(u.z); f[i][6] = blo(v.w) * blo(u.w); f[i][7] = bhi(v.w) * bhi(u.w); }
        quant_store8(f, O, Osc, row0, 16 * g + 8 * hb, 1, lane); }
    __syncthreads();
}

constexpr int CP_RS = 1040, CP_PS = 98304;
__device__ __forceinline__ void conv_load(int tile, const bf16_t* CY, int tid, v4u (&st)[12]) {
    const size_t row0 = (size_t)tile * 64; const int t0 = (tile * 64) % SEQ;
#pragma unroll
    for (int i = 0; i < 12; ++i) { const int idx = tid + 512 * i, r = idx >> 6, ch = idx & 63; int rr = idx < 94 * 64 ? r : 93; rr = rr < 30 - t0 ? 30 - t0 : rr;
        st[i] = *(const v4u*)(CY + (row0 - 30 + rr) * 512 + 8 * ch); }
}
__device__ __forceinline__ void conv_stage(LAS unsigned char* lds, int tile, int tid, const v4u (&st)[12]) {
    const int t0 = (tile * 64) % SEQ;
#pragma unroll
    for (int i = 0; i < 12; ++i) { const int idx = tid + 512 * i, r = idx >> 6, ch = idx & 63; const unsigned mk = (t0 - 30 + r >= 0) ? 0xffffffffu : 0u;
        if (idx < 94 * 64) *(LAS v4u*)(lds + r * CP_RS + ch * 16) = (v4u){st[i].x & mk, st[i].y & mk, st[i].z & mk, st[i].w & mk}; }
}
__device__ __forceinline__ void conv_main(LAS unsigned char* lds, int tile, const f32x2_t (&w)[31], f32x2_t bias, const float* gcv, unsigned char* Oc, float* Osc, int tid) {
    const size_t row0 = (size_t)tile * 64;
    const int p = tid & 255, hf = tid >> 8;
#pragma unroll 1
    for (int tg = 0; tg < 8; ++tg) {
        f32x2_t z2[4];
#pragma unroll
        for (int t = 0; t < 4; ++t) z2[t] = bias;
        const LAS unsigned char* col = lds + (8 * tg + 4 * hf) * CP_RS + p * 4;
        f32x2_t y2[34];
#pragma unroll
        for (int i = 0; i < 34; ++i) { const unsigned u = *(const LAS unsigned*)(col + i * CP_RS); y2[i] = (f32x2_t){__uint_as_float(u << 16), __uint_as_float(u & 0xffff0000u)}; }
#pragma unroll
        for (int t = 0; t < 4; ++t)
#pragma unroll
            for (int j = 0; j < 31; ++j) z2[t] = __builtin_elementwise_fma(w[j], y2[t + j], z2[t]);
        __syncthreads();
#pragma unroll
        for (int t = 0; t < 4; ++t) *(LAS unsigned*)(lds + (8 * tg + 4 * hf + t) * CP_RS + p * 4) = pk2(z2[t][0], z2[t][1]);
    }
    __syncthreads();
    {
        const int ch8 = tid & 63, tr = tid >> 6;
        const f32x4 g0 = *(const f32x4*)(gcv + 8 * ch8), g1 = *(const f32x4*)(gcv + 8 * ch8 + 4);
        v4u v[8]; float ss[8];
#pragma unroll
        for (int i = 0; i < 8; ++i) { v[i] = *(const LAS v4u*)(lds + (tr + 8 * i) * CP_RS + ch8 * 16); ss[i] = 0.f;
#pragma unroll
            for (int e = 0; e < 4; ++e) { const float a = blo(v[i][e]), c = bhi(v[i][e]); ss[i] += a * a + c * c; } }
#pragma unroll
        for (int o = 1; o < 64; o <<= 1)
#pragma unroll
            for (int i = 0; i < 8; ++i) ss[i] += __shfl_xor(ss[i], o);
        float f[8][8];
#pragma unroll
        for (int i = 0; i < 8; ++i) { const float r = __builtin_amdgcn_rsqf(ss[i] * (1.0f / 512.0f) + EPS);
            f[i][0] = blo(v[i].x) * r * g0[0]; f[i][1] = bhi(v[i].x) * r * g0[1]; f[i][2] = blo(v[i].y) * r * g0[2]; f[i][3] = bhi(v[i].y) * r * g0[3];
            f[i][4] = blo(v[i].z) * r * g1[0]; f[i][5] = bhi(v[i].z) * r * g1[1]; f[i][6] = blo(v[i].w) * r * g1[2]; f[i][7] = bhi(v[i].w) * r * g1[3];
#pragma unroll
            for (int e = 0; e < 8; ++e) f[i][e] *= sigm(f[i][e]); }
        quant_store8(f, Oc, Osc, row0, tr, 8, ch8);
    }
    __syncthreads();
}
__device__ __forceinline__ void pool_load(int tile, const bf16_t* PIN, int tid, v4u (&st)[10]) {
    const size_t row0 = (size_t)tile * 64; const int t0 = (tile * 64) % SEQ;
#pragma unroll
    for (int i = 0; i < 10; ++i) { const int idx = tid + 512 * i, r = idx >> 6, ch = idx & 63; const int tt = t0 - 15 + r;
        const bool ok = idx < 79 * 64 && tt >= 0;
        const unsigned mk = ok ? 0xffffffffu : 0u; const v4u x = *(const v4u*)(PIN + (ok ? (row0 - 15 + r) * 512 + 8 * ch : (size_t)0)); st[i] = (v4u){x.x & mk, x.y & mk, x.z & mk, x.w & mk}; }
}
__device__ __forceinline__ void pool_stage(LAS unsigned char* lds, int tid, const v4u (&st)[10]) {
#pragma unroll
    for (int i = 0; i < 10; ++i) { const int idx = tid + 512 * i, r = idx >> 6, ch = idx & 63; if (idx < 79 * 64) *(LAS v4u*)(lds + r * CP_RS + ch * 16) = st[i]; }
}
__device__ __forceinline__ void pool_sums(LAS unsigned char* lds, int tile, int tid) {
    const int wave = __builtin_amdgcn_readfirstlane(tid >> 6);
    const int t0 = (tile * 64) % SEQ;
    {
        float pv[79];
#pragma unroll
        for (int i = 0; i < 79; ++i) pv[i] = bf1(*(const LAS bf16_t*)(lds + i * CP_RS + tid * 2));
        const bool first = (t0 == 0);
        const int wsel = wave >> 1;
#define POOL_W(W) { _Pragma("unroll") for (int t = 0; t < 64; ++t) { float s = 0.f; _Pragma("unroll") for (int j = 0; j < W; ++j) s += pv[t + 15 - j]; \
            const float inv = first ? (1.0f / (float)((t + 1) < W ? (t + 1) : W)) : (1.0f / (float)W); \
            *(LAS bf16_t*)(lds + t * CP_RS + tid * 2) = f2bf(s * inv - pv[t + 15]); } }
        if (wsel == 0) POOL_W(2) else if (wsel == 1) POOL_W(4) else if (wsel == 2) POOL_W(8) else POOL_W(16)
#undef POOL_W
    }
    __syncthreads();
}
__device__ __forceinline__ void pool_main(LAS unsigned char* lds, int tile, const bf16_t* Wpg, const float* pls, int tid) {
    const int lane = tid & 63, wave = __builtin_amdgcn_readfirstlane(tid >> 6), r32 = lane & 31, hi = lane >> 5;
    const size_t row0 = (size_t)tile * 64;
    const int g = wave >> 1, nh = wave & 1;
    {
        f32x16 acc[2][2];
#pragma unroll
        for (int a = 0; a < 2; ++a)
#pragma unroll
            for (int c = 0; c < 2; ++c)
#pragma unroll
                for (int i = 0; i < 16; ++i) acc[a][c][i] = 0.f;
#pragma unroll
        for (int kh = 0; kh < 2; ++kh) {
            bf16x8 Bw[4][2];
#pragma unroll
            for (int k4 = 0; k4 < 4; ++k4) { const int ks = 4 * kh + k4; Bw[k4][0] = *(const bf16x8*)(Wpg + ((size_t)g * 128 + 64 * nh + r32) * 128 + 16 * ks + 8 * hi); Bw[k4][1] = *(const bf16x8*)(Wpg + ((size_t)g * 128 + 64 * nh + 32 + r32) * 128 + 16 * ks + 8 * hi); }
#pragma unroll
            for (int k4 = 0; k4 < 4; ++k4) { const int ks = 4 * kh + k4;
                const bf16x8 A0 = *(const LAS bf16x8*)(lds + r32 * CP_RS + (g * 128 + 16 * ks + 8 * hi) * 2), A1 = *(const LAS bf16x8*)(lds + (32 + r32) * CP_RS + (g * 128 + 16 * ks + 8 * hi) * 2);
                acc[0][0] = MFMA32(A0, Bw[k4][0], acc[0][0]); acc[0][1] = MFMA32(A0, Bw[k4][1], acc[0][1]); acc[1][0] = MFMA32(A1, Bw[k4][0], acc[1][0]); acc[1][1] = MFMA32(A1, Bw[k4][1], acc[1][1]); }
        }
        __syncthreads();
#pragma unroll
        for (int ct = 0; ct < 2; ++ct) { const int col = g * 128 + 64 * nh + 32 * ct + r32; const float sc = pls[col];
#pragma unroll
            for (int rt = 0; rt < 2; ++rt)
#pragma unroll
                for (int i = 0; i < 16; ++i) *(LAS bf16_t*)(lds + (32 * rt + crow(i, hi)) * CP_RS + col * 2) = f2bf(acc[rt][ct][i] * sc); }
    }
    __syncthreads();
}
__device__ __forceinline__ void pool_out(LAS unsigned char* lds, int tile, unsigned char* Op, float* Osc, int tid) {
    const size_t row0 = (size_t)tile * 64;
    {
        const int ch8 = tid & 63, tr = tid >> 6;
        float f[8][8];
#pragma unroll
        for (int i = 0; i < 8; ++i) { const v4u v = *(const LAS v4u*)(lds + (tr + 8 * i) * CP_RS + ch8 * 16);
            f[i][0] = blo(v.x); f[i][1] = bhi(v.x); f[i][2] = blo(v.y); f[i][3] = bhi(v.y); f[i][4] = blo(v.z); f[i][5] = bhi(v.z); f[i][6] = blo(v.w); f[i][7] = bhi(v.w); }
        quant_store8(f, Op, Osc, row0, tr, 8, ch8);
    }
    __syncthreads();
}

__device__ __forceinline__ void moe_offsets(const gu32* cnt, int (&pstart)[8], int (&tend)[8], int& T) {
    int acc = 0;
#pragma unroll
    for (int e = 0; e < 8; ++e) { const int c = (int)__hip_atomic_load(cnt + 64 * e, RLX_AGENT); pstart[e] = acc; acc += (c + 255) & ~255; tend[e] = acc >> 8; }
    T = acc >> 8;
}
__device__ __forceinline__ void moe_scatter(const gu32* cnt, const int* ASG, const bf16_t* H, bf16_t* XS, int* RINFO, const float* HSrc, float* XSS, int gw, int NGW, int lane, int tid, int blk, int nblk, bool f8) {
    int pstart[8], tend[8], T; moe_offsets(cnt, pstart, tend, T);
    for (int e = blk; e < 8; e += nblk) { const int c = (int)__hip_atomic_load(cnt + 64 * e, RLX_AGENT); const int pe = (c + 255) & ~255;
        for (int r = c + tid; r < pe; r += 512) { RINFO[2 * (size_t)(pstart[e] + r)] = -1; RINFO[2 * (size_t)(pstart[e] + r) + 1] = 0; } }
    for (int a0 = gw; a0 < NTOK * 2; a0 += 4 * NGW) {
        int w0[4], gb[4]; size_t dest[4]; v4u r0[4], r1[4]; float rsq[4];
#pragma unroll
        for (int q = 0; q < 4; ++q) { const int a = a0 + q * NGW; w0[q] = 0; gb[q] = 0; rsq[q] = 0.f; if (a < NTOK * 2) { w0[q] = ASG[2 * (size_t)a]; gb[q] = ASG[2 * (size_t)a + 1]; rsq[q] = HSrc[a >> 1]; } }
#pragma unroll
        for (int q = 0; q < 4; ++q) { const int a = a0 + q * NGW; const int e = w0[q] >> 24, pos = w0[q] & 0xffffff; int ps = 0;
#pragma unroll
            for (int k = 0; k < 8; ++k) ps = (e == k) ? pstart[k] : ps;
            dest[q] = (size_t)(ps + pos); r0[q] = (v4u){0u, 0u, 0u, 0u}; r1[q] = r0[q];
            if (a < NTOK * 2) {
                if (f8) r0[q] = ((const v4u*)((const unsigned char*)H + (size_t)(a >> 1) * DM))[lane];
                else { const v4u* src = (const v4u*)(H + (size_t)(a >> 1) * DM); r0[q] = src[lane]; r1[q] = src[64 + lane]; } } }
#pragma unroll
        for (int q = 0; q < 4; ++q) { const int a = a0 + q * NGW; if (a < NTOK * 2) {
            if (lane == 0) { RINFO[2 * dest[q]] = a; RINFO[2 * dest[q] + 1] = gb[q]; XSS[dest[q]] = rsq[q]; }
            if (f8) ((v4u*)((unsigned char*)XS + dest[q] * DM))[lane] = r0[q];
            else { v4u* dst = (v4u*)(XS + dest[q] * DM); dst[lane] = r0[q]; dst[64 + lane] = r1[q]; } } }
    }
}
__device__ __forceinline__ void final_combine(float* out, const bf16_t* xb, const bf16_t* Y, int gw, int NGW, int lane) {
    v2u xn[4], an[4], bn[4];
    if (gw < NTOK) {
#pragma unroll
        for (int jj = 0; jj < 4; ++jj) { xn[jj] = ((const v2u*)(xb + (size_t)gw * DM))[64 * jj + lane]; an[jj] = ((const v2u*)(Y + (size_t)gw * DM))[64 * jj + lane]; bn[jj] = ((const v2u*)(Y + ((size_t)NTOK + gw) * DM))[64 * jj + lane]; }
    }
    for (int row = gw; row < NTOK; row += NGW) {
        v2u x[4], a[4], b[4];
#pragma unroll
        for (int jj = 0; jj < 4; ++jj) { x[jj] = xn[jj]; a[jj] = an[jj]; b[jj] = bn[jj]; }
        const int nr = row + NGW;
        if (nr < NTOK) {
#pragma unroll
            for (int jj = 0; jj < 4; ++jj) { xn[jj] = ((const v2u*)(xb + (size_t)nr * DM))[64 * jj + lane]; an[jj] = ((const v2u*)(Y + (size_t)nr * DM))[64 * jj + lane]; bn[jj] = ((const v2u*)(Y + ((size_t)NTOK + nr) * DM))[64 * jj + lane]; }
        }
#pragma unroll
        for (int jj = 0; jj < 4; ++jj) { f32x4 v;
            v[0] = blo(x[jj].x) + blo(a[jj].x) + blo(b[jj].x); v[1] = bhi(x[jj].x) + bhi(a[jj].x) + bhi(b[jj].x); v[2] = blo(x[jj].y) + blo(a[jj].y) + blo(b[jj].y); v[3] = bhi(x[jj].y) + bhi(a[jj].y) + bhi(b[jj].y);
            ((f32x4*)(out + (size_t)row * DM))[64 * jj + lane] = v; }
    }
}
#define XB_TMO      128
#define XB_XCNT(j)  (256  + 64 * (j))
#define XB_XSUB(j)  (1280 + 64 * (j))
#define XB_XGEN(j)  (2304 + 64 * (j))
#define XB_TOP      3328
#define XB_TOPGEN   3392
#define XCD_BAR_WORDS 3456
#define XB_SPIN_CAP (1u << 18)

__device__ __forceinline__ unsigned xb_ld(unsigned* p)              { return __hip_atomic_load(p, __ATOMIC_RELAXED, __HIP_MEMORY_SCOPE_AGENT); }
__device__ __forceinline__ unsigned xb_add(unsigned* p, unsigned v) { return __hip_atomic_fetch_add(p, v, __ATOMIC_RELAXED, __HIP_MEMORY_SCOPE_AGENT); }
__device__ __forceinline__ unsigned xb_xcc_id() { return (unsigned)__builtin_amdgcn_s_getreg((3 << 11) | 20) & 0xFu; }
#define XB_SPIN(cond, bar) do { unsigned _sp = 0; while (cond) { __builtin_amdgcn_s_sleep(1); \
    if ((++_sp & 255u) == 0u) { if (xb_ld(&(bar)[XB_TMO])) break; if (_sp > XB_SPIN_CAP) { atomicAdd(&(bar)[XB_TMO], 1u); break; } } } } while (0)

struct XcdBarrier {
    unsigned* bar; unsigned x;
    volatile LAS unsigned* st;
};

__device__ __forceinline__ XcdBarrier xcd_barrier_post(unsigned* bar, volatile LAS unsigned* st) {
    XcdBarrier b; b.bar = bar; b.x = xb_xcc_id(); b.st = st;
    if (threadIdx.x == 0) (void)xb_add(&bar[XB_XCNT(b.x)], 1u);
    return b;
}
__device__ __forceinline__ void xcd_barrier_complete(unsigned* bar, unsigned x, unsigned& nloc, unsigned& nx) {
    const unsigned G = gridDim.x * gridDim.y * gridDim.z;
    unsigned sum, cnt, mine, sp = 0u;
    for (;;) {
        sum = 0u; cnt = 0u; mine = 0u;
#pragma unroll
        for (unsigned j = 0; j < 16; ++j) { const unsigned c = xb_ld(&bar[XB_XCNT(j)]); sum += c; cnt += (c > 0u) ? 1u : 0u; mine = (j == x) ? c : mine; }
        if (sum == G) break;
        __builtin_amdgcn_s_sleep(1);
        if ((++sp & 255u) == 0u) { if (xb_ld(&bar[XB_TMO])) break; if (sp > XB_SPIN_CAP) { atomicAdd(&bar[XB_TMO], 1u); break; } }
    }
    nloc = mine > 0u ? mine : 1u; nx = cnt > 0u ? cnt : 1u;
}

__device__ __forceinline__ void xcd_barrier(const XcdBarrier& b) {
    asm volatile("s_waitcnt vmcnt(0)" ::: "memory");
    __syncthreads();
    if (threadIdx.x == 0) {
        unsigned* bar = b.bar;
        __builtin_amdgcn_s_waitcnt(0);
        unsigned nloc = b.st[0], nx = b.st[1];
        if (nloc == 0u) { xcd_barrier_complete(bar, b.x, nloc, nx); b.st[0] = nloc; b.st[1] = nx; }
        const unsigned old = xb_add(&bar[XB_XSUB(b.x)], 1u);
        const unsigned gen = old / nloc;
        if (old + 1u == (gen + 1u) * nloc) {
            __builtin_amdgcn_fence(__ATOMIC_RELEASE, "agent");
            asm volatile("s_waitcnt vmcnt(0)" ::: "memory");
            const unsigned og = xb_add(&bar[XB_TOP], 1u);
            const unsigned tg = og / nx;
            if (og + 1u == (tg + 1u) * nx) xb_add(&bar[XB_TOPGEN], 1u);
            else XB_SPIN(xb_ld(&bar[XB_TOPGEN]) == tg, bar);
            __builtin_amdgcn_fence(__ATOMIC_ACQUIRE, "agent");
            xb_add(&bar[XB_XGEN(b.x)], 1u);
            asm volatile("s_waitcnt vmcnt(0)" ::: "memory");
        } else {
            XB_SPIN(xb_ld(&bar[XB_XGEN(b.x)]) == gen, bar);
            __builtin_amdgcn_fence(__ATOMIC_ACQUIRE, "agent");
            asm volatile("s_waitcnt vmcnt(0)" ::: "memory");
        }
    }
    __syncthreads();
}


struct Args {
    const float* in[25]; float* out; unsigned char* ws; int pad0, pad1;
};
typedef const Args __attribute__((address_space(4)))* KArgs;
enum { I_X = 0, I_GMIX, I_WIN, I_BF, I_GQ, I_GK, I_GSGU, I_WSP, I_BSP, I_WDW, I_BDW, I_GCONV, I_WPOOL, I_PSCALE, I_WBR, I_BGATE, I_WOUT, I_GFFN,
       I_WFG, I_WFU, I_WFD, I_WROUTER, I_WEG, I_WEU, I_WED };
__device__ __forceinline__ int opaque_v(int v) { asm volatile("" : "+v"(v)); return v; }
__device__ __forceinline__ KArgs kargs() { KArgs p = (KArgs)__builtin_amdgcn_kernarg_segment_ptr(); asm volatile("" : "+s"(p)); return p; }

#ifndef F8_MASK
#define F8_MASK 0xE
#endif
constexpr float WBS = 704.0f;
constexpr float WI8S = 1024.0f;
constexpr float W8S_UP = 32.0f, W8S_DN = 64.0f;
static_assert((F8_MASK & 0xA) == 0xA, "the MoE layers' FFN weights are stored as fp8");
#ifndef MK_ATTN2
#define MK_ATTN2 1
#endif
#ifndef MK_MERGE_N1
#define MK_MERGE_N1 1
#endif
#ifndef MK_ONLY
#define MK_ONLY -1
#endif
#define PH(n) (MK_ONLY < 0 || MK_ONLY == (n))
#ifndef MK_DUP
#define MK_DUP -1
#endif
#ifndef MK_TIME_MASK
#define MK_TIME_MASK 0
#endif
#define T_BEGIN(n) cur_ph = (n); unsigned long long tb_ = 0; if ((MK_TIME_MASK >> (n)) & 1) tb_ = __builtin_amdgcn_s_memrealtime();
#define T_END(n) if ((MK_TIME_MASK >> (n)) & 1) { const unsigned long long te_ = __builtin_amdgcn_s_memrealtime(), dt_ = te_ - tb_; while (__builtin_amdgcn_s_memrealtime() - te_ < dt_) __builtin_amdgcn_s_sleep(4); }
#define DUP(n) for (int rep_ = 0; rep_ < ((MK_DUP == (n)) ? 2 : 1); ++rep_)

#define FFN_PREP() do { KArgs ka = kargs(); unsigned char* ws = ka->ws; const int lane = opaque_v(tid) & 63; int f8i_ = ((F8_MASK >> l) | l) & 1; asm volatile("" : "+s"(f8i_)); const bool f8l_ = f8i_ != 0;        \
        if (!moe) ffn_prep(false, f8l_, ka->in[I_WFG] + (size_t)fi * DM * FFD, ka->in[I_WFU] + (size_t)fi * DM * FFD, ka->in[I_WFD] + (size_t)fi * FFD * DM, ws + WF_GU, ws + WF_D_DENSE, scr, gw, NGW, lane); \
        else ffn_prep(true, true, ka->in[I_WEG] + (size_t)fi * NEXP * DM * FFE, ka->in[I_WEU] + (size_t)fi * NEXP * DM * FFE, ka->in[I_WED] + (size_t)fi * NEXP * FFE * DM, ws + WF_GU, ws + WF_D_MOE, scr, gw, NGW, lane); \
        __syncthreads(); } while (0)
__global__ void __launch_bounds__(NWAVES * 64, 2) fwd_kernel(Args args_unused) {
    extern __shared__ __attribute__((aligned(16))) unsigned char lds_raw[];
    LAS unsigned char* lds = (LAS unsigned char*)lds_raw;
    const int tid = threadIdx.x, lane = tid & 63, wave = __builtin_amdgcn_readfirstlane(tid >> 6);
    const int G = gridDim.x, bx = blockIdx.x;
    const int gw = bx * NWAVES + wave, NGW = G * NWAVES;
    const int vcu = (G % 8 == 0) ? (bx % 8) * (G / 8) + bx / 8 : bx;
    volatile LAS unsigned* MISC = (volatile LAS unsigned*)(lds + MISC_OFF);
    for (int u = tid; u < 64; u += NWAVES * 64) ((LAS unsigned*)(lds + MISC_OFF))[u] = 0u;
    __syncthreads();
    XcdBarrier bar;
    { KArgs ka = kargs(); bar = xcd_barrier_post((unsigned*)(ka->ws + WS_CTL) + CW_BAR, MISC + 8); }
#ifndef MK_SKEW_WG
#define MK_SKEW_WG -1
#endif
#ifndef MK_SKEW_MASK
#define MK_SKEW_MASK 0xFFFF
#endif
#define GRID_BAR() do { unsigned long long tw0_ = 0; if (MK_SKEW_WG >= 0) tw0_ = __builtin_amdgcn_s_memrealtime(); GRID_BAR0(); if (MK_SKEW_WG >= 0 && ((MK_SKEW_MASK >> cur_ph) & 1)) skew_acc += __builtin_amdgcn_s_memrealtime() - tw0_; } while (0)
#define GRID_BAR0() do { XcdBarrier b_ = bar; asm volatile("" : "+s"(b_.bar), "+s"(b_.x)); xcd_barrier(b_); } while (0)
    LAS float* scr = (LAS float*)(lds + wave * 16384);
    int cur_ph = 0; unsigned long long skew_acc = 0;

    for (int l = 0; l < NLAYER; ++l) {
        const bool moe = (l & 1) != 0; const int fi = l >> 1;
        const bool f8 = moe ? true : (((F8_MASK >> l) & 1) != 0);
        { T_BEGIN(1)
        if (PH(1)) {
            KArgs ka = kargs(); unsigned char* ws = ka->ws; bf16_t* xout = (bf16_t*)(ws + WS_XB); const int lane = opaque_v(tid) & 63;
            unsigned char* Wproj8 = ws + WM_PROJ;
            int off = 0;
            const float* win = ka->in[I_WIN] + (size_t)l * DM * INW;
            DUP(12) {
            tr_segment8<true>(win, INW, DM, C_Q, 512, Wproj8, 0, -1, WI8S, scr, gw, NGW, lane, off);
            tr_segment8<true>(win, INW, DM, C_K, 512, Wproj8, 512, -1, WI8S, scr, gw, NGW, lane, off);
            tr_segment8<true>(win, INW, DM, C_V, 512, ws + WM_V, 0, 0, WI8S, scr, gw, NGW, lane, off);
            tr_segment8<true>(win, INW, DM, C_SU, 1024, Wproj8, 1024, 0, WI8S, scr, gw, NGW, lane, off);
            tr_segment8<true>(win, INW, DM, C_CONV, 512, Wproj8, 2048, 128, WI8S, scr, gw, NGW, lane, off);
            tr_segment8<true>(win, INW, DM, C_CONV + 512, 512, Wproj8, 2048 + 128, 128, WI8S, scr, gw, NGW, lane, off);
            tr_segment8<true>(win, INW, DM, C_POOL, 512, Wproj8, 3072, 0, WI8S, scr, gw, NGW, lane, off);
            tr_segment8<true>(win, INW, DM, C_GATE, 4096, ws + WM_G8, 0, 0, WI8S, scr, gw, NGW, lane, off);
            for (int i = 0; i < 4; ++i) tr_segment8<true>(ka->in[I_WBR] + ((size_t)l * 4 + i) * 512 * 1024, 1024, 512, 0, 1024, ws + WM_B + (size_t)i * 1024 * 512, 0, 0, WBS, scr, gw, NGW, lane, off);
            tr_segment(ka->in[I_WOUT] + (size_t)l * 1024 * 1024, 1024, 1024, 0, 1024, (bf16_t*)(ws + WM_OUT), 0, 0, scr, gw, NGW, lane, off);
            for (int g = 0; g < 4; ++g) tr_segment(ka->in[I_WPOOL] + ((size_t)l * 4 + g) * 128 * 128, 128, 128, 0, 128, (bf16_t*)(ws + WM_PG) + (size_t)g * 128 * 128, 0, 0, scr, gw, NGW, lane, off);
            { const float* wsp = ka->in[I_WSP] + (size_t)l * 8 * 128 * 128; bf16_t* Wsp = (bf16_t*)(ws + WM_SP);
              for (int i = bx * 512 + opaque_v(tid); i < 8 * 128 * 128; i += G * 512) { const int t = (i >> 7) & 127, s = i & 127; Wsp[i] = (s <= t) ? f2bf(wsp[i]) : (bf16_t)0; } }
            }
            const float* xin32 = (l == 0) ? ka->in[I_X] : nullptr;
            const bf16_t* yc = (l > 0 && ((l - 1) & 1)) ? (const bf16_t*)(ws + WS_XS) : nullptr;
            for (int rep_ = 0; rep_ < ((MK_DUP == 13 && yc == nullptr) ? 2 : 1); ++rep_) norm_rows<0>(xin32, xout, xout, yc != nullptr, yc, ka->in[I_GMIX] + l * DM, nullptr, ws + WS_H8, (float*)(ws + WS_HS), win + C_F, INW, ka->in[I_BF] + l * 8, (float*)(ws + WS_LF), nullptr, nullptr, gw, NGW, lane);
        }
        GRID_BAR();
        T_END(1) }
        { T_BEGIN(2)
        DUP(2) if (PH(2)) {
            KArgs ka = kargs(); unsigned char* ws = ka->ws;
            pg8::Gemm g{(bf16_t*)(ws + WS_H8), (bf16_t*)(ws + WM_PROJ), NTOK, NPROJ, DM / 2}; pg8::StaticOrder S; S.init(NTOK, NPROJ, G, bx);
            pg8::EpiProjI8 E{ws, WS_Q, WS_K, WS_SUV, WS_CY, WS_PIN, ka->in[I_GQ] + l * 64, ka->in[I_GK] + l * 64, (const float*)(ws + WS_HS), 1.0f / WI8S};
            pg8::gemm_phase<pg8::EpiProjI8, pg8::StaticOrder, true, true, false, true>(lds, g, S, E);
        }
        DUP(16) if (PH(2)) {
            KArgs ka = kargs(); unsigned char* ws = ka->ws;
            pg8::Gemm g{(bf16_t*)(ws + WS_H8), (bf16_t*)(ws + WM_G8), NTOK, 4096, DM / 2}; pg8::StaticOrder S; S.init(NTOK, 4096, G, bx);
            pg8::EpiGateI8 E{ws + WS_G, ka->in[I_BGATE] + (size_t)l * 4096, (const float*)(ws + WS_HS), 1.0f / WI8S};
            pg8::gemm_phase<pg8::EpiGateI8, pg8::StaticOrder, true, true, false, true>(lds, g, S, E);
        }
        DUP(2) if (PH(2)) {
            KArgs ka = kargs(); unsigned char* ws = ka->ws;
            pg8::Gemm g2{(bf16_t*)(ws + WM_V), (bf16_t*)(ws + WS_H8), 512, NTOK, DM / 2}; pg8::StaticOrder S2; S2.init(512, NTOK, G, bx);
            pg8::EpiVtI8 E2{(bf16_t*)(ws + WS_VT), NTOK, (const float*)(ws + WS_HS), 1.0f / WI8S, (int)__builtin_offsetof(Args, ws), (int)(WS_CTL + (CW_VMAX + 16 * l) * 4)};
            pg8::gemm_phase<pg8::EpiVtI8, pg8::StaticOrder, true, true, false, true>(lds, g2, S2, E2);
        }
        GRID_BAR();
        T_END(2) }
        { T_BEGIN(3)
        DUP(3) if (PH(3)) {
            if (bx & 1) { FFN_PREP(); if (MK_DUP == 17) FFN_PREP(); }
#ifndef MK_NO_ATTN
#if MK_ATTN2
            DUP(31) for (int i = 0;; ++i) {
                int bh, qb;
                if (G == 256) { if (i >= 2) break; bh = bx >> 1; const int s = (bx & 1); qb = (i == 0) ? s : 3 - s; }
                else { const int u = i * G + bx; if (u >= 512) break; bh = u >> 2; qb = u & 3; }
                KArgs ka = kargs(); unsigned char* ws = ka->ws;
                attn_unit2(lds, bh >> 3, bh & 7, qb, (const bf16_t*)(ws + WS_Q), (const bf16_t*)(ws + WS_K), (const bf16_t*)(ws + WS_VT), (const float*)(ws + WS_LF), ka->in[I_GQ] + l * 64, ka->in[I_GK] + l * 64, ws + WS_YS, (float*)(ws + WS_YSC), (const unsigned*)(ws + WS_CTL) + CW_VMAX + 16 * l + (bh >> 3), opaque_v(tid));
            }
#else
            DUP(31) for (int i = 0;; ++i) {
                int bh, qb;
                if (G == 256) { if (i >= 4) break; bh = bx >> 1; const int s = (bx & 1); qb = (i == 0) ? s : (i == 1) ? 7 - s : (i == 2) ? 2 + s : 5 - s; }
                else { const int u = i * G + bx; if (u >= 1024) break; bh = u >> 3; qb = u & 7; }
                KArgs ka = kargs(); unsigned char* ws = ka->ws;
                attn_unit(lds, bh >> 3, bh & 7, qb, (const bf16_t*)(ws + WS_Q), (const bf16_t*)(ws + WS_K), (const bf16_t*)(ws + WS_VT), (const float*)(ws + WS_LF),
                          ka->in[I_GQ] + l * 64, ka->in[I_GK] + l * 64, (bf16_t*)(ws + WS_YS), opaque_v(tid));
            }
#endif
#endif
#ifndef MK_NO_SGU
            DUP(32) for (int c = bx; c < 256; c += G) {
                KArgs ka = kargs(); unsigned char* ws = ka->ws;
                sgu_unit(lds, c, (const bf16_t*)(ws + WS_SUV), ka->in[I_GSGU] + l * 512, (const bf16_t*)(ws + WM_SP), ka->in[I_BSP] + l * 8 * 128, ws + WS_YS + (size_t)NTOK * 512, (float*)(ws + WS_YSC) + NTOK, opaque_v(tid));
            }
#endif
#ifndef MK_NO_CONV
            DUP(33) if (bx < 512) {
                                v4u pst[10], cst[12];
                int t = bx;
                { KArgs ka = kargs(); conv_load(t, (const bf16_t*)(ka->ws + WS_CY), opaque_v(tid), cst); }
                for (;;) {
                    f32x2_t w[31]; f32x2_t bias;
                    { KArgs ka = kargs(); const float* wdw = ka->in[I_WDW] + (size_t)l * 31 * 512; const int tq_ = 2 * (opaque_v(tid) & 255);
#pragma unroll
                      for (int j = 0; j < 31; ++j) w[j] = *(const f32x2_t*)(wdw + j * 512 + tq_);
                      bias = *(const f32x2_t*)(ka->in[I_BDW] + l * 512 + tq_); }
                    conv_stage(lds, t, opaque_v(tid), cst); __syncthreads();
                    { KArgs ka = kargs(); pool_load(t, (const bf16_t*)(ka->ws + WS_PIN), opaque_v(tid), pst); }
                    { KArgs ka = kargs(); unsigned char* ws = ka->ws; conv_main(lds, t, w, bias, ka->in[I_GCONV] + l * 512, ws + WS_YS + (size_t)2 * NTOK * 512, (float*)(ws + WS_YSC) + 2 * NTOK, opaque_v(tid)); }
                    pool_stage(lds, opaque_v(tid), pst); __syncthreads();
                    pool_sums(lds, t, opaque_v(tid));
                    const int tn = t + G;
                    { KArgs ka = kargs(); pool_main(lds, t, (const bf16_t*)(ka->ws + WM_PG), ka->in[I_PSCALE] + l * 512, opaque_v(tid)); }
                    if (tn < 512) { KArgs ka = kargs(); conv_load(tn, (const bf16_t*)(ka->ws + WS_CY), opaque_v(tid), cst); }
                    { KArgs ka = kargs(); unsigned char* ws = ka->ws; pool_out(lds, t, ws + WS_YS + (size_t)3 * NTOK * 512, (float*)(ws + WS_YSC) + 3 * NTOK, opaque_v(tid)); }
                    if (tn >= 512) break;
                    t = tn;
                }
            }
#endif
            if (!(bx & 1)) { FFN_PREP(); if (MK_DUP == 17) FFN_PREP(); }
        }
        GRID_BAR();
        T_END(3) }
        { T_BEGIN(4)
        DUP(4) if (PH(4)) {
            KArgs ka = kargs(); unsigned char* ws = ka->ws;
            pg8::Gemm g{(bf16_t*)(ws + WS_YS), (bf16_t*)(ws + WM_B), 4 * NTOK, 4096, 256};
#if MK_MERGE_N1
            pg8::MergeOrder2 S{G, vcu};
            pg8::EpiMerge2 E{ws + WS_G, (bf16_t*)(ws + WS_MG), (const float*)(ws + WS_YSC), NTOK, 1.0f / (WBS * 255.0f)};
            pg8::gemm_phase_n1<pg8::EpiMerge2, pg8::MergeOrder2, true>(lds, g, S, E);
#else
            pg8::MergeOrder S{G, vcu};
            pg8::EpiMerge E{(bf16_t*)(ws + WS_G), (bf16_t*)(ws + WS_MG)};
            pg8::gemm_phase<pg8::EpiMerge, pg8::MergeOrder, true, true>(lds, g, S, E);
#endif
        }
        GRID_BAR();
        T_END(4) }
        { T_BEGIN(5)
        if (PH(5)) {
            KArgs ka = kargs(); unsigned char* ws = ka->ws; bf16_t* xout = (bf16_t*)(ws + WS_XB);
            pg8::Gemm g{(bf16_t*)(ws + WS_MG), (bf16_t*)(ws + WM_OUT), NTOK, DM, DM}; pg8::StaticOrder S; S.init(NTOK, DM, G, bx);
            pg8::EpiResid E{(l == 0) ? ka->in[I_X] : nullptr, xout, xout, 1.0f};
            pg8::gemm_phase<pg8::EpiResid, pg8::StaticOrder, true, true>(lds, g, S, E);
        }
        GRID_BAR();
        T_END(5) }
        { T_BEGIN(6)
        if (PH(6)) {
            KArgs ka = kargs(); unsigned char* ws = ka->ws; bf16_t* xout = (bf16_t*)(ws + WS_XB); const int lane = opaque_v(tid) & 63;
            unsigned char* H8 = ws + WS_H; bf16_t* Hb = nullptr; float* HS2 = (float*)(ws + WS_HS2);
            DUP(15) if (!moe) norm_rows<1>(nullptr, xout, xout, false, nullptr, ka->in[I_GFFN] + l * DM, Hb, H8, HS2, nullptr, 0, nullptr, nullptr, nullptr, nullptr, gw, NGW, lane);
            else norm_rows<2>(nullptr, xout, xout, false, nullptr, ka->in[I_GFFN] + l * DM, Hb, H8, HS2, ka->in[I_WROUTER] + (size_t)fi * DM * 8, 8, nullptr, nullptr, (int*)(ws + WS_ASG),
                             (gu32*)(ws + WS_CTL) + CW_CNT + fi * 1024, gw, NGW, lane);
        }
        GRID_BAR();
        T_END(6) }
        if (!moe) {
        { T_BEGIN(7)
            DUP(7) if (PH(7)) {
                KArgs ka = kargs(); unsigned char* ws = ka->ws;
                {
                    pg8::Gemm g{(bf16_t*)(ws + WS_H), (bf16_t*)(ws + WF_GU), NTOK, 2 * FFD, DM / 2}; pg8::StaticOrder S; S.init(NTOK, 2 * FFD, G, bx);
                    pg8::EpiSwigluI8 E{f8 ? ws + WS_ACT : nullptr, (bf16_t*)(ws + WS_ACT), FFD, 2 * FFD / 256, (const float*)(ws + WS_HS2), 1.0f / WI8S};
                    pg8::gemm_phase<pg8::EpiSwigluI8, pg8::StaticOrder, true, true, false, true>(lds, g, S, E);
                }
            }
            GRID_BAR();
        T_END(7) }
        { T_BEGIN(8)
            if (PH(8)) {
                KArgs ka = kargs(); unsigned char* ws = ka->ws; bf16_t* xout = (bf16_t*)(ws + WS_XB);
                if (!f8) {
                    pg8::Gemm g{(bf16_t*)(ws + WS_ACT), (bf16_t*)(ws + WF_D_DENSE), NTOK, DM, FFD}; pg8::StaticOrder S; S.init(NTOK, DM, G, bx);
                    pg8::EpiResid E{nullptr, xout, xout, 1.0f};
                    pg8::gemm_phase<pg8::EpiResid, pg8::StaticOrder, true, true>(lds, g, S, E);
                } else {
                    pg8::Gemm g{(bf16_t*)(ws + WS_ACT), (bf16_t*)(ws + WF_D_DENSE), NTOK, DM, FFD / 2}; pg8::StaticOrder S; S.init(NTOK, DM, G, bx);
                    pg8::EpiResid E{nullptr, xout, xout, 1.0f / W8S_DN};
                    pg8::gemm_phase<pg8::EpiResid, pg8::StaticOrder, true, true, true>(lds, g, S, E);
                }
            }
            GRID_BAR();
        T_END(8) }
        } else {
        { T_BEGIN(9)
            DUP(9) if (PH(9)) {
                KArgs ka = kargs(); unsigned char* ws = ka->ws;
                { const int t_ = opaque_v(tid); moe_scatter((gu32*)(ws + WS_CTL) + CW_CNT + fi * 1024, (const int*)(ws + WS_ASG), (const bf16_t*)(ws + WS_H), (bf16_t*)(ws + WS_XS), (int*)(ws + WS_RINFO), (const float*)(ws + WS_HS2), (float*)(ws + WS_XSS), gw, NGW, t_ & 63, t_, bx, G, true); }
            }
            GRID_BAR();
        T_END(9) }
        { T_BEGIN(10)
            DUP(10) if (PH(10)) {
                KArgs ka = kargs(); unsigned char* ws = ka->ws;
                pg8::GroupedOrder S; S.G = G; S.c = vcu; S.nct = 2 * FFE / 256; { int ps[8]; moe_offsets((gu32*)(ws + WS_CTL) + CW_CNT + fi * 1024, ps, S.tend, S.T); }
                {
                    pg8::Gemm g{(bf16_t*)(ws + WS_XS), (bf16_t*)(ws + WF_GU), PMAX, NEXP * 2 * FFE, DM / 2};
                    pg8::EpiSwigluI8 E{ws + WS_ACT, nullptr, FFE, 2 * FFE / 256, (const float*)(ws + WS_XSS), 1.0f / WI8S};
                    pg8::gemm_phase<pg8::EpiSwigluI8, pg8::GroupedOrder, true, true, false, true>(lds, g, S, E);
                }
            }
            GRID_BAR();
        T_END(10) }
        { T_BEGIN(11)
            DUP(11) if (PH(11)) {
                KArgs ka = kargs(); unsigned char* ws = ka->ws;
                pg8::GroupedOrder S; S.G = G; S.c = vcu; S.nct = 4; { int ps[8]; moe_offsets((gu32*)(ws + WS_CTL) + CW_CNT + fi * 1024, ps, S.tend, S.T); }
                if (!f8) {
                    pg8::Gemm g{(bf16_t*)(ws + WS_ACT), (bf16_t*)(ws + WF_D_MOE), PMAX, NEXP * DM, FFE};
                    pg8::EpiDownMoe E{(const int*)(ws + WS_RINFO), (bf16_t*)(ws + WS_XS), 1.0f};
                    pg8::gemm_phase<pg8::EpiDownMoe, pg8::GroupedOrder, true, true>(lds, g, S, E);
                } else {
                    pg8::Gemm g{(bf16_t*)(ws + WS_ACT), (bf16_t*)(ws + WF_D_MOE), PMAX, NEXP * DM, FFE / 2};
                    pg8::EpiDownMoe E{(const int*)(ws + WS_RINFO), (bf16_t*)(ws + WS_XS), 1.0f / W8S_DN};
                    pg8::gemm_phase<pg8::EpiDownMoe, pg8::GroupedOrder, true, true, true>(lds, g, S, E);
                }
            }
            GRID_BAR();
        T_END(11) }
        }
    }
    if (MK_SKEW_WG >= 0 && (int)blockIdx.x == MK_SKEW_WG) { const unsigned long long te_ = __builtin_amdgcn_s_memrealtime(); while (__builtin_amdgcn_s_memrealtime() - te_ < skew_acc) __builtin_amdgcn_s_sleep(4); }
    { KArgs ka = kargs(); final_combine(ka->out, (const bf16_t*)(ka->ws + WS_XB), (const bf16_t*)(ka->ws + WS_XS), gw, NGW, opaque_v(tid) & 63); }
}

extern "C" void kernel_launch(void* const* d_in, const int* in_sizes, int n_in, void* d_out, int out_size, void* d_ws, size_t ws_size, hipStream_t stream) {
    static int grid = 0;
    if (grid == 0) {
        if (n_in != 25 || in_sizes[0] != NTOK * DM || out_size != NTOK * DM || ws_size < WS_END) {
            fprintf(stderr, "kernel_launch: unexpected shapes / workspace (n_in %d, in0 %d, out %d, ws %zu < %zu)\n", n_in, n_in > 0 ? in_sizes[0] : -1, out_size, ws_size, (size_t)WS_END); grid = -1; return; }
        int dev = 0, cus = 0, per_cu = 0;
        if (hipGetDevice(&dev) != hipSuccess || hipDeviceGetAttribute(&cus, hipDeviceAttributeMultiprocessorCount, dev) != hipSuccess) { grid = -1; return; }
        if (hipFuncSetAttribute((const void*)fwd_kernel, hipFuncAttributeMaxDynamicSharedMemorySize, LDS_BYTES) != hipSuccess) { fprintf(stderr, "kernel_launch: hipFuncSetAttribute failed\n"); grid = -1; return; }
        if (hipOccupancyMaxActiveBlocksPerMultiprocessor(&per_cu, (const void*)fwd_kernel, NWAVES * 64, LDS_BYTES) != hipSuccess || per_cu < 1) { fprintf(stderr, "kernel_launch: occupancy query reports %d\n", per_cu); }
        (void)hipGetLastError();
        grid = cus;
    }
    if (grid < 0) return;
    if (hipMemsetAsync((char*)d_ws + WS_CTL, 0, CTL_ZERO_BYTES, stream) != hipSuccess) return;
    Args a{};
    for (int i = 0; i < 25; ++i) a.in[i] = (const float*)d_in[i];
    a.out = (float*)d_out; a.ws = (unsigned char*)d_ws;
    hipLaunchKernelGGL(fwd_kernel, dim3(grid), dim3(NWAVES * 64), LDS_BYTES, stream, a);
}
```

```cpp
#include <hip/hip_runtime.h>
#include <cstdio>
#include <cstdint>
#include <type_traits>
__device__ __forceinline__ int lane_id_v() { int l; asm volatile("v_mbcnt_lo_u32_b32 %0, -1, 0\n\tv_mbcnt_hi_u32_b32 %0, -1, %0" : "=v"(l)); return l; }
#ifndef ZC_PROJ
#define ZC_PROJ true
#endif
#ifndef ZC_GATE
#define ZC_GATE false
#endif
namespace pg8 {
template <class T, class = void> struct has_pre : std::false_type {};
template <class T> struct has_pre<T, std::void_t<typename T::Pre>> : std::true_type {};
#define PG8_LAS __attribute__((address_space(3)))
typedef unsigned short bf16_t;
typedef short bf16x8 __attribute__((ext_vector_type(8)));
typedef float f32x4 __attribute__((ext_vector_type(4)));
typedef unsigned u32x4 __attribute__((ext_vector_type(4)));
constexpr int BM = 256, BK = 64, HALF = 128, HTB = HALF * BK * 2  , STAGE_BYTES = 8 * HTB, NXCD = 8, WGM = 8;

__host__ __device__ __forceinline__ int lds_byte(int r, int c) { const int st = (r >> 4) * 2 + (c >> 5), rr = r & 15, cc = c & 31, ob = rr * 64 + cc * 2; return st * 1024 + (ob ^ (((ob >> 9) & 1) << 5)); }
__host__ __device__ __forceinline__ void stage_rc(int b, int& R, int& C) { const int st = b / 1024, sb = b % 1024, swz = sb ^ (((sb >> 9) & 1) << 5); R = (st >> 1) * 16 + swz / 64; C = (st & 1) * 32 + (swz % 64) / 2; }
__host__ __device__ __forceinline__ int perm32(int rho) { const int n = rho >> 4, i = rho & 15; return 8 * (i >> 2) + 4 * n + (i & 3); }

struct Unit { int pm, pn; };
struct Gemm { const bf16_t* A; const bf16_t* Bt; int M, N, K; };

struct StaticOrder {
    int nM, nN, nwg, G, c;
    __host__ __device__ void init(int M, int N, int G_, int c_) { nM = M / BM; nN = N / BM; nwg = nM * nN; G = G_; c = c_; }
    __host__ __device__ bool next(int i, Unit& u) const {
        const long L = (long)i * G + c; if (L >= nwg) return false;
        int wgid = (int)L; { const int q = nwg / NXCD, r = nwg % NXCD, xcd = wgid % NXCD, off = wgid / NXCD; wgid = (xcd < r ? xcd * (q + 1) : r * (q + 1) + (xcd - r) * q) + off; }
        const int nig = WGM * nN, gid = wgid / nig, fm = gid * WGM, gsz = (nM - fm) < WGM ? (nM - fm) : WGM;
        u.pm = fm + ((wgid % nig) % gsz); u.pn = (wgid % nig) / gsz; return true;
    }
    __device__ __forceinline__ void a_ready(const Unit&) const {}
    __device__ __forceinline__ void done(const Unit&) const {}
};

typedef float pg8_f32x2_t __attribute__((ext_vector_type(2))); typedef __bf16 pg8_bf16x2_t __attribute__((ext_vector_type(2)));
__device__ __forceinline__ unsigned cvt_pk_bf16(float lo, float hi) { pg8_f32x2_t v = {lo, hi}; pg8_bf16x2_t b = __builtin_convertvector(v, pg8_bf16x2_t); return __builtin_bit_cast(unsigned, b); }
typedef float f32x2 __attribute__((ext_vector_type(2)));
__device__ __forceinline__ f32x2 gelu_pk(f32x2 v) {
    const f32x2 av = __builtin_elementwise_abs(v), d = av * 0.2316418882f + 1.0f;
    f32x2 t; t.x = __builtin_amdgcn_rcpf(d.x); t.y = __builtin_amdgcn_rcpf(d.y);
    f32x2 q = t * 0.5307027145f + (-0.7265760135f); q = q * t + 0.7107068705f; q = q * t + (-0.142248368f); q = q * t + 0.127414796f; q = q * t;
    const f32x2 s = (v * v) * (-0.72134752044f);
    f32x2 e; e.x = __builtin_amdgcn_exp2f(s.x); e.y = __builtin_amdgcn_exp2f(s.y);
    const f32x2 m = v * (q * e), r = v - m;
    f32x2 o; o.x = v.x < 0.f ? m.x : r.x; o.y = v.y < 0.f ? m.y : r.y; return o;
}

template <int ACT  > struct EpiBf16 {
    static constexpr bool PERM = true, AFTER_DRAIN = false; static_assert(ACT == 0 || ACT == 1, "EpiBf16: ACT is 0 (none) or 1 (gelu_pk)");
    bf16_t* O; int ldc; const float* bias; int split_cols; size_t split_stride; float scale0;
    __device__ __forceinline__ void operator()(const f32x4 (&acc)[2][2][4][2], const Unit& u, int wr, int wc, int fr, int fq) const {
        const int row0 = u.pm * BM + wr * 64 + fr; int colt = u.pn * BM; bf16_t* base = O;
        float sc = 1.f; if (split_cols) { const int t = colt / split_cols; base += (size_t)t * split_stride; colt -= t * split_cols; if (t == 0) sc = scale0; }
        const int col0 = colt + wc * 32 + 8 * fq, bcol0 = u.pn * BM + wc * 32 + 8 * fq;
        f32x4 bv[2][2];
#pragma unroll
        for (int bj = 0; bj < 2; ++bj)
#pragma unroll
            for (int n = 0; n < 2; ++n) bv[bj][n] = bias ? *(const f32x4*)(bias + bcol0 + bj * HALF + 4 * n) : (f32x4){0.f, 0.f, 0.f, 0.f};
#pragma unroll
        for (int ai = 0; ai < 2; ++ai)
#pragma unroll
            for (int m = 0; m < 4; ++m) { bf16_t* rowp = base + (size_t)(row0 + ai * HALF + m * 16) * ldc + col0;
#pragma unroll
                for (int bj = 0; bj < 2; ++bj) { f32x4 v0 = acc[ai][bj][m][0] + bv[bj][0], v1 = acc[ai][bj][m][1] + bv[bj][1];
                    if (ACT == 1) { f32x2 a = gelu_pk((f32x2){v0[0], v0[1]}), b = gelu_pk((f32x2){v0[2], v0[3]}), c = gelu_pk((f32x2){v1[0], v1[1]}), d = gelu_pk((f32x2){v1[2], v1[3]});
                        v0 = (f32x4){a.x, a.y, b.x, b.y}; v1 = (f32x4){c.x, c.y, d.x, d.y}; }
                    v0 = v0 * sc; v1 = v1 * sc; u32x4 w; w.x = cvt_pk_bf16(v0[0], v0[1]); w.y = cvt_pk_bf16(v0[2], v0[3]); w.z = cvt_pk_bf16(v1[0], v1[1]); w.w = cvt_pk_bf16(v1[2], v1[3]);
                    *(u32x4*)(rowp + bj * HALF) = w; } }
    }
};


typedef unsigned u32x2 __attribute__((ext_vector_type(2)));
typedef int i32x8 __attribute__((ext_vector_type(8))); typedef int i32x4 __attribute__((ext_vector_type(4)));
__device__ __forceinline__ i32x8 cat8(bf16x8 a, bf16x8 b) { const i32x4 x = __builtin_bit_cast(i32x4, a), y = __builtin_bit_cast(i32x4, b); return __builtin_shufflevector(x, y, 0, 1, 2, 3, 4, 5, 6, 7); }
__device__ __forceinline__ unsigned pk4_fp8(float a, float b, float c, float d) {
    a = __builtin_fminf(__builtin_fmaxf(a, -448.f), 448.f); b = __builtin_fminf(__builtin_fmaxf(b, -448.f), 448.f); c = __builtin_fminf(__builtin_fmaxf(c, -448.f), 448.f); d = __builtin_fminf(__builtin_fmaxf(d, -448.f), 448.f);
    int w = 0; w = __builtin_amdgcn_cvt_pk_fp8_f32(a, b, w, false); w = __builtin_amdgcn_cvt_pk_fp8_f32(c, d, w, true); return (unsigned)w; }
__device__ __forceinline__ float fast_sigmoid(float x) { return __builtin_amdgcn_rcpf(1.0f + __builtin_amdgcn_exp2f(-1.4426950408889634f * x)); }
__device__ __forceinline__ f32x4 sigmoid4(f32x4 x) { f32x4 e = x * -1.4426950408889634f;
#pragma unroll
    for (int i = 0; i < 4; ++i) e[i] = __builtin_amdgcn_exp2f(e[i]);
    e = e + 1.0f;
#pragma unroll
    for (int i = 0; i < 4; ++i) e[i] = __builtin_amdgcn_rcpf(e[i]);
    return e; }
__device__ __forceinline__ f32x4 gelu_tanh4(f32x4 x) { const f32x4 a = x * (x * x * 0.044715f + 1.0f) * 1.5957691216057308f; return x * sigmoid4(a); }
__device__ __forceinline__ float gelu_tanh(float x) {
    const float a = 1.5957691216057308f * (x + 0.044715f * x * x * x);
    return x * fast_sigmoid(a);
}
__device__ __forceinline__ float bf_lo(unsigned w) { return __uint_as_float(w << 16); }
__device__ __forceinline__ float bf_hi(unsigned w) { return __uint_as_float(w & 0xffff0000u); }
__device__ __forceinline__ u32x4 pack8(f32x4 v0, f32x4 v1) { u32x4 w; w.x = cvt_pk_bf16(v0[0], v0[1]); w.y = cvt_pk_bf16(v0[2], v0[3]); w.z = cvt_pk_bf16(v1[0], v1[1]); w.w = cvt_pk_bf16(v1[2], v1[3]); return w; }

struct EpiProj {
    static constexpr bool PERM = true, AFTER_DRAIN = false;
    unsigned char* ws; size_t oQ, oK, oSUV, oCY, oPIN; const float* gq; const float* gk;
    __device__ __forceinline__ void operator()(const f32x4 (&acc)[2][2][4][2], const Unit& u, int wr, int wc, int fr, int fq) const {
        const int row0 = u.pm * BM + wr * 64 + fr; const int pn = u.pn; const int cw = wc * 32 + 8 * fq;
        if (pn >= 8 && pn < 12) {
            bf16_t* base = (bf16_t*)(ws + oCY) + (pn - 8) * HALF + cw;
#pragma unroll
            for (int ai = 0; ai < 2; ++ai)
#pragma unroll
                for (int m = 0; m < 4; ++m) { bf16_t* rowp = base + (size_t)(row0 + ai * HALF + m * 16) * 512;
                    f32x4 v0 = acc[ai][0][m][0], v1 = acc[ai][0][m][1]; const f32x4 g0 = acc[ai][1][m][0], g1 = acc[ai][1][m][1];
                    v0 = v0 * sigmoid4(g0); v1 = v1 * sigmoid4(g1);
                    *(u32x4*)rowp = pack8(v0, v1); }
        } else {
            if (pn < 4) {
                const bool isq = pn < 2; const float* gv = isq ? gq : gk; bf16_t* base = (bf16_t*)(ws + (isq ? oQ : oK)) + (pn & 1) * BM + wc * 64 + 8 * fq;
                f32x4 gg[2][2];
#pragma unroll
                for (int bj = 0; bj < 2; ++bj)
#pragma unroll
                    for (int n = 0; n < 2; ++n) gg[bj][n] = *(const f32x4*)(gv + 32 * bj + 8 * fq + 4 * n);
                const float post = isq ? 0.125f * 1.4426950408889634f : 1.0f;
#pragma unroll
                for (int ai = 0; ai < 2; ++ai)
#pragma unroll
                    for (int m = 0; m < 4; ++m) { float ss = 0.f;
#pragma unroll
                        for (int bj = 0; bj < 2; ++bj)
#pragma unroll
                            for (int n = 0; n < 2; ++n) { const f32x4 a = acc[ai][bj][m][n]; ss += (a[0] * a[0] + a[1] * a[1]) + (a[2] * a[2] + a[3] * a[3]); }
                        ss += __shfl_xor(ss, 16); ss += __shfl_xor(ss, 32);
                        const float r = __builtin_amdgcn_rsqf(ss * (1.0f / 64.0f) + 1e-6f) * post;
                        bf16_t* rowp = base + (size_t)(row0 + ai * HALF + m * 16) * 512;
#pragma unroll
                        for (int bj = 0; bj < 2; ++bj) *(u32x4*)(rowp + 32 * bj) = pack8(acc[ai][bj][m][0] * r * gg[bj][0], acc[ai][bj][m][1] * r * gg[bj][1]); }
                return;
            }
            size_t boff; int ld, colt, kind;
            if (pn < 8) { boff = oSUV; ld = 1024; colt = (pn - 4) * BM; kind = 1; }
            else { boff = oPIN; ld = 512; colt = (pn - 12) * BM; kind = 0; }
            bf16_t* base = (bf16_t*)(ws + boff) + colt + cw;
#pragma unroll
            for (int ai = 0; ai < 2; ++ai)
#pragma unroll
                for (int m = 0; m < 4; ++m) { bf16_t* rowp = base + (size_t)(row0 + ai * HALF + m * 16) * ld;
#pragma unroll
                    for (int bj = 0; bj < 2; ++bj) { f32x4 v0 = acc[ai][bj][m][0], v1 = acc[ai][bj][m][1];
                        if (kind == 1) { v0 = gelu_tanh4(v0); v1 = gelu_tanh4(v1); }
                        *(u32x4*)(rowp + bj * HALF) = pack8(v0, v1); } }
        }
    }
};
struct EpiProjI8 {
    static constexpr bool PERM = true, AFTER_DRAIN = false;
    unsigned char* ws; size_t oQ, oK, oSUV, oCY, oPIN; const float* gq; const float* gk; const float* rs; float wsc;
    struct Pre { float rs[2][4]; };
    __device__ __forceinline__ void preload(Pre& p, const Unit& u, int wr, int wc, int fr, int fq) const {
        const int row0 = u.pm * BM + wr * 64 + fr;
#pragma unroll
        for (int ai = 0; ai < 2; ++ai)
#pragma unroll
            for (int m = 0; m < 4; ++m) p.rs[ai][m] = rs[row0 + ai * HALF + m * 16];
    }
    __device__ __forceinline__ void operator()(const f32x4 (&acc)[2][2][4][2], const Pre& p, const Unit& u, int wr, int wc, int fr, int fq) const {
        const int row0 = u.pm * BM + wr * 64 + fr; const int pn = u.pn; const int cw = wc * 32 + 8 * fq;
        float rsc[2][4];
#pragma unroll
        for (int ai = 0; ai < 2; ++ai)
#pragma unroll
            for (int m = 0; m < 4; ++m) rsc[ai][m] = p.rs[ai][m] * wsc;
#define CV(A, S) (__builtin_convertvector(__builtin_bit_cast(i32x4, (A)), f32x4) * (S))
        if (pn >= 8 && pn < 12) {
            bf16_t* base = (bf16_t*)(ws + oCY) + (pn - 8) * HALF + cw;
#pragma unroll
            for (int ai = 0; ai < 2; ++ai)
#pragma unroll
                for (int m = 0; m < 4; ++m) { bf16_t* rowp = base + (size_t)(row0 + ai * HALF + m * 16) * 512;
                    const float sc = rsc[ai][m]; f32x4 v0 = CV(acc[ai][0][m][0], sc), v1 = CV(acc[ai][0][m][1], sc); const f32x4 g0 = CV(acc[ai][1][m][0], sc), g1 = CV(acc[ai][1][m][1], sc);
                    v0 = v0 * sigmoid4(g0); v1 = v1 * sigmoid4(g1);
                    *(u32x4*)rowp = pack8(v0, v1); }
        } else {
            if (pn < 4) {
                const bool isq = pn < 2; const float* gv = isq ? gq : gk; bf16_t* base = (bf16_t*)(ws + (isq ? oQ : oK)) + (pn & 1) * BM + wc * 64 + 8 * fq;
                f32x4 gg[2][2];
#pragma unroll
                for (int bj = 0; bj < 2; ++bj)
#pragma unroll
                    for (int n = 0; n < 2; ++n) gg[bj][n] = *(const f32x4*)(gv + 32 * bj + 8 * fq + 4 * n);
                const float post = isq ? 0.125f * 1.4426950408889634f : 1.0f;
#pragma unroll
                for (int ai = 0; ai < 2; ++ai)
#pragma unroll
                    for (int m = 0; m < 4; ++m) { float ss = 0.f; const float sc = rsc[ai][m]; f32x4 cv[2][2];
#pragma unroll
                        for (int bj = 0; bj < 2; ++bj)
#pragma unroll
                            for (int n = 0; n < 2; ++n) { const f32x4 a = CV(acc[ai][bj][m][n], sc); cv[bj][n] = a; ss += (a[0] * a[0] + a[1] * a[1]) + (a[2] * a[2] + a[3] * a[3]); }
                        ss += __shfl_xor(ss, 16); ss += __shfl_xor(ss, 32);
                        const float r = __builtin_amdgcn_rsqf(ss * (1.0f / 64.0f) + 1e-6f) * post;
                        bf16_t* rowp = base + (size_t)(row0 + ai * HALF + m * 16) * 512;
#pragma unroll
                        for (int bj = 0; bj < 2; ++bj) *(u32x4*)(rowp + 32 * bj) = pack8(cv[bj][0] * r * gg[bj][0], cv[bj][1] * r * gg[bj][1]); }
                return;
            }
            size_t boff; int ld, colt, kind;
            if (pn < 8) { boff = oSUV; ld = 1024; colt = (pn - 4) * BM; kind = 1; }
            else { boff = oPIN; ld = 512; colt = (pn - 12) * BM; kind = 0; }
            bf16_t* base = (bf16_t*)(ws + boff) + colt + cw;
#pragma unroll
            for (int ai = 0; ai < 2; ++ai)
#pragma unroll
                for (int m = 0; m < 4; ++m) { bf16_t* rowp = base + (size_t)(row0 + ai * HALF + m * 16) * ld;
#pragma unroll
                    for (int bj = 0; bj < 2; ++bj) { f32x4 v0 = CV(acc[ai][bj][m][0], rsc[ai][m]), v1 = CV(acc[ai][bj][m][1], rsc[ai][m]);
                        if (kind == 1) { v0 = gelu_tanh4(v0); v1 = gelu_tanh4(v1); }
                        *(u32x4*)(rowp + bj * HALF) = pack8(v0, v1); } }
        }
    }
#undef CV
};


struct EpiVtI8 {
    static constexpr bool PERM = true, AFTER_DRAIN = false;
    bf16_t* O; int ldc; const float* cs; float wsc; int karg_off, vmax_off;
    __device__ __forceinline__ void operator()(const f32x4 (&acc)[2][2][4][2], const Unit& u, int wr, int wc, int fr, int fq) const {
        const int row0 = u.pm * BM + wr * 64 + fr, col0 = u.pn * BM + wc * 32 + 8 * fq;
        float am = 0.f;
#pragma unroll
        for (int bj = 0; bj < 2; ++bj) {
            const f32x4 s0 = *(const f32x4*)(cs + col0 + bj * HALF) * wsc, s1 = *(const f32x4*)(cs + col0 + bj * HALF + 4) * wsc;
#pragma unroll
            for (int ai = 0; ai < 2; ++ai)
#pragma unroll
                for (int m = 0; m < 4; ++m) { const f32x4 v0 = __builtin_convertvector(__builtin_bit_cast(i32x4, acc[ai][bj][m][0]), f32x4) * s0, v1 = __builtin_convertvector(__builtin_bit_cast(i32x4, acc[ai][bj][m][1]), f32x4) * s1;
#pragma unroll
                    for (int e = 0; e < 4; ++e) am = __builtin_fmaxf(am, __builtin_fmaxf(__builtin_fabsf(v0[e]), __builtin_fabsf(v1[e])));
                    *(u32x4*)(O + (size_t)(row0 + ai * HALF + m * 16) * ldc + col0 + bj * HALF) = pack8(v0, v1); }
        }
#pragma unroll
        for (int o = 1; o < 64; o <<= 1) am = __builtin_fmaxf(am, __shfl_xor(am, o));
        am *= 1.00390625f;
        { const char __attribute__((address_space(4)))* kp = (const char __attribute__((address_space(4)))*)__builtin_amdgcn_kernarg_segment_ptr(); asm volatile("" : "+s"(kp));
          unsigned char* wsb = *(unsigned char* const __attribute__((address_space(4)))*)(kp + karg_off);
          if ((fr | fq) == 0) __hip_atomic_fetch_max((unsigned*)(wsb + vmax_off) + (u.pn >> 3), __float_as_uint(am), __ATOMIC_RELAXED, __HIP_MEMORY_SCOPE_AGENT); }
    }
};

struct EpiGate8 {
    static constexpr bool PERM = true, AFTER_DRAIN = false;
    bf16_t* G; const float* bgate; float sc;
    __device__ __forceinline__ void operator()(const f32x4 (&acc)[2][2][4][2], const Unit& u, int wr, int wc, int fr, int fq) const {
        const int row0 = u.pm * BM + wr * 64 + fr, col0 = u.pn * BM + wc * 32 + 8 * fq;
        f32x4 bv[2][2];
#pragma unroll
        for (int bj = 0; bj < 2; ++bj)
#pragma unroll
            for (int n = 0; n < 2; ++n) bv[bj][n] = *(const f32x4*)(bgate + col0 + bj * HALF + 4 * n);
#pragma unroll
        for (int ai = 0; ai < 2; ++ai)
#pragma unroll
            for (int m = 0; m < 4; ++m) { bf16_t* rowp = G + (size_t)(row0 + ai * HALF + m * 16) * 4096 + col0;
#pragma unroll
                for (int bj = 0; bj < 2; ++bj) { f32x4 v0 = acc[ai][bj][m][0] * sc + bv[bj][0], v1 = acc[ai][bj][m][1] * sc + bv[bj][1];
#pragma unroll
                    for (int e = 0; e < 4; ++e) { v0[e] = fast_sigmoid(v0[e]); v1[e] = fast_sigmoid(v1[e]); }
                    __builtin_nontemporal_store(pack8(v0, v1), (u32x4*)(rowp + bj * HALF)); } }
    }
};

struct EpiGateI8 {
    static constexpr bool PERM = true, AFTER_DRAIN = false;
    unsigned char* G; const float* bgate; const float* rs; float wsc;
    struct Pre { f32x4 bv[2][2]; float rs[2][4]; };
    __device__ __forceinline__ void preload(Pre& p, const Unit& u, int wr, int wc, int fr, int fq) const {
        const int row0 = u.pm * BM + wr * 64 + fr, col0 = u.pn * BM + wc * 32 + 8 * fq;
#pragma unroll
        for (int bj = 0; bj < 2; ++bj)
#pragma unroll
            for (int n = 0; n < 2; ++n) p.bv[bj][n] = *(const f32x4*)(bgate + col0 + bj * HALF + 4 * n);
#pragma unroll
        for (int ai = 0; ai < 2; ++ai)
#pragma unroll
            for (int m = 0; m < 4; ++m) p.rs[ai][m] = rs[row0 + ai * HALF + m * 16];
    }
    __device__ __forceinline__ void operator()(const f32x4 (&acc)[2][2][4][2], const Pre& p, const Unit& u, int wr, int wc, int fr, int fq) const {
        const int row0 = u.pm * BM + wr * 64 + fr, col0 = u.pn * BM + wc * 32 + 8 * fq;
        f32x4 bv[2][2]; float rsc[2][4];
#pragma unroll
        for (int bj = 0; bj < 2; ++bj)
#pragma unroll
            for (int n = 0; n < 2; ++n) bv[bj][n] = p.bv[bj][n] * -1.4426950408889634f;
#pragma unroll
        for (int ai = 0; ai < 2; ++ai)
#pragma unroll
            for (int m = 0; m < 4; ++m) rsc[ai][m] = p.rs[ai][m] * (wsc * -1.4426950408889634f);
#pragma unroll
        for (int ai = 0; ai < 2; ++ai)
#pragma unroll
            for (int m = 0; m < 4; ++m) { unsigned char* rowp = G + (size_t)(row0 + ai * HALF + m * 16) * 4096 + col0; const float sc = rsc[ai][m];
#pragma unroll
                for (int bj = 0; bj < 2; ++bj) { const i32x4 a0 = __builtin_bit_cast(i32x4, acc[ai][bj][m][0]), a1 = __builtin_bit_cast(i32x4, acc[ai][bj][m][1]);
                    f32x4 v0 = __builtin_convertvector(a0, f32x4) * sc + bv[bj][0], v1 = __builtin_convertvector(a1, f32x4) * sc + bv[bj][1];
#pragma unroll
                    for (int e = 0; e < 4; ++e) { v0[e] = __builtin_amdgcn_exp2f(v0[e]); v1[e] = __builtin_amdgcn_exp2f(v1[e]); }
                    v0 = v0 * (1.0f / 255.0f) + (1.0f / 255.0f); v1 = v1 * (1.0f / 255.0f) + (1.0f / 255.0f);
#pragma unroll
                    for (int e = 0; e < 4; ++e) { v0[e] = __builtin_amdgcn_rcpf(v0[e]); v1[e] = __builtin_amdgcn_rcpf(v1[e]); }
                    unsigned p0 = 0u, p1 = 0u;
#pragma unroll
                    for (int e = 0; e < 4; ++e) { p0 = __builtin_amdgcn_cvt_pk_u8_f32(__builtin_rintf(v0[e]), e, p0); p1 = __builtin_amdgcn_cvt_pk_u8_f32(__builtin_rintf(v1[e]), e, p1); }
                    typedef unsigned u32x2_g __attribute__((ext_vector_type(2)));
                    *(u32x2_g*)(rowp + bj * HALF) = (u32x2_g){p0, p1}; } }
    }
};

struct EpiMerge {
    static constexpr bool PERM = true, AFTER_DRAIN = false;
    const bf16_t* G; bf16_t* MG;
    __device__ __forceinline__ void operator()(const f32x4 (&acc)[2][2][4][2], const Unit& u, int wr, int wc, int fr, int fq) const {
        const int br = u.pn >> 2, ct = u.pn & 3, rt = u.pm - br * 128;
        const int row0 = rt * BM + wr * 64 + fr, col0 = ct * BM + wc * 32 + 8 * fq;
#pragma unroll
        for (int ai = 0; ai < 2; ++ai) {
            u32x4 g[4][2], o[4][2];
#pragma unroll
            for (int m = 0; m < 4; ++m) { const size_t row = (size_t)(row0 + ai * HALF + m * 16);
#pragma unroll
                for (int bj = 0; bj < 2; ++bj) { const int col = col0 + bj * HALF;
                    g[m][bj] = *(const u32x4*)(G + row * 4096 + br * 1024 + col);
                    o[m][bj] = (br > 0) ? *(const u32x4*)(MG + row * 1024 + col) : (u32x4){0u, 0u, 0u, 0u}; } }
#pragma unroll
            for (int m = 0; m < 4; ++m) { const size_t row = (size_t)(row0 + ai * HALF + m * 16);
#pragma unroll
                for (int bj = 0; bj < 2; ++bj) { const int col = col0 + bj * HALF; const u32x4 gg = g[m][bj], oo = o[m][bj];
                    f32x4 v0 = acc[ai][bj][m][0], v1 = acc[ai][bj][m][1];
                    v0[0] = v0[0] * bf_lo(gg.x) + bf_lo(oo.x); v0[1] = v0[1] * bf_hi(gg.x) + bf_hi(oo.x); v0[2] = v0[2] * bf_lo(gg.y) + bf_lo(oo.y); v0[3] = v0[3] * bf_hi(gg.y) + bf_hi(oo.y);
                    v1[0] = v1[0] * bf_lo(gg.z) + bf_lo(oo.z); v1[1] = v1[1] * bf_hi(gg.z) + bf_hi(oo.z); v1[2] = v1[2] * bf_lo(gg.w) + bf_lo(oo.w); v1[3] = v1[3] * bf_hi(gg.w) + bf_hi(oo.w);
                    *(u32x4*)(MG + row * 1024 + col) = pack8(v0, v1); } }
        }
    }
};
struct EpiMerge2 {
    const unsigned char* G; bf16_t* MG; const float* rs; int rstride; float wsc;
    __device__ __forceinline__ void operator()(const f32x4 (&acc)[2][4][2], u32x4 (&mgp)[2][4], const Unit& u, int wr, int wc, int fr, int fq) const {
        const int br = u.pn >> 3, ct = u.pn & 7, rt = u.pm - br * 128;
        const int row0 = rt * BM + wr * 64 + fr, col0 = ct * HALF + wc * 32 + 8 * fq;
        typedef unsigned u32x2_g __attribute__((ext_vector_type(2)));
        u32x2_g g[2][4]; float rsc[2][4];
#pragma unroll
        for (int ai = 0; ai < 2; ++ai)
#pragma unroll
            for (int m = 0; m < 4; ++m) { g[ai][m] = *(const u32x2_g*)(G + (size_t)(row0 + ai * HALF + m * 16) * 4096 + br * 1024 + col0); rsc[ai][m] = rs[(size_t)br * rstride + row0 + ai * HALF + m * 16] * wsc; }
#pragma unroll
        for (int ai = 0; ai < 2; ++ai)
#pragma unroll
            for (int m = 0; m < 4; ++m) { const u32x2_g gg = g[ai][m]; f32x4 v0 = __builtin_convertvector(__builtin_bit_cast(i32x4, acc[ai][m][0]), f32x4) * rsc[ai][m], v1 = __builtin_convertvector(__builtin_bit_cast(i32x4, acc[ai][m][1]), f32x4) * rsc[ai][m];
                v0[0] *= (float)(gg.x & 255u); v0[1] *= (float)((gg.x >> 8) & 255u); v0[2] *= (float)((gg.x >> 16) & 255u); v0[3] *= (float)(gg.x >> 24);
                v1[0] *= (float)(gg.y & 255u); v1[1] *= (float)((gg.y >> 8) & 255u); v1[2] *= (float)((gg.y >> 16) & 255u); v1[3] *= (float)(gg.y >> 24);
                if (br != 0) { const u32x4 oo = mgp[ai][m];
                    v0[0] += bf_lo(oo.x); v0[1] += bf_hi(oo.x); v0[2] += bf_lo(oo.y); v0[3] += bf_hi(oo.y); v1[0] += bf_lo(oo.z); v1[1] += bf_hi(oo.z); v1[2] += bf_lo(oo.w); v1[3] += bf_hi(oo.w); }
                const u32x4 pk = pack8(v0, v1); mgp[ai][m] = pk;
                if (br == 3) *(u32x4*)(MG + (size_t)(row0 + ai * HALF + m * 16) * 1024 + col0) = pk; }
    }
};
struct MergeOrder2 {
    int G, c;
    __device__ __forceinline__ bool next(int i, Unit& u) const {
        const int tl = (i >> 2) * G + c; if (tl >= 1024) return false;
        const int br = i & 3, rt = tl >> 3, ct = tl & 7; u.pm = br * 128 + rt; u.pn = br * 8 + ct; return true;
    }
    __device__ __forceinline__ void a_ready(const Unit&) const {}
    __device__ __forceinline__ void done(const Unit&) const {}
};
struct MergeOrder {
    int G, c;
    __device__ __forceinline__ bool next(int i, Unit& u) const {
        const int tl = (i >> 2) * G + c; if (tl >= 512) return false;
        const int br = i & 3, rt = tl >> 2, ct = tl & 3; u.pm = br * 128 + rt; u.pn = br * 4 + ct; return true;
    }
    __device__ __forceinline__ void a_ready(const Unit&) const {}
    __device__ __forceinline__ void done(const Unit&) const {}
};

struct EpiResid {
    static constexpr bool PERM = true, AFTER_DRAIN = false;
    const float* xin32; const bf16_t* xin; bf16_t* xout; float sc;
    __device__ __forceinline__ void operator()(const f32x4 (&acc)[2][2][4][2], const Unit& u, int wr, int wc, int fr, int fq) const {
        const int row0 = u.pm * BM + wr * 64 + fr, col0 = u.pn * BM + wc * 32 + 8 * fq;
#pragma unroll
        for (int ai = 0; ai < 2; ++ai) {
            f32x4 a[4][2][2];
            if (xin32) {
#pragma unroll
                for (int m = 0; m < 4; ++m) { const size_t off = (size_t)(row0 + ai * HALF + m * 16) * 1024 + col0;
#pragma unroll
                    for (int bj = 0; bj < 2; ++bj) { a[m][bj][0] = *(const f32x4*)(xin32 + off + bj * HALF); a[m][bj][1] = *(const f32x4*)(xin32 + off + bj * HALF + 4); } }
            } else {
                u32x4 r[4][2];
#pragma unroll
                for (int m = 0; m < 4; ++m) { const size_t off = (size_t)(row0 + ai * HALF + m * 16) * 1024 + col0;
#pragma unroll
                    for (int bj = 0; bj < 2; ++bj) r[m][bj] = *(const u32x4*)(xin + off + bj * HALF); }
#pragma unroll
                for (int m = 0; m < 4; ++m)
#pragma unroll
                    for (int bj = 0; bj < 2; ++bj) { const u32x4 q = r[m][bj]; a[m][bj][0] = (f32x4){bf_lo(q.x), bf_hi(q.x), bf_lo(q.y), bf_hi(q.y)}; a[m][bj][1] = (f32x4){bf_lo(q.z), bf_hi(q.z), bf_lo(q.w), bf_hi(q.w)}; }
            }
#pragma unroll
            for (int m = 0; m < 4; ++m) { const size_t off = (size_t)(row0 + ai * HALF + m * 16) * 1024 + col0;
#pragma unroll
                for (int bj = 0; bj < 2; ++bj) *(u32x4*)(xout + off + bj * HALF) = pack8(a[m][bj][0] + acc[ai][bj][m][0] * sc, a[m][bj][1] + acc[ai][bj][m][1] * sc); }
        }
    }
};

struct EpiSwiglu {
    static constexpr bool PERM = true, AFTER_DRAIN = false;
    bf16_t* ACT; int ldc, nct;
    __device__ __forceinline__ void operator()(const f32x4 (&acc)[2][2][4][2], const Unit& u, int wr, int wc, int fr, int fq) const {
        const int row0 = u.pm * BM + wr * 64 + fr, col0 = (u.pn % nct) * HALF + wc * 32 + 8 * fq;
#pragma unroll
        for (int ai = 0; ai < 2; ++ai)
#pragma unroll
            for (int m = 0; m < 4; ++m) { bf16_t* rowp = ACT + (size_t)(row0 + ai * HALF + m * 16) * ldc + col0;
                const f32x4 g0 = acc[ai][0][m][0], g1 = acc[ai][0][m][1]; f32x4 v0 = acc[ai][1][m][0], v1 = acc[ai][1][m][1];
#pragma unroll
                for (int e = 0; e < 4; ++e) { v0[e] *= g0[e] * fast_sigmoid(g0[e]); v1[e] *= g1[e] * fast_sigmoid(g1[e]); }
                *(u32x4*)rowp = pack8(v0, v1); }
    }
};

struct EpiSwiglu8 {
    static constexpr bool PERM = true, AFTER_DRAIN = false;
    unsigned char* ACT; int ldc, nct; float sc;
    __device__ __forceinline__ void operator()(const f32x4 (&acc)[2][2][4][2], const Unit& u, int wr, int wc, int fr, int fq) const {
        const int row0 = u.pm * BM + wr * 64 + fr, col0 = (u.pn % nct) * HALF + wc * 32 + 8 * fq;
#pragma unroll
        for (int ai = 0; ai < 2; ++ai)
#pragma unroll
            for (int m = 0; m < 4; ++m) { unsigned char* rowp = ACT + (size_t)(row0 + ai * HALF + m * 16) * ldc + col0;
                const f32x4 g0 = acc[ai][0][m][0] * sc, g1 = acc[ai][0][m][1] * sc; f32x4 v0 = acc[ai][1][m][0] * sc, v1 = acc[ai][1][m][1] * sc;
#pragma unroll
                for (int e = 0; e < 4; ++e) { v0[e] *= g0[e] * fast_sigmoid(g0[e]); v1[e] *= g1[e] * fast_sigmoid(g1[e]); }
                u32x2 w; w.x = pk4_fp8(v0[0], v0[1], v0[2], v0[3]); w.y = pk4_fp8(v1[0], v1[1], v1[2], v1[3]);
                *(u32x2*)rowp = w; }
    }
};

struct EpiSwigluI8 {
    static constexpr bool PERM = true, AFTER_DRAIN = false;
    unsigned char* ACT8; bf16_t* ACTb; int ldc, nct; const float* rs; float wsc;
    struct Pre { float rs[2][4]; };
    __device__ __forceinline__ void preload(Pre& p, const Unit& u, int wr, int wc, int fr, int fq) const {
        const int row0 = u.pm * BM + wr * 64 + fr;
#pragma unroll
        for (int ai = 0; ai < 2; ++ai)
#pragma unroll
            for (int m = 0; m < 4; ++m) p.rs[ai][m] = rs[row0 + ai * HALF + m * 16];
    }
    __device__ __forceinline__ void operator()(const f32x4 (&acc)[2][2][4][2], const Pre& p, const Unit& u, int wr, int wc, int fr, int fq) const {
        const int row0 = u.pm * BM + wr * 64 + fr, col0 = (u.pn % nct) * HALF + wc * 32 + 8 * fq;
        float rsc[2][4];
#pragma unroll
        for (int ai = 0; ai < 2; ++ai)
#pragma unroll
            for (int m = 0; m < 4; ++m) rsc[ai][m] = p.rs[ai][m] * wsc;
#pragma unroll
        for (int ai = 0; ai < 2; ++ai)
#pragma unroll
            for (int m = 0; m < 4; ++m) { const size_t row = (size_t)(row0 + ai * HALF + m * 16); const float sc = rsc[ai][m];
                const i32x4 ga = __builtin_bit_cast(i32x4, acc[ai][0][m][0]), gb = __builtin_bit_cast(i32x4, acc[ai][0][m][1]), ua = __builtin_bit_cast(i32x4, acc[ai][1][m][0]), ub = __builtin_bit_cast(i32x4, acc[ai][1][m][1]);
                const f32x4 gaf = __builtin_convertvector(ga, f32x4), gbf = __builtin_convertvector(gb, f32x4), uaf = __builtin_convertvector(ua, f32x4), ubf = __builtin_convertvector(ub, f32x4);
                const float nsc = sc * -1.4426950408889634f, sc2 = sc * sc;
                f32x4 e0 = gaf * nsc, e1 = gbf * nsc;
#pragma unroll
                for (int e = 0; e < 4; ++e) { e0[e] = __builtin_amdgcn_exp2f(e0[e]); e1[e] = __builtin_amdgcn_exp2f(e1[e]); }
                e0 = e0 + 1.0f; e1 = e1 + 1.0f;
#pragma unroll
                for (int e = 0; e < 4; ++e) { e0[e] = __builtin_amdgcn_rcpf(e0[e]); e1[e] = __builtin_amdgcn_rcpf(e1[e]); }
                const f32x4 v0 = (uaf * gaf) * (e0 * sc2), v1 = (ubf * gbf) * (e1 * sc2);
                if (ACT8) { u32x2 w; w.x = pk4_fp8(v0[0], v0[1], v0[2], v0[3]); w.y = pk4_fp8(v1[0], v1[1], v1[2], v1[3]); *(u32x2*)(ACT8 + row * ldc + col0) = w; }
                else *(u32x4*)(ACTb + row * ldc + col0) = pack8(v0, v1); }
    }
};

struct EpiDownMoe {
    static constexpr bool PERM = true, AFTER_DRAIN = false;
    const int* rinfo; bf16_t* Y; float sc;
    __device__ __forceinline__ void operator()(const f32x4 (&acc)[2][2][4][2], const Unit& u, int wr, int wc, int fr, int fq) const {
        const int prow0 = u.pm * BM + wr * 64 + fr, col0 = (u.pn & 3) * BM + wc * 32 + 8 * fq;
        u32x2 rinf[2][4];
#pragma unroll
        for (int ai = 0; ai < 2; ++ai)
#pragma unroll
            for (int m = 0; m < 4; ++m) rinf[ai][m] = *(const u32x2*)(rinfo + 2 * (size_t)(prow0 + ai * HALF + m * 16));
#pragma unroll
        for (int ai = 0; ai < 2; ++ai)
#pragma unroll
            for (int m = 0; m < 4; ++m) {
                const u32x2 ri = rinf[ai][m]; const int tokk = (int)ri.x; const float gt = __uint_as_float(ri.y) * sc;
                if (tokk >= 0) { bf16_t* rowp = Y + ((size_t)(tokk & 1) * 32768 + (size_t)(tokk >> 1)) * 1024 + col0;
#pragma unroll
                    for (int bj = 0; bj < 2; ++bj) *(u32x4*)(rowp + bj * HALF) = pack8(acc[ai][bj][m][0] * gt, acc[ai][bj][m][1] * gt); } }
    }
};
struct GroupedOrder {
    int G, c, nct, T; int tend[8];
    __device__ __forceinline__ bool next(int i, Unit& u) const {
        const int L = i * G + c; if (L >= T * nct) return false;
        int grp, w;
        if (nct == 28) { grp = L / 224; w = L - grp * 224; } else if (nct == 4) { grp = L >> 5; w = L & 31; } else { const int nig = 8 * nct; grp = L / nig; w = L % nig; }
        const int fm = grp * 8, gsz = (T - fm) < 8 ? (T - fm) : 8;
        int rt, ct; if (gsz == 8) { rt = fm + (w & 7); ct = w >> 3; } else { rt = fm + w % gsz; ct = w / gsz; }
        int e = 0;
#pragma unroll
        for (int k = 0; k < 7; ++k) e += (rt >= tend[k]) ? 1 : 0;
        u.pm = rt; u.pn = e * nct + ct; return true;
    }
    __device__ __forceinline__ void a_ready(const Unit&) const {}
    __device__ __forceinline__ void done(const Unit&) const {}
};
template <class Epi, class Sched, bool ALIGN_EPI = false, bool SP2 = false, bool F8 = false, bool I8 = false, bool ZC = false>
__device__ __forceinline__ void gemm_phase(PG8_LAS unsigned char* lds, const Gemm g, const Sched& S, const Epi& E, int wave_id) {
    int tid_l = wave_id * 64 + lane_id_v(); asm volatile("" : "+v"(tid_l));
    const int tid = tid_l, wid = __builtin_amdgcn_readfirstlane(tid >> 6), lane = tid & 63, wr = wid >> 2, wc = wid & 3, fr = lane & 15, fq = lane >> 4;
    const int K = g.K, nt = K / BK;
    unsigned voffA[2], voffB[2];
#pragma unroll
    for (int i = 0; i < 2; ++i) { int R, C; stage_rc(tid * 16 + i * 8192, R, C); const int Rb = Epi::PERM ? ((R & ~31) + perm32(R & 31)) : R;
        voffA[i] = (unsigned)(R * K + C) * 2u; voffB[i] = (unsigned)(Rb * K + C) * 2u; }
    const size_t kstep = (size_t)(BK * 2);
    const size_t hstep = (size_t)HALF * K * 2;
    const size_t tstep = 2 * hstep;
    const unsigned ldsw = (unsigned)wid * 1024u;
    const int aoff = lds_byte(wr * 64 + fr, fq * 8), boff = lds_byte(wc * 32 + fr, fq * 8);
#define PG8_SA(b, h) (((b) * 2 + (h)) * HTB)
#define PG8_SB(b, h) ((4 + (b) * 2 + (h)) * HTB)
#define PG8_STAGE(bufoff, gbase, voff) do { _Pragma("unroll") for (int _i = 0; _i < 2; ++_i) \
        __builtin_amdgcn_global_load_lds((const unsigned*)((const char*)(gbase) + (voff)[_i]), (PG8_LAS unsigned*)(lds + (bufoff) + ldsw + _i * 8192), 16, 0, 0); } while (0)
#define PG8_LDA(dst, b, h) do { _Pragma("unroll") for (int m = 0; m < 4; ++m) _Pragma("unroll") for (int k = 0; k < 2; ++k) dst[m][k] = *(const PG8_LAS bf16x8*)(lds + PG8_SA(b, h) + aoff + m * 2048 + k * 1024); } while (0)
#define PG8_LDB(dst, b, h) do { _Pragma("unroll") for (int n = 0; n < 2; ++n) _Pragma("unroll") for (int k = 0; k < 2; ++k) dst[n][k] = *(const PG8_LAS bf16x8*)(lds + PG8_SB(b, h) + boff + n * 2048 + k * 1024); } while (0)
#define PG8_MMA(ai, bj, At, Bt) do { __builtin_amdgcn_s_setprio(1); if constexpr (F8) { _Pragma("unroll") for (int m = 0; m < 4; ++m) _Pragma("unroll") for (int n = 0; n < 2; ++n) \
        asm volatile("s_nop 1\n\tv_mfma_f32_16x16x128_f8f6f4 %0, %1, %2, %0" : "+v"(acc[ai][bj][m][n]) : "v"(cat8(Bt[n][0], Bt[n][1])), "v"(cat8(At[m][0], At[m][1]))); } \
        else if constexpr (I8) { _Pragma("unroll") for (int m = 0; m < 4; ++m) _Pragma("unroll") for (int n = 0; n < 2; ++n) _Pragma("unroll") for (int k = 0; k < 2; ++k) \
        acc[ai][bj][m][n] = __builtin_bit_cast(f32x4, __builtin_amdgcn_mfma_i32_16x16x64_i8(__builtin_bit_cast(i32x4, Bt[n][k]), __builtin_bit_cast(i32x4, At[m][k]), __builtin_bit_cast(i32x4, acc[ai][bj][m][n]), 0, 0, 0)); } \
        else { _Pragma("unroll") for (int m = 0; m < 4; ++m) _Pragma("unroll") for (int n = 0; n < 2; ++n) _Pragma("unroll") for (int k = 0; k < 2; ++k) \
        acc[ai][bj][m][n] = __builtin_amdgcn_mfma_f32_16x16x32_bf16(Bt[n][k], At[m][k], acc[ai][bj][m][n], 0, 0, 0); } __builtin_amdgcn_s_setprio(0); } while (0)
#define PG8_MMAZ(ai, bj, At, Bt) do { __builtin_amdgcn_s_setprio(1); if constexpr (F8) { _Pragma("unroll") for (int m = 0; m < 4; ++m) _Pragma("unroll") for (int n = 0; n < 2; ++n) \
        asm volatile("s_nop 1\n\tv_mfma_f32_16x16x128_f8f6f4 %0, %1, %2, 0" : "=&v"(acc[ai][bj][m][n]) : "v"(cat8(Bt[n][0], Bt[n][1])), "v"(cat8(At[m][0], At[m][1]))); } \
        else if constexpr (I8) { _Pragma("unroll") for (int m = 0; m < 4; ++m) _Pragma("unroll") for (int n = 0; n < 2; ++n) { \
        acc[ai][bj][m][n] = __builtin_bit_cast(f32x4, __builtin_amdgcn_mfma_i32_16x16x64_i8(__builtin_bit_cast(i32x4, Bt[n][0]), __builtin_bit_cast(i32x4, At[m][0]), (i32x4){0, 0, 0, 0}, 0, 0, 0)); \
        acc[ai][bj][m][n] = __builtin_bit_cast(f32x4, __builtin_amdgcn_mfma_i32_16x16x64_i8(__builtin_bit_cast(i32x4, Bt[n][1]), __builtin_bit_cast(i32x4, At[m][1]), __builtin_bit_cast(i32x4, acc[ai][bj][m][n]), 0, 0, 0)); } } \
        else { _Pragma("unroll") for (int m = 0; m < 4; ++m) _Pragma("unroll") for (int n = 0; n < 2; ++n) { \
        acc[ai][bj][m][n] = __builtin_amdgcn_mfma_f32_16x16x32_bf16(Bt[n][0], At[m][0], (f32x4){0.f, 0.f, 0.f, 0.f}, 0, 0, 0); \
        acc[ai][bj][m][n] = __builtin_amdgcn_mfma_f32_16x16x32_bf16(Bt[n][1], At[m][1], acc[ai][bj][m][n], 0, 0, 0); } } __builtin_amdgcn_s_setprio(0); } while (0)
#define PG8_WAIT_V(n) asm volatile("s_waitcnt vmcnt(" #n ")" ::: "memory")
#define PG8_WAIT_L(n) asm volatile("s_waitcnt lgkmcnt(" #n ")" ::: "memory")
#define PG8_BAR __builtin_amdgcn_s_barrier()
#define PG8_SCHED __builtin_amdgcn_sched_barrier(0)
    Unit cur, nxt; int ui = 0;
    if (!S.next(0, cur)) return;
    f32x4 acc[2][2][4][2];
    if constexpr (!(SP2 && ZC)) {
#pragma unroll
    for (int a = 0; a < 2; ++a)
#pragma unroll
        for (int b = 0; b < 2; ++b)
#pragma unroll
            for (int m = 0; m < 4; ++m)
#pragma unroll
                for (int n = 0; n < 2; ++n) acc[a][b][m][n] = (f32x4){0.f, 0.f, 0.f, 0.f};
    }
    bf16x8 At[4][2], B0[2][2], B1[2][2];
    const char* cA = (const char*)g.A + (size_t)cur.pm * tstep; const char* cB = (const char*)g.Bt + (size_t)cur.pn * tstep;
    S.a_ready(cur);
    if constexpr (SP2) {
        PG8_STAGE(PG8_SB(0, 0), cB, voffB); PG8_STAGE(PG8_SB(0, 1), cB + hstep, voffB); PG8_STAGE(PG8_SA(0, 0), cA, voffA); PG8_STAGE(PG8_SA(0, 1), cA + hstep, voffA);
        if (wr == 1) PG8_BAR;
        PG8_WAIT_V(2); PG8_BAR;
        PG8_STAGE(PG8_SB(1, 0), cB + kstep, voffB); PG8_STAGE(PG8_SA(1, 0), cA + kstep, voffA); PG8_STAGE(PG8_SB(1, 1), cB + hstep + kstep, voffB);
        PG8_WAIT_V(6); PG8_BAR;
    } else {
        PG8_STAGE(PG8_SB(0, 0), cB, voffB); PG8_STAGE(PG8_SA(0, 0), cA, voffA); PG8_STAGE(PG8_SB(0, 1), cB + hstep, voffB); PG8_STAGE(PG8_SA(0, 1), cA + hstep, voffA);
        if (wr == 1) PG8_BAR;
        PG8_WAIT_V(4); PG8_BAR;
        PG8_STAGE(PG8_SB(1, 0), cB + kstep, voffB); PG8_STAGE(PG8_SA(1, 0), cA + kstep, voffA); PG8_STAGE(PG8_SB(1, 1), cB + hstep + kstep, voffB);
        PG8_WAIT_V(6); PG8_BAR;
    }
    for (;;) {
        const bool has_next = S.next(ui + 1, nxt);
        const char* nA = has_next ? (const char*)g.A + (size_t)nxt.pm * tstep : cA; const char* nB = has_next ? (const char*)g.Bt + (size_t)nxt.pn * tstep : cB;
        for (int t = 0; t < nt; t += 2) {
            const bool last = (t == nt - 2);
            const char* a1 = cA + (size_t)(t + 1) * kstep;
            const char* a2 = last ? nA : cA + (size_t)(t + 2) * kstep; const char* b2 = last ? nB : cB + (size_t)(t + 2) * kstep;
            const char* a3 = a2 + kstep; const char* b3 = b2 + kstep;
            if (last && has_next) S.a_ready(nxt);
            if constexpr (SP2) {
            PG8_LDB(B0, 0, 0); PG8_LDB(B1, 0, 1); PG8_SCHED; PG8_LDA(At, 0, 0); PG8_STAGE(PG8_SA(1, 1), a1 + hstep, voffA);
            PG8_WAIT_V(8); PG8_WAIT_L(0); PG8_BAR; if (ZC && t == 0) { PG8_MMAZ(0, 0, At, B0); PG8_MMAZ(0, 1, At, B1); } else { PG8_MMA(0, 0, At, B0); PG8_MMA(0, 1, At, B1); } PG8_BAR; PG8_SCHED;
            PG8_LDA(At, 0, 1); PG8_STAGE(PG8_SB(0, 0), b2, voffB); PG8_STAGE(PG8_SB(0, 1), b2 + hstep, voffB); PG8_STAGE(PG8_SA(0, 0), a2, voffA);
            PG8_WAIT_V(8); PG8_WAIT_L(0); PG8_BAR; if (ZC && t == 0) { PG8_MMAZ(1, 0, At, B0); PG8_MMAZ(1, 1, At, B1); } else { PG8_MMA(1, 0, At, B0); PG8_MMA(1, 1, At, B1); } PG8_BAR; PG8_SCHED;
            PG8_LDB(B0, 1, 0); PG8_LDB(B1, 1, 1); PG8_SCHED; PG8_LDA(At, 1, 0); PG8_STAGE(PG8_SA(0, 1), a2 + hstep, voffA);
            PG8_WAIT_V(8); PG8_WAIT_L(0); PG8_BAR; PG8_MMA(0, 0, At, B0); PG8_MMA(0, 1, At, B1); PG8_BAR; PG8_SCHED;
            PG8_LDA(At, 1, 1); PG8_STAGE(PG8_SB(1, 0), b3, voffB); PG8_STAGE(PG8_SB(1, 1), b3 + hstep, voffB); PG8_STAGE(PG8_SA(1, 0), a3, voffA);
            PG8_WAIT_V(8); PG8_WAIT_L(0); PG8_BAR; PG8_MMA(1, 0, At, B0); PG8_MMA(1, 1, At, B1); PG8_BAR; PG8_SCHED;
            } else {
            PG8_LDB(B0, 0, 0); PG8_SCHED; PG8_LDA(At, 0, 0); PG8_STAGE(PG8_SA(1, 1), a1 + hstep, voffA);
            PG8_WAIT_L(8); PG8_BAR; PG8_WAIT_L(0); PG8_MMA(0, 0, At, B0); PG8_BAR; PG8_SCHED;
            PG8_LDB(B1, 0, 1); PG8_STAGE(PG8_SB(0, 0), b2, voffB);
            PG8_BAR; PG8_WAIT_L(0); PG8_MMA(0, 1, At, B1); PG8_BAR;
            PG8_LDA(At, 0, 1); PG8_STAGE(PG8_SA(0, 0), a2, voffA);
            PG8_BAR; PG8_WAIT_L(0); PG8_MMA(1, 0, At, B0); PG8_BAR; PG8_SCHED;
            PG8_STAGE(PG8_SB(0, 1), b2 + hstep, voffB);
            PG8_WAIT_V(6); PG8_BAR; PG8_MMA(1, 1, At, B1); PG8_BAR;
            PG8_LDB(B0, 1, 0); PG8_SCHED; PG8_LDA(At, 1, 0); PG8_STAGE(PG8_SA(0, 1), a2 + hstep, voffA);
            PG8_WAIT_L(8); PG8_BAR; PG8_WAIT_L(0); PG8_MMA(0, 0, At, B0); PG8_BAR; PG8_SCHED;
            PG8_LDB(B1, 1, 1); PG8_STAGE(PG8_SB(1, 0), b3, voffB);
            PG8_BAR; PG8_WAIT_L(0); PG8_MMA(0, 1, At, B1); PG8_BAR;
            PG8_LDA(At, 1, 1); PG8_STAGE(PG8_SA(1, 0), a3, voffA);
            PG8_BAR; PG8_WAIT_L(0); PG8_MMA(1, 0, At, B0); PG8_BAR; PG8_SCHED;
            PG8_STAGE(PG8_SB(1, 1), b3 + hstep, voffB);
            PG8_WAIT_V(6); PG8_BAR; PG8_MMA(1, 1, At, B1); PG8_BAR;
            }
        }
        if constexpr (F8) {
#define PG8_PIN8(a, b) asm volatile("" : "+v"(acc[a][b][0][0]), "+v"(acc[a][b][0][1]), "+v"(acc[a][b][1][0]), "+v"(acc[a][b][1][1]), "+v"(acc[a][b][2][0]), "+v"(acc[a][b][2][1]), "+v"(acc[a][b][3][0]), "+v"(acc[a][b][3][1]))
            asm volatile("s_nop 15\n\ts_nop 15" : "+v"(acc[0][0][0][0]), "+v"(acc[0][0][0][1]), "+v"(acc[0][0][1][0]), "+v"(acc[0][0][1][1]), "+v"(acc[0][0][2][0]), "+v"(acc[0][0][2][1]), "+v"(acc[0][0][3][0]), "+v"(acc[0][0][3][1]) :: "memory");
            PG8_PIN8(0, 1); PG8_PIN8(1, 0); PG8_PIN8(1, 1);
#undef PG8_PIN8
        }
        if constexpr (has_pre<Epi>::value && !Epi::AFTER_DRAIN) {
            const int le_ = lane_id_v(), fr_e = le_ & 15, fq_e = le_ >> 4;
            typename Epi::Pre pre; E.preload(pre, cur, wr, wc, fr_e, fq_e);
            asm volatile("" ::: "memory");
            if constexpr (ALIGN_EPI) { if (wr == 0) PG8_BAR; }
            E(acc, pre, cur, wr, wc, fr_e, fq_e); S.done(cur);
        } else {
        if constexpr (ALIGN_EPI) { if (wr == 0) PG8_BAR; }
        if constexpr (!Epi::AFTER_DRAIN) { E(acc, cur, wr, wc, fr, fq); S.done(cur); }
        }
        if (!has_next) break;
        if constexpr (!(SP2 && ZC)) {
#pragma unroll
        for (int a = 0; a < 2; ++a)
#pragma unroll
            for (int b = 0; b < 2; ++b)
#pragma unroll
                for (int m = 0; m < 4; ++m)
#pragma unroll
                    for (int n = 0; n < 2; ++n) acc[a][b][m][n] = (f32x4){0.f, 0.f, 0.f, 0.f};
        }
        cur = nxt; cA = nA; cB = nB; ++ui;
        if constexpr (ALIGN_EPI) { if (wr == 1) PG8_BAR; }
    }
    PG8_WAIT_V(0);
    if constexpr (!ALIGN_EPI) { if (wr == 0) PG8_BAR; }
    PG8_BAR;
    if constexpr (Epi::AFTER_DRAIN) { E.fused(acc, cur, wr, wc, fr, fq, lds, wid, lane); S.done(cur); }
#undef PG8_SA
#undef PG8_SB
#undef PG8_STAGE
#undef PG8_LDA
#undef PG8_LDB
#undef PG8_MMA
#undef PG8_MMAZ
#undef PG8_WAIT_V
#undef PG8_WAIT_L
#undef PG8_BAR
#undef PG8_SCHED
}

template <class Epi, class Sched, bool I8 = false>
__device__ __forceinline__ void gemm_phase_n1(PG8_LAS unsigned char* lds, const Gemm g, const Sched& S, const Epi& E, int wave_id) {
    int tid_l = wave_id * 64 + lane_id_v(); asm volatile("" : "+v"(tid_l));
    const int tid = tid_l, wid = __builtin_amdgcn_readfirstlane(tid >> 6), lane = tid & 63, wr = wid >> 2, wc = wid & 3, fr = lane & 15, fq = lane >> 4;
    const int K = g.K, nt = K / BK;
    unsigned voffA[2], voffB[2];
#pragma unroll
    for (int i = 0; i < 2; ++i) { int R, C; stage_rc(tid * 16 + i * 8192, R, C); const int Rb = (R & ~31) + perm32(R & 31);
        voffA[i] = (unsigned)(R * K + C) * 2u; voffB[i] = (unsigned)(Rb * K + C) * 2u; }
    const size_t kstep = (size_t)(BK * 2);
    const size_t hstep = (size_t)HALF * K * 2;
    const size_t tstep = 2 * hstep;
    const unsigned ldsw = (unsigned)wid * 1024u;
    const int aoff = lds_byte(wr * 64 + fr, fq * 8), boff = lds_byte(wc * 32 + fr, fq * 8);
#define PG8_SA(b, h) (((b) * 2 + (h)) * HTB)
#define PG8_SB(b, h) ((4 + (b) * 2 + (h)) * HTB)
#define PG8_STAGE(bufoff, gbase, voff) do { _Pragma("unroll") for (int _i = 0; _i < 2; ++_i) \
        __builtin_amdgcn_global_load_lds((const unsigned*)((const char*)(gbase) + (voff)[_i]), (PG8_LAS unsigned*)(lds + (bufoff) + ldsw + _i * 8192), 16, 0, 0); } while (0)
#define PG8_LDA(dst, b, h) do { _Pragma("unroll") for (int m = 0; m < 4; ++m) _Pragma("unroll") for (int k = 0; k < 2; ++k) dst[m][k] = *(const PG8_LAS bf16x8*)(lds + PG8_SA(b, h) + aoff + m * 2048 + k * 1024); } while (0)
#define PG8_LDB(dst, b, h) do { _Pragma("unroll") for (int n = 0; n < 2; ++n) _Pragma("unroll") for (int k = 0; k < 2; ++k) dst[n][k] = *(const PG8_LAS bf16x8*)(lds + PG8_SB(b, h) + boff + n * 2048 + k * 1024); } while (0)
#define PG8_MMA1(ai, At, Bt) do { __builtin_amdgcn_s_setprio(1); _Pragma("unroll") for (int m = 0; m < 4; ++m) _Pragma("unroll") for (int n = 0; n < 2; ++n) _Pragma("unroll") for (int k = 0; k < 2; ++k) { \
        if constexpr (I8) acc[ai][m][n] = __builtin_bit_cast(f32x4, __builtin_amdgcn_mfma_i32_16x16x64_i8(__builtin_bit_cast(i32x4, Bt[n][k]), __builtin_bit_cast(i32x4, At[m][k]), __builtin_bit_cast(i32x4, acc[ai][m][n]), 0, 0, 0)); \
        else acc[ai][m][n] = __builtin_amdgcn_mfma_f32_16x16x32_bf16(Bt[n][k], At[m][k], acc[ai][m][n], 0, 0, 0); } __builtin_amdgcn_s_setprio(0); } while (0)
#define PG8_MMA1Z(ai, At, Bt) do { __builtin_amdgcn_s_setprio(1); _Pragma("unroll") for (int m = 0; m < 4; ++m) _Pragma("unroll") for (int n = 0; n < 2; ++n) { \
        if constexpr (I8) { acc[ai][m][n] = __builtin_bit_cast(f32x4, __builtin_amdgcn_mfma_i32_16x16x64_i8(__builtin_bit_cast(i32x4, Bt[n][0]), __builtin_bit_cast(i32x4, At[m][0]), (i32x4){0, 0, 0, 0}, 0, 0, 0)); \
                            acc[ai][m][n] = __builtin_bit_cast(f32x4, __builtin_amdgcn_mfma_i32_16x16x64_i8(__builtin_bit_cast(i32x4, Bt[n][1]), __builtin_bit_cast(i32x4, At[m][1]), __builtin_bit_cast(i32x4, acc[ai][m][n]), 0, 0, 0)); } \
        else { acc[ai][m][n] = __builtin_amdgcn_mfma_f32_16x16x32_bf16(Bt[n][0], At[m][0], (f32x4){0.f, 0.f, 0.f, 0.f}, 0, 0, 0); acc[ai][m][n] = __builtin_amdgcn_mfma_f32_16x16x32_bf16(Bt[n][1], At[m][1], acc[ai][m][n], 0, 0, 0); } } __builtin_amdgcn_s_setprio(0); } while (0)
#define PG8_WAIT_V(n) asm volatile("s_waitcnt vmcnt(" #n ")" ::: "memory")
#define PG8_WAIT_L(n) asm volatile("s_waitcnt lgkmcnt(" #n ")" ::: "memory")
#define PG8_BAR __builtin_amdgcn_s_barrier()
#define PG8_SCHED __builtin_amdgcn_sched_barrier(0)
    Unit cur, nxt; int ui = 0;
    if (!S.next(0, cur)) return;
    f32x4 acc[2][4][2];
    bf16x8 At[4][2], B0[2][2];
    u32x4 xst[2][4];
#pragma unroll
    for (int a = 0; a < 2; ++a)
#pragma unroll
        for (int m = 0; m < 4; ++m) xst[a][m] = (u32x4){0u, 0u, 0u, 0u};
    const char* cA = (const char*)g.A + (size_t)cur.pm * tstep; const char* cB = (const char*)g.Bt + (size_t)cur.pn * hstep;
    S.a_ready(cur);
    PG8_STAGE(PG8_SB(0, 0), cB, voffB); PG8_STAGE(PG8_SA(0, 0), cA, voffA); PG8_STAGE(PG8_SA(0, 1), cA + hstep, voffA);
    if (wr == 1) PG8_BAR;
    PG8_WAIT_V(2); PG8_BAR;
    PG8_STAGE(PG8_SB(1, 0), cB + kstep, voffB); PG8_STAGE(PG8_SA(1, 0), cA + kstep, voffA);
    PG8_WAIT_V(4); PG8_BAR;
    for (;;) {
        const bool has_next = S.next(ui + 1, nxt);
        const char* nA = has_next ? (const char*)g.A + (size_t)nxt.pm * tstep : cA; const char* nB = has_next ? (const char*)g.Bt + (size_t)nxt.pn * hstep : cB;
        for (int t = 0; t < nt; t += 2) {
            const bool last = (t == nt - 2);
            const char* a1 = cA + (size_t)(t + 1) * kstep;
            const char* a2 = last ? nA : cA + (size_t)(t + 2) * kstep; const char* b2 = last ? nB : cB + (size_t)(t + 2) * kstep;
            const char* a3 = a2 + kstep; const char* b3 = b2 + kstep;
            if (last && has_next) S.a_ready(nxt);
            PG8_LDB(B0, 0, 0); PG8_SCHED; PG8_LDA(At, 0, 0); PG8_STAGE(PG8_SA(1, 1), a1 + hstep, voffA);
            PG8_WAIT_V(6); PG8_WAIT_L(0); PG8_BAR; if (t == 0) { PG8_MMA1Z(0, At, B0); } else { PG8_MMA1(0, At, B0); } PG8_BAR; PG8_SCHED;
            PG8_LDA(At, 0, 1); PG8_STAGE(PG8_SB(0, 0), b2, voffB); PG8_STAGE(PG8_SA(0, 0), a2, voffA);
            PG8_WAIT_V(6); PG8_WAIT_L(0); PG8_BAR; if (t == 0) { PG8_MMA1Z(1, At, B0); } else { PG8_MMA1(1, At, B0); } PG8_BAR; PG8_SCHED;
            PG8_LDB(B0, 1, 0); PG8_SCHED; PG8_LDA(At, 1, 0); PG8_STAGE(PG8_SA(0, 1), a2 + hstep, voffA);
            PG8_WAIT_V(6); PG8_WAIT_L(0); PG8_BAR; PG8_MMA1(0, At, B0); PG8_BAR; PG8_SCHED;
            PG8_LDA(At, 1, 1); PG8_STAGE(PG8_SB(1, 0), b3, voffB); PG8_STAGE(PG8_SA(1, 0), a3, voffA);
            PG8_WAIT_V(6); PG8_WAIT_L(0); PG8_BAR; PG8_MMA1(1, At, B0); PG8_BAR; PG8_SCHED;
        }
        if (wr == 0) PG8_BAR;
        E(acc, xst, cur, wr, wc, fr, fq); S.done(cur);
        if (!has_next) break;
        cur = nxt; cA = nA; cB = nB; ++ui;
        if (wr == 1) PG8_BAR;
    }
    PG8_WAIT_V(0);
    PG8_BAR;
#undef PG8_SA
#undef PG8_SB
#undef PG8_STAGE
#undef PG8_LDA
#undef PG8_LDB
#undef PG8_MMA1
#undef PG8_MMA1Z
#undef PG8_WAIT_V
#undef PG8_WAIT_L
#undef PG8_BAR
#undef PG8_SCHED
}

}

constexpr int NTOK = 32768, SEQ = 2048, DM = 1024, NLAYER = 4;
constexpr int INW = 8200;
constexpr int C_Q = 0, C_K = 512, C_V = 1024, C_F = 1536, C_SU = 1544, C_CONV = 2568, C_POOL = 3592, C_GATE = 4104;
constexpr int NPROJ = 3584;
constexpr int FFD = 2816, FFE = 3584, NEXP = 8;
constexpr int PMAX = 65536 + NEXP * 256;
constexpr float EPS = 1e-6f, LOG2E = 1.4426950408889634f;
constexpr int NWAVES = 8;

constexpr size_t MiB = 1u << 20;
constexpr size_t WS_CTL = 0, CTL_ZERO_BYTES = 1 * MiB;
constexpr size_t WS_LF = 1 * MiB;
constexpr size_t WS_RINFO = 2 * MiB;
constexpr size_t WS_HS2 = 3 * MiB + 640 * 1024;
constexpr size_t WS_XSS = 2 * MiB + 640 * 1024;
constexpr size_t WS_HS = 3 * MiB + 512 * 1024;
constexpr size_t WS_ASG = 3 * MiB;
constexpr size_t WS_WMIX = 4 * MiB;
constexpr size_t WM_PROJ = WS_WMIX, WM_G8 = WM_PROJ + (size_t)NPROJ * 1024 * 2  , WM_V = WM_G8 + (size_t)4096 * 1024, WM_B = WM_V + 512 * 1024 * 2, WM_OUT = WM_B + (size_t)4096 * 512 * 2,
                 WM_PG = WM_OUT + (size_t)1024 * 1024 * 2, WM_SP = WM_PG + 4 * 128 * 128 * 2, WM_END = WM_SP + 8 * 128 * 128 * 2;
static_assert(WM_END <= 28 * MiB, "mixer weights");
constexpr size_t WS_XB = 28 * MiB;
constexpr size_t WS_R = 92 * MiB;
constexpr size_t WS_Q = WS_R, WS_K = WS_Q + 32 * MiB, WS_VT = WS_K + 32 * MiB, WS_SUV = WS_VT + 32 * MiB, WS_CY = WS_SUV + 64 * MiB, WS_PIN = WS_CY + 32 * MiB,
                 WS_G = WS_PIN + 32 * MiB, WS_YS = WS_G + 256 * MiB, WS_MG = WS_YS + 128 * MiB, WS_MIX_END = WS_MG + 64 * MiB;
constexpr size_t WS_YSC = WS_YS + 64 * MiB;
constexpr size_t WS_XS = WS_R;
constexpr size_t WS_WFFN = WS_XS + 132 * MiB;
constexpr size_t WS_WF2 = WS_XS + 132 * MiB + 168 * MiB + 462 * MiB + 32 * MiB;
constexpr size_t WF_GU = WS_WF2, WF_D_DENSE = WF_GU + (size_t)2 * FFD * 1024 * 2, WF_D_MOE = WF_GU + (size_t)NEXP * 2 * FFE * 1024;
constexpr size_t WS_ACT = WS_WFFN + 168 * MiB;
constexpr size_t WS_H8 = WS_ACT + 462 * MiB;
constexpr size_t WS_H = WS_H8 + 32 * MiB + 112 * MiB;
constexpr size_t WS_END = WS_H + 32 * MiB;
static_assert(WS_WF2 == WS_H8 + 32 * MiB && WF_D_MOE + (size_t)NEXP * 1024 * FFE <= WS_END && WF_D_DENSE + (size_t)1024 * FFD * 2 <= WS_END, "FFN weight region");
static_assert((size_t)PMAX * FFE * 2 <= 462 * MiB && (size_t)PMAX * 1024 * 2 <= 132 * MiB && WS_MIX_END <= WS_END, "d_ws map");
constexpr int CW_BAR = 4096;
constexpr int CW_VMAX = 32768;
constexpr int CW_CNT = 16384;

constexpr int RING_BYTES = 147456;
constexpr int MISC_OFF = RING_BYTES;
constexpr int LDS_BYTES = RING_BYTES + 256;

#define GAS __attribute__((address_space(1)))
#define LAS __attribute__((address_space(3)))
typedef unsigned short bf16_t;
typedef unsigned v4u __attribute__((ext_vector_type(4)));
typedef unsigned v2u __attribute__((ext_vector_type(2)));
typedef float f32x4 __attribute__((ext_vector_type(4)));
typedef float f32x16 __attribute__((ext_vector_type(16)));
typedef short bf16x8 __attribute__((ext_vector_type(8)));
typedef GAS unsigned gu32;
#define RLX_AGENT __ATOMIC_RELAXED, __HIP_MEMORY_SCOPE_AGENT
#define LDS_WAIT() asm volatile("s_waitcnt lgkmcnt(0)" ::: "memory")
typedef float f32x2_t __attribute__((ext_vector_type(2))); typedef __bf16 bf16x2_t __attribute__((ext_vector_type(2)));
__device__ __forceinline__ unsigned pk2(float lo, float hi) { f32x2_t v = {lo, hi}; bf16x2_t b = __builtin_convertvector(v, bf16x2_t); return __builtin_bit_cast(unsigned, b); }
__device__ __forceinline__ float blo(unsigned w) { return __uint_as_float(w << 16); }
__device__ __forceinline__ float bhi(unsigned w) { return __uint_as_float(w & 0xffff0000u); }
__device__ __forceinline__ float bf1(bf16_t b) { return __uint_as_float((unsigned)b << 16); }
__device__ __forceinline__ bf16_t f2bf(float f) { return (bf16_t)(pk2(f, 0.f) & 0xffffu); }
__device__ __forceinline__ float sigm(float x) { return __builtin_amdgcn_rcpf(1.0f + __builtin_amdgcn_exp2f(-LOG2E * x)); }
__device__ __forceinline__ float wave_sum(float v) {
#pragma unroll
    for (int o = 1; o < 64; o <<= 1) v += __shfl_xor(v, o);
    return v;
}
__device__ __forceinline__ int crow(int r, int hi) { return (r & 3) + 8 * (r >> 2) + 4 * hi; }
#define MFMA32(a, b, c) __builtin_amdgcn_mfma_f32_32x32x16_bf16((a), (b), (c), 0, 0, 0)

__device__ __forceinline__ void tr_item(const float* src, int ldn, int c0, int k0, bf16_t* dst, int ldk, int drow0, LAS float* scr, int lane) {
    {
        f32x4 ld[8]; const int kr = lane >> 3, n4 = (lane & 7) * 4;
#pragma unroll
        for (int i = 0; i < 8; ++i) ld[i] = __builtin_nontemporal_load((const f32x4*)(src + (size_t)(k0 + 8 * i + kr) * ldn + c0 + n4));
#pragma unroll
        for (int i = 0; i < 8; ++i) { LAS float* d = scr + (8 * i + kr) * 33 + n4; d[0] = ld[i][0]; d[1] = ld[i][1]; d[2] = ld[i][2]; d[3] = ld[i][3]; }
    }
    LDS_WAIT(); asm volatile("" ::: "memory");
    const int c = lane & 7;
#pragma unroll
    for (int j = 0; j < 4; ++j) { const int n = (lane >> 3) + 8 * j; const LAS float* s = scr + (8 * c) * 33 + n;
        v4u o; o.x = pk2(s[0 * 33], s[1 * 33]); o.y = pk2(s[2 * 33], s[3 * 33]); o.z = pk2(s[4 * 33], s[5 * 33]); o.w = pk2(s[6 * 33], s[7 * 33]);
        *(v4u*)(dst + (size_t)(drow0 + n) * ldk + k0 + 8 * c) = o; }
    LDS_WAIT(); asm volatile("" ::: "memory");
}
__device__ __forceinline__ unsigned pk4f8(float a, float b, float c, float d) {
    a = __builtin_fminf(__builtin_fmaxf(a, -448.f), 448.f); b = __builtin_fminf(__builtin_fmaxf(b, -448.f), 448.f); c = __builtin_fminf(__builtin_fmaxf(c, -448.f), 448.f); d = __builtin_fminf(__builtin_fmaxf(d, -448.f), 448.f);
    int w = 0; w = __builtin_amdgcn_cvt_pk_fp8_f32(a, b, w, false); w = __builtin_amdgcn_cvt_pk_fp8_f32(c, d, w, true); return (unsigned)w; }
__device__ __forceinline__ unsigned pk4i8(float a, float b, float c, float d) {
    int qa = (int)__builtin_rintf(a), qb = (int)__builtin_rintf(b), qc = (int)__builtin_rintf(c), qd = (int)__builtin_rintf(d);
    qa = qa < -127 ? -127 : (qa > 127 ? 127 : qa); qb = qb < -127 ? -127 : (qb > 127 ? 127 : qb); qc = qc < -127 ? -127 : (qc > 127 ? 127 : qc); qd = qd < -127 ? -127 : (qd > 127 ? 127 : qd);
    return (unsigned)(qa & 255) | ((unsigned)(qb & 255) << 8) | ((unsigned)(qc & 255) << 16) | ((unsigned)(qd & 255) << 24); }
__device__ __forceinline__ v2u quant_row8(const float (&f)[8], float* scp, int lane) {
    float am = 0.f;
#pragma unroll
    for (int e = 0; e < 8; ++e) am = __builtin_fmaxf(am, __builtin_fabsf(f[e]));
#pragma unroll
    for (int o = 1; o < 64; o <<= 1) am = __builtin_fmaxf(am, __shfl_xor(am, o));
    am = __builtin_fmaxf(am, 1e-20f); const float qi = 127.0f / am; if (lane == 0) *scp = am * (1.0f / 127.0f);
    v2u o; o.x = pk4i8(f[0] * qi, f[1] * qi, f[2] * qi, f[3] * qi); o.y = pk4i8(f[4] * qi, f[5] * qi, f[6] * qi, f[7] * qi); return o;
}
__device__ __forceinline__ void quant_store8(const float (&f)[8][8], unsigned char* O, float* Osc, size_t row0, int tfirst, int tstep, int lane) {
    float am[8];
#pragma unroll
    for (int i = 0; i < 8; ++i) { am[i] = 0.f;
#pragma unroll
        for (int e = 0; e < 8; ++e) am[i] = __builtin_fmaxf(am[i], __builtin_fabsf(f[i][e])); }
#pragma unroll
    for (int o = 1; o < 64; o <<= 1)
#pragma unroll
        for (int i = 0; i < 8; ++i) am[i] = __builtin_fmaxf(am[i], __shfl_xor(am[i], o));
#pragma unroll
    for (int i = 0; i < 8; ++i) { const float a = __builtin_fmaxf(am[i], 1e-20f), qi = 127.0f / a; const size_t row = row0 + tfirst + tstep * i;
        if (lane == 0) Osc[row] = a * (1.0f / 127.0f);
        v2u o; o.x = pk4i8(f[i][0] * qi, f[i][1] * qi, f[i][2] * qi, f[i][3] * qi); o.y = pk4i8(f[i][4] * qi, f[i][5] * qi, f[i][6] * qi, f[i][7] * qi);
        *(v2u*)(O + row * 512 + 8 * lane) = o; }
}
template <bool I8Q = false>
__device__ __forceinline__ void tr_item8(const float* src, int ldn, int c0, int k0, unsigned char* dst, int ldk, int drow0, float scale, LAS float* scr, int lane) {
    {
        f32x4 ld[8]; const int kr = lane >> 3, n4 = (lane & 7) * 4;
#pragma unroll
        for (int i = 0; i < 8; ++i) ld[i] = __builtin_nontemporal_load((const f32x4*)(src + (size_t)(k0 + 8 * i + kr) * ldn + c0 + n4));
#pragma unroll
        for (int i = 0; i < 8; ++i) { LAS float* d = scr + (8 * i + kr) * 33 + n4; d[0] = ld[i][0]; d[1] = ld[i][1]; d[2] = ld[i][2]; d[3] = ld[i][3]; }
    }
    LDS_WAIT(); asm volatile("" ::: "memory");
    const int c = lane & 7;
#pragma unroll
    for (int j = 0; j < 4; ++j) { const int n = (lane >> 3) + 8 * j; const LAS float* s = scr + (8 * c) * 33 + n;
        v2u o; if (I8Q) { o.x = pk4i8(s[0 * 33] * scale, s[1 * 33] * scale, s[2 * 33] * scale, s[3 * 33] * scale); o.y = pk4i8(s[4 * 33] * scale, s[5 * 33] * scale, s[6 * 33] * scale, s[7 * 33] * scale); }
        else { o.x = pk4f8(s[0 * 33] * scale, s[1 * 33] * scale, s[2 * 33] * scale, s[3 * 33] * scale); o.y = pk4f8(s[4 * 33] * scale, s[5 * 33] * scale, s[6 * 33] * scale, s[7 * 33] * scale); }
        *(v2u*)(dst + (size_t)(drow0 + n) * ldk + k0 + 8 * c) = o; }
    LDS_WAIT(); asm volatile("" ::: "memory");
}
template <bool I8Q = false>
__device__ __forceinline__ void tr_segment8(const float* src, int ldn, int K, int c_begin, int ncols, unsigned char* dst, int drow_begin, int blk, float scale, LAS float* scr, int gw, int NGW, int lane, int& off) {
    const int nblk = ncols / 32, nitems = (K / 64) * nblk;
    int start = (gw - (off % NGW) + NGW) % NGW;
    for (int it = start; it < nitems; it += NGW) {
        const int kb = it / nblk, nb = it % nblk, n0 = nb * 32;
        const int drow0 = drow_begin + (blk < 0 ? (n0 & ~255) + 128 * ((n0 >> 5) & 1) + 32 * ((n0 >> 6) & 3) : (blk ? (n0 / blk) * (2 * blk) + (n0 % blk) : n0));
        tr_item8<I8Q>(src, ldn, c_begin + n0, kb * 64, dst, K, drow0, scale, scr, lane);
    }
    off += nitems;
}
__device__ __forceinline__ void tr_segment(const float* src, int ldn, int K, int c_begin, int ncols, bf16_t* dst, int drow_begin, int blk, LAS float* scr, int gw, int NGW, int lane, int& off) {
    const int nblk = ncols / 32, nitems = (K / 64) * nblk;
    int start = (gw - (off % NGW) + NGW) % NGW;
    for (int it = start; it < nitems; it += NGW) {
        const int kb = it / nblk, nb = it % nblk, n0 = nb * 32;
        const int drow0 = drow_begin + (blk < 0 ? (n0 & ~255) + 128 * ((n0 >> 5) & 1) + 32 * ((n0 >> 6) & 3)
                                              : (blk ? (n0 / blk) * (2 * blk) + (n0 % blk) : n0));
        tr_item(src, ldn, c_begin + n0, kb * 64, dst, K, drow0, scr, lane);
    }
    off += nitems;
}

struct PItem { const float* srcp; int ldn; unsigned char* dstp; int ldkb; float scale; int kind; };
__device__ __forceinline__ void pitem_load(const PItem& it, f32x4 (&ld)[8], int lane) {
    const int kr = lane >> 3, n4 = (lane & 7) * 4;
#pragma unroll
    for (int i = 0; i < 8; ++i) ld[i] = __builtin_nontemporal_load((const f32x4*)(it.srcp + (size_t)(8 * i + kr) * it.ldn + n4));
}
__device__ __forceinline__ void pitem_finish(const PItem& it, const f32x4 (&ld)[8], LAS float* scr, int lane) {
    const int kr = lane >> 3, n4 = (lane & 7) * 4;
#pragma unroll
    for (int i = 0; i < 8; ++i) { LAS float* d = scr + (8 * i + kr) * 33 + n4; d[0] = ld[i][0]; d[1] = ld[i][1]; d[2] = ld[i][2]; d[3] = ld[i][3]; }
    LDS_WAIT(); asm volatile("" ::: "memory");
    const int c = lane & 7;
#pragma unroll
    for (int j = 0; j < 4; ++j) { const int n = (lane >> 3) + 8 * j; const LAS float* sp = scr + (8 * c) * 33 + n;
        float v[8];
#pragma unroll
        for (int e = 0; e < 8; ++e) v[e] = sp[e * 33] * it.scale;
        if (it.kind == 2) { v2u o; o.x = pk4i8(v[0], v[1], v[2], v[3]); o.y = pk4i8(v[4], v[5], v[6], v[7]); *(v2u*)(it.dstp + (size_t)n * it.ldkb + 8 * c) = o; }
        else if (it.kind == 1) { v2u o; o.x = pk4f8(v[0], v[1], v[2], v[3]); o.y = pk4f8(v[4], v[5], v[6], v[7]); *(v2u*)(it.dstp + (size_t)n * it.ldkb + 8 * c) = o; }
        else { v4u o; o.x = pk2(v[0], v[1]); o.y = pk2(v[2], v[3]); o.z = pk2(v[4], v[5]); o.w = pk2(v[6], v[7]); *(v4u*)(it.dstp + (size_t)n * it.ldkb + 16 * c) = o; } }
    LDS_WAIT(); asm volatile("" ::: "memory");
}
__device__ __forceinline__ PItem ffn_item(int idx, bool moe, bool f8, const float* wg, const float* wu, const float* wd, unsigned char* Wgu, unsigned char* Wdn) {
    PItem it; const int FF = moe ? FFE : FFD, NI = moe ? 1792 : 1408;
    const int seg = idx / NI, local = idx - seg * NI, e = seg / 3, w = seg - 3 * e; const int esz = (w < 2 || f8) ? 1 : 2;
    if (w < 2) { const int nblk = FF / 32, kb = local / nblk, nb = local - kb * nblk, n0 = nb * 32, drow0 = (n0 >> 7) * 256 + (n0 & 127) + 128 * w;
        it.srcp = (w ? wu : wg) + (size_t)e * DM * FF + (size_t)(kb * 64) * FF + n0; it.ldn = FF;
        it.dstp = Wgu + ((size_t)e * 2 * FF * DM + (size_t)drow0 * DM + kb * 64) * esz; it.ldkb = DM * esz; it.scale = 1024.0f; it.kind = 2; }
    else { const int kb = local >> 5, nb = local & 31, n0 = nb * 32;
        it.srcp = wd + (size_t)e * FF * DM + (size_t)(kb * 64) * DM + n0; it.ldn = DM;
        it.dstp = Wdn + ((size_t)e * DM * FF + (size_t)n0 * FF + kb * 64) * esz; it.ldkb = FF * esz; it.scale = f8 ? 64.0f : 1.0f; it.kind = f8 ? 1 : 0; }
    return it;
}
__device__ __forceinline__ void ffn_prep(bool moe, bool f8, const float* wg, const float* wu, const float* wd, unsigned char* Wgu, unsigned char* Wdn, LAS float* scr, int gw, int NGW, int lane) {
    const int total = moe ? 24 * 1792 : 3 * 1408;
    f32x4 la[8], lb[8];
    int idx = gw; PItem cur, nxt;
    if (idx < total) { cur = ffn_item(idx, moe, f8, wg, wu, wd, Wgu, Wdn); pitem_load(cur, la, lane); }
    while (idx < total) {
        const int nidx = idx + NGW; const bool has = nidx < total;
        if (has) { nxt = ffn_item(nidx, moe, f8, wg, wu, wd, Wgu, Wdn); pitem_load(nxt, lb, lane); }
        pitem_finish(cur, la, scr, lane);
        if (has) {
#pragma unroll
            for (int i = 0; i < 8; ++i) la[i] = lb[i];
            cur = nxt; }
        idx = nidx;
    }
}

template <int MODE>
__device__ __forceinline__ void norm_rows(const float* xin32  , const bf16_t* xin, bf16_t* xout, bool write_x, const bf16_t* ycomb  , const float* gain, bf16_t* H, unsigned char* H8  , float* HS  ,
                                          const float* w8, int ldw8, const float* b8, float* LF, int* ASG, gu32* cnt, int gw, int NGW, int lane) {
    f32x4 gv[4];
#pragma unroll
    for (int jj = 0; jj < 4; ++jj) gv[jj] = ((const f32x4*)gain)[64 * jj + lane];
    float wf[4][4][8];
    if (MODE != 1) {
#pragma unroll
        for (int jj = 0; jj < 4; ++jj)
#pragma unroll
            for (int i = 0; i < 4; ++i) { const float* wr = w8 + (size_t)(4 * lane + 256 * jj + i) * ldw8; const f32x4 a = *(const f32x4*)wr, b = *(const f32x4*)(wr + 4);
                wf[jj][i][0] = a[0]; wf[jj][i][1] = a[1]; wf[jj][i][2] = a[2]; wf[jj][i][3] = a[3]; wf[jj][i][4] = b[0]; wf[jj][i][5] = b[1]; wf[jj][i][6] = b[2]; wf[jj][i][7] = b[3]; }
    }
    int my_e = -1, my_row = 0, my_k = 0, nheld = 0; float my_g = 0.f;
    f32x4 vn[4]; v2u vb[4];
    if (gw < NTOK) {
        if (xin32) {
#pragma unroll
            for (int jj = 0; jj < 4; ++jj) vn[jj] = ((const f32x4*)(xin32 + (size_t)gw * DM))[64 * jj + lane];
        } else {
#pragma unroll
            for (int jj = 0; jj < 4; ++jj) vb[jj] = ((const v2u*)(xin + (size_t)gw * DM))[64 * jj + lane];
        }
    }
    for (int row = gw; row < NTOK; row += NGW) {
        f32x4 v[4];
        if (xin32) {
#pragma unroll
            for (int jj = 0; jj < 4; ++jj) v[jj] = vn[jj];
        } else {
#pragma unroll
            for (int jj = 0; jj < 4; ++jj) v[jj] = (f32x4){blo(vb[jj].x), bhi(vb[jj].x), blo(vb[jj].y), bhi(vb[jj].y)};
        }
        if (row + NGW < NTOK) {
            if (xin32) {
#pragma unroll
                for (int jj = 0; jj < 4; ++jj) vn[jj] = ((const f32x4*)(xin32 + (size_t)(row + NGW) * DM))[64 * jj + lane];
            } else {
#pragma unroll
                for (int jj = 0; jj < 4; ++jj) vb[jj] = ((const v2u*)(xin + (size_t)(row + NGW) * DM))[64 * jj + lane];
            }
        }
        if (ycomb) {
#pragma unroll
            for (int jj = 0; jj < 4; ++jj) { const v2u a = ((const v2u*)(ycomb + (size_t)row * DM))[64 * jj + lane], b = ((const v2u*)(ycomb + ((size_t)NTOK + row) * DM))[64 * jj + lane];
                v[jj][0] += blo(a.x) + blo(b.x); v[jj][1] += bhi(a.x) + bhi(b.x); v[jj][2] += blo(a.y) + blo(b.y); v[jj][3] += bhi(a.y) + bhi(b.y); }
        }
        if (write_x) {
#pragma unroll
            for (int jj = 0; jj < 4; ++jj) { v2u o; o.x = pk2(v[jj][0], v[jj][1]); o.y = pk2(v[jj][2], v[jj][3]); ((v2u*)(xout + (size_t)row * DM))[64 * jj + lane] = o;
                v[jj] = (f32x4){blo(o.x), bhi(o.x), blo(o.y), bhi(o.y)}; }
        }
        float ss = 0.f;
#pragma unroll
        for (int jj = 0; jj < 4; ++jj) ss += (v[jj][0] * v[jj][0] + v[jj][1] * v[jj][1]) + (v[jj][2] * v[jj][2] + v[jj][3] * v[jj][3]);
        const float r = __builtin_amdgcn_rsqf(wave_sum(ss) * (1.0f / DM) + EPS);
#pragma unroll
        for (int jj = 0; jj < 4; ++jj) v[jj] = v[jj] * r * gv[jj];
        float qinv = 1.0f;
        if (HS) { float am = 0.f;
#pragma unroll
            for (int jj = 0; jj < 4; ++jj) am = __builtin_fmaxf(__builtin_fmaxf(am, __builtin_fmaxf(__builtin_fabsf(v[jj][0]), __builtin_fabsf(v[jj][1]))), __builtin_fmaxf(__builtin_fabsf(v[jj][2]), __builtin_fabsf(v[jj][3])));
#pragma unroll
            for (int o = 1; o < 64; o <<= 1) am = __builtin_fmaxf(am, __shfl_xor(am, o));
            am = __builtin_fmaxf(am, 1e-20f); qinv = 127.0f / am; if (lane == 0) HS[row] = am * (1.0f / 127.0f); }
#pragma unroll
        for (int jj = 0; jj < 4; ++jj) {
            if (H8 && HS) ((unsigned*)(H8 + (size_t)row * DM))[64 * jj + lane] = pk4i8(v[jj][0] * qinv, v[jj][1] * qinv, v[jj][2] * qinv, v[jj][3] * qinv);
            else if (H8) ((unsigned*)(H8 + (size_t)row * DM))[64 * jj + lane] = pk4f8(v[jj][0], v[jj][1], v[jj][2], v[jj][3]);
            if (H) { v2u o; o.x = pk2(v[jj][0], v[jj][1]); o.y = pk2(v[jj][2], v[jj][3]); ((v2u*)(H + (size_t)row * DM))[64 * jj + lane] = o; } }
        if (MODE != 1) {
            float ps[8];
#pragma unroll
            for (int j = 0; j < 8; ++j) { float s = 0.f;
#pragma unroll
                for (int jj = 0; jj < 4; ++jj)
#pragma unroll
                    for (int i = 0; i < 4; ++i) s += v[jj][i] * wf[jj][i][j];
                ps[j] = s; }
#define RS_STEP(HH) { const bool up = (lane & HH) != 0; _Pragma("unroll") for (int i = 0; i < HH; ++i) { const float keep = up ? ps[i + HH] : ps[i]; const float send = up ? ps[i] : ps[i + HH]; ps[i] = keep + __shfl_xor(send, HH); } }
            RS_STEP(4) RS_STEP(2) RS_STEP(1)
#undef RS_STEP
            float z = ps[0]; z += __shfl_xor(z, 8); z += __shfl_xor(z, 16); z += __shfl_xor(z, 32);
            if (MODE == 0) {
                if (lane < 8) { z += b8[lane]; const float az = __builtin_fabsf(z);
                    const float ls = __builtin_fminf(z, 0.f) - __builtin_amdgcn_logf(1.0f + __builtin_amdgcn_exp2f(-LOG2E * az)) * 0.6931471805599453f;
                    LF[(size_t)row * 8 + lane] = ls; }
            } else {
                float fd[8];
#pragma unroll
                for (int j = 0; j < 8; ++j) fd[j] = __shfl(z, j);
                int i0 = 0; float v0 = fd[0];
#pragma unroll
                for (int j = 1; j < 8; ++j) if (fd[j] > v0) { v0 = fd[j]; i0 = j; }
                int i1 = -1; float v1 = -3.0e38f;
#pragma unroll
                for (int j = 0; j < 8; ++j) if (j != i0 && fd[j] > v1) { v1 = fd[j]; i1 = j; }
                const float g0 = __builtin_amdgcn_rcpf(1.0f + __builtin_amdgcn_exp2f(LOG2E * (v1 - v0))), g1 = 1.0f - g0;
                if (lane == 2 * nheld) { my_e = i0; my_g = g0; my_row = row; my_k = 0; }
                if (lane == 2 * nheld + 1) { my_e = i1; my_g = g1; my_row = row; my_k = 1; }
                ++nheld;
            }
        }
        if (MODE == 2 && (nheld == 32 || row + NGW >= NTOK)) {
            int pos = 0;
#pragma unroll
            for (int e = 0; e < 8; ++e) { const unsigned long long mk = __ballot(my_e == e);
                if (mk) { const int leader = __builtin_ctzll(mk); unsigned base = 0;
                    if (lane == leader) base = __hip_atomic_fetch_add(cnt + 64 * e, (unsigned)__builtin_popcountll(mk), RLX_AGENT);
                    base = __shfl(base, leader);
                    if (my_e == e) pos = (int)base + __builtin_popcountll(mk & ((1ull << lane) - 1ull)); } }
            if (my_e >= 0) { ASG[(size_t)(my_row * 2 + my_k) * 2] = (my_e << 24) | pos; ASG[(size_t)(my_row * 2 + my_k) * 2 + 1] = (int)__float_as_uint(my_g); }
            my_e = -1; nheld = 0;
        }
    }
}

constexpr int AT_KT = 0, AT_VT = 18432, AT_CK = 36864, AT_WT = 45056, AT_TS = 144, AT_QS = 49152  ;
__device__ __forceinline__ void attn_unit(LAS unsigned char* lds, int b, int h, int qb, const bf16_t* Qr, const bf16_t* Kr, const bf16_t* VT, const float* LF,
                                          const float* gq, const float* gk, bf16_t* O, int tid) {
    const int lane = tid & 63, wave = __builtin_amdgcn_readfirstlane(tid >> 6), r32 = lane & 31, hi = lane >> 5;
    const size_t rowbase = (size_t)b * SEQ;
    LAS float* CK = (LAS float*)(lds + AT_CK); LAS float* WT = (LAS float*)(lds + AT_WT);
    {
        float v0 = LF[(rowbase + 4 * tid + 0) * 8 + h], v1 = LF[(rowbase + 4 * tid + 1) * 8 + h], v2 = LF[(rowbase + 4 * tid + 2) * 8 + h], v3 = LF[(rowbase + 4 * tid + 3) * 8 + h];
        v1 += v0; v2 += v1; v3 += v2;
        float incl = v3;
#pragma unroll
        for (int o = 1; o < 64; o <<= 1) { const float n = __shfl_up(incl, o); if (lane >= o) incl += n; }
        if (lane == 63) WT[wave] = incl;
        __syncthreads();
        float base = 0.f;
        for (int w = 0; w < wave; ++w) base += WT[w];
        const float ex = base + incl - v3;
        *(LAS f32x4*)(CK + 4 * tid) = (f32x4){(ex + v0) * -LOG2E, (ex + v1) * -LOG2E, (ex + v2) * -LOG2E, (ex + v3) * -LOG2E};
        __syncthreads();
    }
    const int q_abs = qb * 256 + wave * 32 + r32;
    bf16x8 qf[4];
    {
        const bf16_t* qp = Qr + (rowbase + q_abs) * 512 + h * 64 + 8 * hi;
#pragma unroll
        for (int s = 0; s < 4; ++s) qf[s] = *(const bf16x8*)(qp + 16 * s);
    }
    const int NT = 4 * qb + 4;
    const int lkv = tid >> 3, lch = tid & 7;
    const bf16_t* kp = Kr + (rowbase + lkv) * 512 + h * 64 + 8 * lch;
    const bf16_t* vp = VT + (size_t)(h * 64 + lkv) * NTOK + rowbase + 8 * lch;
    v4u kreg = *(const v4u*)kp, vreg = *(const v4u*)vp;
    f32x16 o0, o1;
#pragma unroll
    for (int i = 0; i < 16; ++i) { o0[i] = 0.f; o1[i] = 0.f; }
    float mrun = -1.0e30f, lrun = 0.f;
    const int qw_max = qb * 256 + wave * 32 + 31, qw_min = qb * 256 + wave * 32;
    for (int j = 0; j < NT; ++j) {
        const int buf = j & 1;
        *(LAS v4u*)(lds + AT_KT + buf * 9216 + lkv * AT_TS + lch * 16) = kreg;
        *(LAS v4u*)(lds + AT_VT + buf * 9216 + lkv * AT_TS + lch * 16) = vreg;
        __syncthreads();
        if (j + 1 < NT) { kreg = *(const v4u*)(kp + (size_t)(j + 1) * 64 * 512); vreg = *(const v4u*)(vp + (j + 1) * 64); }
        if (64 * j <= qw_max) {
            const LAS unsigned char* KT = lds + AT_KT + buf * 9216; const LAS unsigned char* VTL = lds + AT_VT + buf * 9216;
            f32x16 p0, p1;
            const int kvb = 64 * j;
#pragma unroll
            for (int g4 = 0; g4 < 4; ++g4) { const f32x4 c0 = *(const LAS f32x4*)(CK + kvb + 4 * hi + 8 * g4), c1 = *(const LAS f32x4*)(CK + kvb + 32 + 4 * hi + 8 * g4);
#pragma unroll
                for (int e = 0; e < 4; ++e) { p0[4 * g4 + e] = c0[e]; p1[4 * g4 + e] = c1[e]; } }
#pragma unroll
            for (int s = 0; s < 4; ++s) {
                const bf16x8 a0 = *(const LAS bf16x8*)(KT + r32 * AT_TS + (16 * s + 8 * hi) * 2);
                const bf16x8 a1 = *(const LAS bf16x8*)(KT + (32 + r32) * AT_TS + (16 * s + 8 * hi) * 2);
                p0 = MFMA32(a0, qf[s], p0); p1 = MFMA32(a1, qf[s], p1);
            }
            if (kvb + 63 > qw_min) {
#pragma unroll
                for (int i = 0; i < 16; ++i) { const int kv = kvb + crow(i, hi); if (kv > q_abs) p0[i] = -1.0e30f; if (kv + 32 > q_abs) p1[i] = -1.0e30f; }
            }
            float mx = p0[0];
#pragma unroll
            for (int i = 1; i < 16; ++i) mx = __builtin_fmaxf(mx, p0[i]);
#pragma unroll
            for (int i = 0; i < 16; ++i) mx = __builtin_fmaxf(mx, p1[i]);
            mx = __builtin_fmaxf(mx, __shfl_xor(mx, 32));
            const float mnew = __builtin_fmaxf(mrun, mx), alpha = __builtin_amdgcn_exp2f(mrun - mnew); mrun = mnew;
            float ls = 0.f;
#pragma unroll
            for (int i = 0; i < 16; ++i) { p0[i] = __builtin_amdgcn_exp2f(p0[i] - mnew); p1[i] = __builtin_amdgcn_exp2f(p1[i] - mnew); ls += p0[i] + p1[i]; }
            lrun = lrun * alpha + ls;
            if (__any(alpha != 1.0f)) {
#pragma unroll
                for (int i = 0; i < 16; ++i) { o0[i] *= alpha; o1[i] *= alpha; }
            }
            bf16x8 pf[4];
            { v4u w;
              w.x = pk2(p0[0], p0[1]); w.y = pk2(p0[2], p0[3]); w.z = pk2(p0[4], p0[5]); w.w = pk2(p0[6], p0[7]); pf[0] = __builtin_bit_cast(bf16x8, w);
              w.x = pk2(p0[8], p0[9]); w.y = pk2(p0[10], p0[11]); w.z = pk2(p0[12], p0[13]); w.w = pk2(p0[14], p0[15]); pf[1] = __builtin_bit_cast(bf16x8, w);
              w.x = pk2(p1[0], p1[1]); w.y = pk2(p1[2], p1[3]); w.z = pk2(p1[4], p1[5]); w.w = pk2(p1[6], p1[7]); pf[2] = __builtin_bit_cast(bf16x8, w);
              w.x = pk2(p1[8], p1[9]); w.y = pk2(p1[10], p1[11]); w.z = pk2(p1[12], p1[13]); w.w = pk2(p1[14], p1[15]); pf[3] = __builtin_bit_cast(bf16x8, w); }
#pragma unroll
            for (int ks = 0; ks < 4; ++ks) {
                const v2u a0l = *(const LAS v2u*)(VTL + r32 * AT_TS + (16 * ks + 4 * hi) * 2), a0h = *(const LAS v2u*)(VTL + r32 * AT_TS + (16 * ks + 8 + 4 * hi) * 2);
                const v2u a1l = *(const LAS v2u*)(VTL + (32 + r32) * AT_TS + (16 * ks + 4 * hi) * 2), a1h = *(const LAS v2u*)(VTL + (32 + r32) * AT_TS + (16 * ks + 8 + 4 * hi) * 2);
                const v4u A0 = (v4u){a0l.x, a0l.y, a0h.x, a0h.y}, A1 = (v4u){a1l.x, a1l.y, a1h.x, a1h.y};
                o0 = MFMA32(__builtin_bit_cast(bf16x8, A0), pf[ks], o0); o1 = MFMA32(__builtin_bit_cast(bf16x8, A1), pf[ks], o1);
            }
        }
    }
    lrun += __shfl_xor(lrun, 32);
    const float inv = __builtin_amdgcn_rcpf(lrun);
    bf16_t* op = O + (rowbase + q_abs) * 512 + h * 64 + 4 * hi;
#pragma unroll
    for (int g4 = 0; g4 < 4; ++g4) {
        v2u w0, w1; w0.x = pk2(o0[4 * g4] * inv, o0[4 * g4 + 1] * inv); w0.y = pk2(o0[4 * g4 + 2] * inv, o0[4 * g4 + 3] * inv);
        w1.x = pk2(o1[4 * g4] * inv, o1[4 * g4 + 1] * inv); w1.y = pk2(o1[4 * g4 + 2] * inv, o1[4 * g4 + 3] * inv);
        *(v2u*)(op + 8 * g4) = w0; *(v2u*)(op + 32 + 8 * g4) = w1;
    }
    __syncthreads();
}


__device__ __forceinline__ void attn_unit2(LAS unsigned char* lds, int b, int h, int qb, const bf16_t* Qr, const bf16_t* Kr, const bf16_t* VT, const float* LF, const float* gq, const float* gk, unsigned char* O, float* Osc, const unsigned* vmaxp, int tid) {
    const int lane = tid & 63, wave = __builtin_amdgcn_readfirstlane(tid >> 6), r32 = lane & 31, hi = lane >> 5;
    const size_t rowbase = (size_t)b * SEQ;
    LAS float* CK = (LAS float*)(lds + AT_CK); LAS float* WT = (LAS float*)(lds + AT_WT);
    {
        float v0 = LF[(rowbase + 4 * tid + 0) * 8 + h], v1 = LF[(rowbase + 4 * tid + 1) * 8 + h], v2 = LF[(rowbase + 4 * tid + 2) * 8 + h], v3 = LF[(rowbase + 4 * tid + 3) * 8 + h];
        v1 += v0; v2 += v1; v3 += v2;
        float incl = v3;
#pragma unroll
        for (int o = 1; o < 64; o <<= 1) { const float n = __shfl_up(incl, o); if (lane >= o) incl += n; }
        if (lane == 63) WT[wave] = incl;
        __syncthreads();
        float base = 0.f;
        for (int w = 0; w < wave; ++w) base += WT[w];
        const float ex = base + incl - v3;
        *(LAS f32x4*)(CK + 4 * tid) = (f32x4){(ex + v0) * -LOG2E, (ex + v1) * -LOG2E, (ex + v2) * -LOG2E, (ex + v3) * -LOG2E};
        __syncthreads();
    }
    const int qw0 = qb * 512 + wave * 64;
    const int qa0 = qw0 + r32, qa1 = qw0 + 32 + r32;
    LAS unsigned char* qimg = lds + AT_QS + wave * 8192 + lane * 16;
    {
        const bf16_t* qp = Qr + (rowbase + qa0) * 512 + h * 64 + 8 * hi;
        bf16x8 q0[4], q1[4];
#pragma unroll
        for (int s = 0; s < 4; ++s) { q0[s] = *(const bf16x8*)(qp + 16 * s); q1[s] = *(const bf16x8*)(qp + 32 * 512 + 16 * s); }
#pragma unroll
        for (int s = 0; s < 4; ++s) { *(LAS bf16x8*)(qimg + s * 1024) = q0[s]; *(LAS bf16x8*)(qimg + (4 + s) * 1024) = q1[s]; }
    }
    float MBf;
    { float a = __builtin_fabsf(gq[lane]), c = __builtin_fabsf(gk[lane]);
#pragma unroll
      for (int o = 1; o < 64; o <<= 1) { a = __builtin_fmaxf(a, __shfl_xor(a, o)); c = __builtin_fmaxf(c, __shfl_xor(c, o)); }
      MBf = 0.125f * LOG2E * 64.0f * 1.02f * a * c; }
    const bool fixed = __builtin_amdgcn_readfirstlane(__float_as_uint(MBf)) < __float_as_uint(40.0f);
    const int NT = 8 * qb + 8;
    const int lkv = tid >> 3, lch = tid & 7;
    const bf16_t* kp = Kr + (rowbase + lkv) * 512 + h * 64 + 8 * lch;
    const bf16_t* vp = VT + (size_t)(h * 64 + lkv) * NTOK + rowbase + 8 * lch;
#define AT2_CAT16(A, B, C, D) __builtin_shufflevector(__builtin_shufflevector(A, B, 0, 1, 2, 3, 4, 5, 6, 7), __builtin_shufflevector(C, D, 0, 1, 2, 3, 4, 5, 6, 7), 0, 1, 2, 3, 4, 5, 6, 7, 8, 9, 10, 11, 12, 13, 14, 15)
#define AT2_QK(P0, P1, QF) { \
            { const LAS f32x4* cp = (const LAS f32x4*)(CK + kvb + 4 * hi); P0 = AT2_CAT16(cp[0], cp[2], cp[4], cp[6]); P1 = AT2_CAT16(cp[8], cp[10], cp[12], cp[14]); } \
            bf16x8 kfa[4], kfb[4]; \
            _Pragma("unroll") for (int s = 0; s < 4; ++s) { kfa[s] = *(const LAS bf16x8*)(KT + r32 * AT_TS + (16 * s + 8 * hi) * 2); kfb[s] = *(const LAS bf16x8*)(KT + (32 + r32) * AT_TS + (16 * s + 8 * hi) * 2); } \
            bf16x8 qfr[4]; _Pragma("unroll") for (int s = 0; s < 4; ++s) qfr[s] = *(const LAS bf16x8*)(qimg + (4 * (QF) + s) * 1024); \
            __builtin_amdgcn_sched_barrier(0); \
            _Pragma("unroll") for (int s = 0; s < 4; ++s) { P0 = MFMA32(kfa[s], qfr[s], P0); P1 = MFMA32(kfb[s], qfr[s], P1); } }
#define AT2_MASK(P0, P1, QA) { if (kvb + 63 > (QA) - r32) { _Pragma("unroll") for (int i = 0; i < 16; ++i) { const int kv = kvb + crow(i, hi); if (kv > (QA)) P0[i] = -1.0e30f; if (kv + 32 > (QA)) P1[i] = -1.0e30f; } } }
    float rta, rtb;
    if (fixed) { rta = -CK[qb * 512 + wave * 64 + r32] - MBf; rtb = -CK[qb * 512 + wave * 64 + 32 + r32] - MBf; }
    else {
        float mxa = -1.0e30f, mxb = -1.0e30f;
        v4u kr = *(const v4u*)kp;
        for (int j = 0; j < NT; ++j) {
            const int buf = j & 1;
            *(LAS v4u*)(lds + AT_KT + buf * 9216 + lkv * AT_TS + lch * 16) = kr;
            __syncthreads();
            if (j + 1 < NT) kr = *(const v4u*)(kp + (size_t)(j + 1) * 64 * 512);
            const int kvb = 64 * j;
            if (kvb <= qw0 + 63) {
                const LAS unsigned char* KT = lds + AT_KT + buf * 9216;
                if (kvb <= qw0 + 31) { f32x16 p0, p1; AT2_QK(p0, p1, 0) AT2_MASK(p0, p1, qa0)
#pragma unroll
                    for (int i = 0; i < 16; ++i) mxa = __builtin_fmaxf(mxa, __builtin_fmaxf(p0[i], p1[i])); }
                { f32x16 p0, p1; AT2_QK(p0, p1, 1) AT2_MASK(p0, p1, qa1)
#pragma unroll
                    for (int i = 0; i < 16; ++i) mxb = __builtin_fmaxf(mxb, __builtin_fmaxf(p0[i], p1[i])); }
            }
        }
        __syncthreads();
        mxa = __builtin_fmaxf(mxa, __shfl_xor(mxa, 32)); mxb = __builtin_fmaxf(mxb, __shfl_xor(mxb, 32));
        rta = -mxa; rtb = -mxb;
    }
    v4u kreg = *(const v4u*)kp, vreg = *(const v4u*)vp;
    f32x16 oa0, oa1, ob0, ob1;
#pragma unroll
    for (int i = 0; i < 16; ++i) { oa0[i] = 0.f; oa1[i] = 0.f; ob0[i] = 0.f; ob1[i] = 0.f; }
    float l0 = 0.f, l1 = 0.f;
    for (int j = 0; j < NT; ++j) {
        const int buf = j & 1;
        *(LAS v4u*)(lds + AT_KT + buf * 9216 + lkv * AT_TS + lch * 16) = kreg;
        *(LAS v4u*)(lds + AT_VT + buf * 9216 + lkv * AT_TS + lch * 16) = vreg;
        __syncthreads();
        if (j + 1 < NT) { kreg = *(const v4u*)(kp + (size_t)(j + 1) * 64 * 512); vreg = *(const v4u*)(vp + (j + 1) * 64); }
        const int kvb = 64 * j;
        if (kvb <= qw0 + 63) {
            const LAS unsigned char* KT = lds + AT_KT + buf * 9216; const LAS unsigned char* VTL = lds + AT_VT + buf * 9216;
            const bool act0 = kvb <= qw0 + 31;
            bf16x8 pfa[4], pfb[4];
#define AT2_SOFTMAX(P0, P1, QA, RT, LR, PF) { \
            AT2_MASK(P0, P1, QA) \
            { P0 += (RT); P1 += (RT);        \
              _Pragma("unroll") for (int i = 0; i < 16; ++i) { P0[i] = __builtin_amdgcn_exp2f(P0[i]); P1[i] = __builtin_amdgcn_exp2f(P1[i]); } \
              f32x2_t ls2 = {0.f, 0.f};        \
              _Pragma("unroll") for (int i = 0; i < 8; ++i) ls2 += (f32x2_t){P0[2 * i], P0[2 * i + 1]} + (f32x2_t){P1[2 * i], P1[2 * i + 1]}; \
              LR += ls2[0] + ls2[1]; } \
            { v4u w; \
              w.x = pk2(P0[0], P0[1]); w.y = pk2(P0[2], P0[3]); w.z = pk2(P0[4], P0[5]); w.w = pk2(P0[6], P0[7]); PF[0] = __builtin_bit_cast(bf16x8, w); \
              w.x = pk2(P0[8], P0[9]); w.y = pk2(P0[10], P0[11]); w.z = pk2(P0[12], P0[13]); w.w = pk2(P0[14], P0[15]); PF[1] = __builtin_bit_cast(bf16x8, w); \
              w.x = pk2(P1[0], P1[1]); w.y = pk2(P1[2], P1[3]); w.z = pk2(P1[4], P1[5]); w.w = pk2(P1[6], P1[7]); PF[2] = __builtin_bit_cast(bf16x8, w); \
              w.x = pk2(P1[8], P1[9]); w.y = pk2(P1[10], P1[11]); w.z = pk2(P1[12], P1[13]); w.w = pk2(P1[14], P1[15]); PF[3] = __builtin_bit_cast(bf16x8, w); } }
            if (act0) { f32x16 pa0, pa1; AT2_QK(pa0, pa1, 0) AT2_SOFTMAX(pa0, pa1, qa0, rta, l0, pfa) }
            { f32x16 pb0, pb1; AT2_QK(pb0, pb1, 1) AT2_SOFTMAX(pb0, pb1, qa1, rtb, l1, pfb) }
#undef AT2_SOFTMAX
#pragma unroll
            for (int kg = 0; kg < 2; ++kg) {
                bf16x8 VA0[2], VA1[2];
#pragma unroll
                for (int k2 = 0; k2 < 2; ++k2) { const int ks = 2 * kg + k2;
                    const v2u a0l = *(const LAS v2u*)(VTL + r32 * AT_TS + (16 * ks + 4 * hi) * 2), a0h = *(const LAS v2u*)(VTL + r32 * AT_TS + (16 * ks + 8 + 4 * hi) * 2);
                    const v2u a1l = *(const LAS v2u*)(VTL + (32 + r32) * AT_TS + (16 * ks + 4 * hi) * 2), a1h = *(const LAS v2u*)(VTL + (32 + r32) * AT_TS + (16 * ks + 8 + 4 * hi) * 2);
                    VA0[k2] = __builtin_bit_cast(bf16x8, ((v4u){a0l.x, a0l.y, a0h.x, a0h.y})); VA1[k2] = __builtin_bit_cast(bf16x8, ((v4u){a1l.x, a1l.y, a1h.x, a1h.y})); }
                __builtin_amdgcn_sched_barrier(0);
#pragma unroll
                for (int k2 = 0; k2 < 2; ++k2) { const int ks = 2 * kg + k2;
                    if (act0) { oa0 = MFMA32(VA0[k2], pfa[ks], oa0); oa1 = MFMA32(VA1[k2], pfa[ks], oa1); }
                    ob0 = MFMA32(VA0[k2], pfb[ks], ob0); ob1 = MFMA32(VA1[k2], pfb[ks], ob1); }
            }
        }
    }
#undef AT2_MASK
#undef AT2_QK
#undef AT2_CAT16
    l0 += __shfl_xor(l0, 32); l1 += __shfl_xor(l1, 32);
    const float vm = __builtin_fmaxf(__uint_as_float(__hip_atomic_load(vmaxp, __ATOMIC_RELAXED, __HIP_MEMORY_SCOPE_AGENT)), 1e-20f), qsc = 127.0f / vm;
    const float inv0 = __builtin_amdgcn_rcpf(l0) * qsc, inv1 = __builtin_amdgcn_rcpf(l1) * qsc;
    unsigned char* op0 = O + (rowbase + qa0) * 512 + h * 64 + 4 * hi; unsigned char* op1 = op0 + 32 * 512;
#pragma unroll
    for (int g4 = 0; g4 < 4; ++g4) {
        *(unsigned*)(op0 + 8 * g4) = pk4i8(oa0[4 * g4] * inv0, oa0[4 * g4 + 1] * inv0, oa0[4 * g4 + 2] * inv0, oa0[4 * g4 + 3] * inv0);
        *(unsigned*)(op0 + 32 + 8 * g4) = pk4i8(oa1[4 * g4] * inv0, oa1[4 * g4 + 1] * inv0, oa1[4 * g4 + 2] * inv0, oa1[4 * g4 + 3] * inv0);
        *(unsigned*)(op1 + 8 * g4) = pk4i8(ob0[4 * g4] * inv1, ob0[4 * g4 + 1] * inv1, ob0[4 * g4 + 2] * inv1, ob0[4 * g4 + 3] * inv1);
        *(unsigned*)(op1 + 32 + 8 * g4) = pk4i8(ob1[4 * g4] * inv1, ob1[4 * g4 + 1] * inv1, ob1[4 * g4 + 2] * inv1, ob1[4 * g4 + 3] * inv1);
    }
    if (h == 0 && hi == 0) { Osc[rowbase + qa0] = vm * (1.0f / 127.0f); Osc[rowbase + qa1] = vm * (1.0f / 127.0f); }
    __syncthreads();
}

constexpr int SG_VT = 0, SG_VS = 272, SG_WB = 64 * 272, SG_PS = 8 * SG_WB;
__device__ __forceinline__ void sgu_unit(LAS unsigned char* lds, int chunk, const bf16_t* SUV, const float* gsgu, const bf16_t* Wsp, const float* bsp, unsigned char* O, float* Osc, int tid) {
    const int lane = tid & 63, g = __builtin_amdgcn_readfirstlane(tid >> 6), r32 = lane & 31, hi = lane >> 5;
    const size_t row0 = (size_t)chunk * 128;
    LAS float* PS = (LAS float*)(lds + SG_PS);
    LAS unsigned char* VTw = lds + SG_VT + g * SG_WB;
    const int c8 = lane & 7, rl = lane >> 3;
    v4u raw[16];
#pragma unroll
    for (int i = 0; i < 16; ++i) raw[i] = *(const v4u*)(SUV + (row0 + rl + 8 * i) * 1024 + 512 + g * 64 + 8 * c8);
#pragma unroll
    for (int i = 0; i < 16; ++i) { float ss = 0.f;
#pragma unroll
        for (int e = 0; e < 4; ++e) { const float a = blo(raw[i][e]), c = bhi(raw[i][e]); ss += a * a + c * c; }
        ss += __shfl_xor(ss, 1); ss += __shfl_xor(ss, 2); ss += __shfl_xor(ss, 4);
        if (c8 == 0) PS[(rl + 8 * i) * 8 + g] = ss; }
    __syncthreads();
    const f32x4 gs0 = *(const f32x4*)(gsgu + g * 64 + 8 * c8), gs1 = *(const f32x4*)(gsgu + g * 64 + 8 * c8 + 4);
#pragma unroll
    for (int i = 0; i < 16; ++i) { const int t = rl + 8 * i;
        const f32x4 pa = *(const LAS f32x4*)(PS + t * 8), pb = *(const LAS f32x4*)(PS + t * 8 + 4);
        const float r = __builtin_amdgcn_rsqf(((pa[0] + pa[1]) + (pa[2] + pa[3]) + (pb[0] + pb[1]) + (pb[2] + pb[3])) * (1.0f / 512.0f) + EPS);
        float f[8]; f[0] = blo(raw[i].x) * r * gs0[0]; f[1] = bhi(raw[i].x) * r * gs0[1]; f[2] = blo(raw[i].y) * r * gs0[2]; f[3] = bhi(raw[i].y) * r * gs0[3];
        f[4] = blo(raw[i].z) * r * gs1[0]; f[5] = bhi(raw[i].z) * r * gs1[1]; f[6] = blo(raw[i].w) * r * gs1[2]; f[7] = bhi(raw[i].w) * r * gs1[3];
#pragma unroll
        for (int e = 0; e < 8; ++e) *(LAS bf16_t*)(VTw + (8 * c8 + e) * SG_VS + t * 2) = f2bf(f[e]); }
    __syncthreads();
    const bf16_t* Wg = Wsp + (size_t)g * 128 * 128;
    unsigned res[4][16];
#pragma unroll
    for (int tb = 0; tb < 4; ++tb) {
        f32x16 a0, a1;
#pragma unroll
        for (int i = 0; i < 16; ++i) { a0[i] = 0.f; a1[i] = 0.f; }
        const int nks = 2 * (tb + 1);
        bf16x8 Af[8];
#pragma unroll
        for (int ks = 0; ks < 8; ++ks) if (ks < nks) Af[ks] = *(const bf16x8*)(Wg + (32 * tb + r32) * 128 + 16 * ks + 8 * hi);
#pragma unroll
        for (int ks = 0; ks < 8; ++ks) { if (ks >= nks) break;
            const bf16x8 A = Af[ks];
            const bf16x8 B0 = *(const LAS bf16x8*)(VTw + r32 * SG_VS + (16 * ks + 8 * hi) * 2), B1 = *(const LAS bf16x8*)(VTw + (32 + r32) * SG_VS + (16 * ks + 8 * hi) * 2);
            a0 = MFMA32(A, B0, a0); a1 = MFMA32(A, B1, a1);
        }
        float bsv[16];
#pragma unroll
        for (int i = 0; i < 16; ++i) bsv[i] = bsp[g * 128 + 32 * tb + crow(i, hi)];
#pragma unroll
        for (int i = 0; i < 16; ++i) res[tb][i] = pk2(a0[i] + bsv[i], a1[i] + bsv[i]);
    }
    v4u ur[16];
#pragma unroll
    for (int i = 0; i < 16; ++i) ur[i] = *(const v4u*)(SUV + (row0 + 16 * g + i) * 1024 + 8 * lane);
    __syncthreads();
#pragma unroll
    for (int tb = 0; tb < 4; ++tb)
#pragma unroll
        for (int i = 0; i < 16; ++i) { const int t = 32 * tb + crow(i, hi);
            *(LAS bf16_t*)(lds + t * 1040 + (g * 64 + r32) * 2) = (bf16_t)(res[tb][i] & 0xffffu); *(LAS bf16_t*)(lds + t * 1040 + (g * 64 + 32 + r32) * 2) = (bf16_t)(res[tb][i] >> 16); }
    __syncthreads();
#pragma unroll
    for (int hb = 0; hb < 2; ++hb) { float f[8][8];
#pragma unroll
        for (int i = 0; i < 8; ++i) { const int t = 16 * g + 8 * hb + i; const v4u v = *(const LAS v4u*)(lds + t * 1040 + lane * 16); const v4u u = ur[8 * hb + i];
            f[i][0] = blo(v.x) * blo(u.x); f[i][1] = bhi(v.x) * bhi(u.x); f[i][2] = blo(v.y) * blo(u.y); f[i][3] = bhi(v.y) * bhi(u.y);
            f[i][4] = blo(v.z) * blo(u.z); f[i][5] = bhi(v.z) * bhi(u.z); f[i][6] = blo(v.w) * blo(u.w); f[i][7] = bhi(v.w) * bhi(u.w); }
        quant_store8(f, O, Osc, row0, 16 * g + 8 * hb, 1, lane); }
    __syncthreads();
}

constexpr int CP_RS = 1040, CP_PS = 98304;
__device__ __forceinline__ void conv_load(int tile, const bf16_t* CY, int tid, v4u (&st)[12]) {
    const size_t row0 = (size_t)tile * 64; const int t0 = (tile * 64) % SEQ;
#pragma unroll
    for (int i = 0; i < 12; ++i) { const int idx = tid + 512 * i, r = idx >> 6, ch = idx & 63; int rr = idx < 94 * 64 ? r : 93; rr = rr < 30 - t0 ? 30 - t0 : rr;
        st[i] = *(const v4u*)(CY + (row0 - 30 + rr) * 512 + 8 * ch); }
}
__device__ __forceinline__ void conv_stage(LAS unsigned char* lds, int tile, int tid, const v4u (&st)[12]) {
    const int t0 = (tile * 64) % SEQ;
#pragma unroll
    for (int i = 0; i < 12; ++i) { const int idx = tid + 512 * i, r = idx >> 6, ch = idx & 63; const unsigned mk = (t0 - 30 + r >= 0) ? 0xffffffffu : 0u;
        if (idx < 94 * 64) *(LAS v4u*)(lds + r * CP_RS + ch * 16) = (v4u){st[i].x & mk, st[i].y & mk, st[i].z & mk, st[i].w & mk}; }
}
__device__ __forceinline__ void conv_main(LAS unsigned char* lds, int tile, const float (&w)[31], float bias, const float* gcv, unsigned char* Oc, float* Osc, int tid) {
    const size_t row0 = (size_t)tile * 64;
#pragma unroll 1
    for (int tg = 0; tg < 8; ++tg) {
        float z8[8];
#pragma unroll
        for (int t = 0; t < 8; ++t) z8[t] = bias;
        const LAS unsigned char* col = lds + (8 * tg) * CP_RS + tid * 2;
        float yv[38];
#pragma unroll
        for (int i = 0; i < 38; ++i) yv[i] = bf1(*(const LAS bf16_t*)(col + i * CP_RS));
#pragma unroll
        for (int t = 0; t < 8; ++t)
#pragma unroll
            for (int j = 0; j < 31; ++j) z8[t] = __builtin_fmaf(w[j], yv[t + j], z8[t]);
#pragma unroll
        for (int t = 0; t < 8; ++t) *(LAS bf16_t*)(lds + (8 * tg + t) * CP_RS + tid * 2) = f2bf(z8[t]);
    }
    __syncthreads();
    {
        const int ch8 = tid & 63, tr = tid >> 6;
        const f32x4 g0 = *(const f32x4*)(gcv + 8 * ch8), g1 = *(const f32x4*)(gcv + 8 * ch8 + 4);
        v4u v[8]; float ss[8];
#pragma unroll
        for (int i = 0; i < 8; ++i) { v[i] = *(const LAS v4u*)(lds + (tr + 8 * i) * CP_RS + ch8 * 16); ss[i] = 0.f;
#pragma unroll
            for (int e = 0; e < 4; ++e) { const float a = blo(v[i][e]), c = bhi(v[i][e]); ss[i] += a * a + c * c; } }
#pragma unroll
        for (int o = 1; o < 64; o <<= 1)
#pragma unroll
            for (int i = 0; i < 8; ++i) ss[i] += __shfl_xor(ss[i], o);
        float f[8][8];
#pragma unroll
        for (int i = 0; i < 8; ++i) { const float r = __builtin_amdgcn_rsqf(ss[i] * (1.0f / 512.0f) + EPS);
            f[i][0] = blo(v[i].x) * r * g0[0]; f[i][1] = bhi(v[i].x) * r * g0[1]; f[i][2] = blo(v[i].y) * r * g0[2]; f[i][3] = bhi(v[i].y) * r * g0[3];
            f[i][4] = blo(v[i].z) * r * g1[0]; f[i][5] = bhi(v[i].z) * r * g1[1]; f[i][6] = blo(v[i].w) * r * g1[2]; f[i][7] = bhi(v[i].w) * r * g1[3];
#pragma unroll
            for (int e = 0; e < 8; ++e) f[i][e] *= sigm(f[i][e]); }
        quant_store8(f, Oc, Osc, row0, tr, 8, ch8);
    }
    __syncthreads();
}
__device__ __forceinline__ void pool_load(int tile, const bf16_t* PIN, int tid, v4u (&st)[10]) {
    const size_t row0 = (size_t)tile * 64; const int t0 = (tile * 64) % SEQ;
#pragma unroll
    for (int i = 0; i < 10; ++i) { const int idx = tid + 512 * i, r = idx >> 6, ch = idx & 63; const int tt = t0 - 15 + r;
        const bool ok = idx < 79 * 64 && tt >= 0;
        const unsigned mk = ok ? 0xffffffffu : 0u; const v4u x = *(const v4u*)(PIN + (ok ? (row0 - 15 + r) * 512 + 8 * ch : (size_t)0)); st[i] = (v4u){x.x & mk, x.y & mk, x.z & mk, x.w & mk}; }
}
__device__ __forceinline__ void pool_stage(LAS unsigned char* lds, int tid, const v4u (&st)[10]) {
#pragma unroll
    for (int i = 0; i < 10; ++i) { const int idx = tid + 512 * i, r = idx >> 6, ch = idx & 63; if (idx < 79 * 64) *(LAS v4u*)(lds + r * CP_RS + ch * 16) = st[i]; }
}
__device__ __forceinline__ void pool_sums(LAS unsigned char* lds, int tile, int tid) {
    const int wave = __builtin_amdgcn_readfirstlane(tid >> 6);
    const int t0 = (tile * 64) % SEQ;
    {
        float pv[79];
#pragma unroll
        for (int i = 0; i < 79; ++i) pv[i] = bf1(*(const LAS bf16_t*)(lds + i * CP_RS + tid * 2));
        const bool first = (t0 == 0);
        const int wsel = wave >> 1;
#define POOL_W(W) { _Pragma("unroll") for (int t = 0; t < 64; ++t) { float s = 0.f; _Pragma("unroll") for (int j = 0; j < W; ++j) s += pv[t + 15 - j]; \
            const float inv = first ? (1.0f / (float)((t + 1) < W ? (t + 1) : W)) : (1.0f / (float)W); \
            *(LAS bf16_t*)(lds + t * CP_RS + tid * 2) = f2bf(s * inv - pv[t + 15]); } }
        if (wsel == 0) POOL_W(2) else if (wsel == 1) POOL_W(4) else if (wsel == 2) POOL_W(8) else POOL_W(16)
#undef POOL_W
    }
    __syncthreads();
}
__device__ __forceinline__ void pool_main(LAS unsigned char* lds, int tile, const bf16_t* Wpg, const float* pls, int tid) {
    const int lane = tid & 63, wave = __builtin_amdgcn_readfirstlane(tid >> 6), r32 = lane & 31, hi = lane >> 5;
    const size_t row0 = (size_t)tile * 64;
    const int g = wave >> 1, nh = wave & 1;
    {
        f32x16 acc[2][2];
#pragma unroll
        for (int a = 0; a < 2; ++a)
#pragma unroll
            for (int c = 0; c < 2; ++c)
#pragma unroll
                for (int i = 0; i < 16; ++i) acc[a][c][i] = 0.f;
#pragma unroll
        for (int kh = 0; kh < 2; ++kh) {
            bf16x8 Bw[4][2];
#pragma unroll
            for (int k4 = 0; k4 < 4; ++k4) { const int ks = 4 * kh + k4; Bw[k4][0] = *(const bf16x8*)(Wpg + ((size_t)g * 128 + 64 * nh + r32) * 128 + 16 * ks + 8 * hi); Bw[k4][1] = *(const bf16x8*)(Wpg + ((size_t)g * 128 + 64 * nh + 32 + r32) * 128 + 16 * ks + 8 * hi); }
#pragma unroll
            for (int k4 = 0; k4 < 4; ++k4) { const int ks = 4 * kh + k4;
                const bf16x8 A0 = *(const LAS bf16x8*)(lds + r32 * CP_RS + (g * 128 + 16 * ks + 8 * hi) * 2), A1 = *(const LAS bf16x8*)(lds + (32 + r32) * CP_RS + (g * 128 + 16 * ks + 8 * hi) * 2);
                acc[0][0] = MFMA32(A0, Bw[k4][0], acc[0][0]); acc[0][1] = MFMA32(A0, Bw[k4][1], acc[0][1]); acc[1][0] = MFMA32(A1, Bw[k4][0], acc[1][0]); acc[1][1] = MFMA32(A1, Bw[k4][1], acc[1][1]); }
        }
        __syncthreads();
#pragma unroll
        for (int ct = 0; ct < 2; ++ct) { const int col = g * 128 + 64 * nh + 32 * ct + r32; const float sc = pls[col];
#pragma unroll
            for (int rt = 0; rt < 2; ++rt)
#pragma unroll
                for (int i = 0; i < 16; ++i) *(LAS bf16_t*)(lds + (32 * rt + crow(i, hi)) * CP_RS + col * 2) = f2bf(acc[rt][ct][i] * sc); }
    }
    __syncthreads();
}
__device__ __forceinline__ void pool_out(LAS unsigned char* lds, int tile, unsigned char* Op, float* Osc, int tid) {
    const size_t row0 = (size_t)tile * 64;
    {
        const int ch8 = tid & 63, tr = tid >> 6;
        float f[8][8];
#pragma unroll
        for (int i = 0; i < 8; ++i) { const v4u v = *(const LAS v4u*)(lds + (tr + 8 * i) * CP_RS + ch8 * 16);
            f[i][0] = blo(v.x); f[i][1] = bhi(v.x); f[i][2] = blo(v.y); f[i][3] = bhi(v.y); f[i][4] = blo(v.z); f[i][5] = bhi(v.z); f[i][6] = blo(v.w); f[i][7] = bhi(v.w); }
        quant_store8(f, Op, Osc, row0, tr, 8, ch8);
    }
    __syncthreads();
}

__device__ __forceinline__ void moe_offsets(const gu32* cnt, int (&pstart)[8], int (&tend)[8], int& T) {
    int acc = 0;
#pragma unroll
    for (int e = 0; e < 8; ++e) { const int c = (int)__hip_atomic_load(cnt + 64 * e, RLX_AGENT); pstart[e] = acc; acc += (c + 255) & ~255; tend[e] = acc >> 8; }
    T = acc >> 8;
}
__device__ __forceinline__ void moe_scatter(const gu32* cnt, const int* ASG, const bf16_t* H, bf16_t* XS, int* RINFO, const float* HSrc, float* XSS, int gw, int NGW, int lane, int tid, int blk, int nblk, bool f8) {
    int pstart[8], tend[8], T; moe_offsets(cnt, pstart, tend, T);
    for (int e = blk; e < 8; e += nblk) { const int c = (int)__hip_atomic_load(cnt + 64 * e, RLX_AGENT); const int pe = (c + 255) & ~255;
        int m1_ = -1; asm volatile("" : "+v"(m1_));
        for (int r = c + tid; r < pe; r += 512) { RINFO[2 * (size_t)(pstart[e] + r)] = m1_; RINFO[2 * (size_t)(pstart[e] + r) + 1] = 0; } }
    for (int a0 = gw; a0 < NTOK * 2; a0 += 4 * NGW) {
        int w0[4], gb[4]; size_t dest[4]; v4u r0[4], r1[4]; float rsq[4];
#pragma unroll
        for (int q = 0; q < 4; ++q) { const int a = a0 + q * NGW; w0[q] = 0; gb[q] = 0; rsq[q] = 0.f; if (a < NTOK * 2) { w0[q] = ASG[2 * (size_t)a]; gb[q] = ASG[2 * (size_t)a + 1]; rsq[q] = HSrc[a >> 1]; } }
#pragma unroll
        for (int q = 0; q < 4; ++q) { const int a = a0 + q * NGW; const int e = w0[q] >> 24, pos = w0[q] & 0xffffff; int ps = 0;
#pragma unroll
            for (int k = 0; k < 8; ++k) ps = (e == k) ? pstart[k] : ps;
            dest[q] = (size_t)(ps + pos); r0[q] = (v4u){0u, 0u, 0u, 0u}; r1[q] = r0[q];
            if (a < NTOK * 2) {
                if (f8) r0[q] = ((const v4u*)((const unsigned char*)H + (size_t)(a >> 1) * DM))[lane];
                else { const v4u* src = (const v4u*)(H + (size_t)(a >> 1) * DM); r0[q] = src[lane]; r1[q] = src[64 + lane]; } } }
#pragma unroll
        for (int q = 0; q < 4; ++q) { const int a = a0 + q * NGW; if (a < NTOK * 2) {
            if (lane == 0) { RINFO[2 * dest[q]] = a; RINFO[2 * dest[q] + 1] = gb[q]; XSS[dest[q]] = rsq[q]; }
            if (f8) ((v4u*)((unsigned char*)XS + dest[q] * DM))[lane] = r0[q];
            else { v4u* dst = (v4u*)(XS + dest[q] * DM); dst[lane] = r0[q]; dst[64 + lane] = r1[q]; } } }
    }
}
__device__ __forceinline__ void final_combine(float* out, const bf16_t* xb, const bf16_t* Y, int gw, int NGW, int lane) {
    v2u xn[4], an[4], bn[4];
    if (gw < NTOK) {
#pragma unroll
        for (int jj = 0; jj < 4; ++jj) { xn[jj] = ((const v2u*)(xb + (size_t)gw * DM))[64 * jj + lane]; an[jj] = ((const v2u*)(Y + (size_t)gw * DM))[64 * jj + lane]; bn[jj] = ((const v2u*)(Y + ((size_t)NTOK + gw) * DM))[64 * jj + lane]; }
    }
    for (int row = gw; row < NTOK; row += NGW) {
        v2u x[4], a[4], b[4];
#pragma unroll
        for (int jj = 0; jj < 4; ++jj) { x[jj] = xn[jj]; a[jj] = an[jj]; b[jj] = bn[jj]; }
        const int nr = row + NGW;
        if (nr < NTOK) {
#pragma unroll
            for (int jj = 0; jj < 4; ++jj) { xn[jj] = ((const v2u*)(xb + (size_t)nr * DM))[64 * jj + lane]; an[jj] = ((const v2u*)(Y + (size_t)nr * DM))[64 * jj + lane]; bn[jj] = ((const v2u*)(Y + ((size_t)NTOK + nr) * DM))[64 * jj + lane]; }
        }
#pragma unroll
        for (int jj = 0; jj < 4; ++jj) { f32x4 v;
            v[0] = blo(x[jj].x) + blo(a[jj].x) + blo(b[jj].x); v[1] = bhi(x[jj].x) + bhi(a[jj].x) + bhi(b[jj].x); v[2] = blo(x[jj].y) + blo(a[jj].y) + blo(b[jj].y); v[3] = bhi(x[jj].y) + bhi(a[jj].y) + bhi(b[jj].y);
            ((f32x4*)(out + (size_t)row * DM))[64 * jj + lane] = v; }
    }
}
#define XB_TMO      128
#define XB_XCNT(j)  (256  + 64 * (j))
#define XB_XSUB(j)  (1280 + 64 * (j))
#define XB_XGEN(j)  (2304 + 64 * (j))
#define XB_TOP      3328
#define XB_TOPGEN   3392
#define XCD_BAR_WORDS 3456
#define XB_SPIN_CAP (1u << 18)

__device__ __forceinline__ unsigned xb_ld(unsigned* p)              { return __hip_atomic_load(p, __ATOMIC_RELAXED, __HIP_MEMORY_SCOPE_AGENT); }
__device__ __forceinline__ unsigned xb_add(unsigned* p, unsigned v) { return __hip_atomic_fetch_add(p, v, __ATOMIC_RELAXED, __HIP_MEMORY_SCOPE_AGENT); }
__device__ __forceinline__ unsigned xb_xcc_id() { return (unsigned)__builtin_amdgcn_s_getreg((3 << 11) | 20) & 0xFu; }
#define XB_SPIN(cond, bar) do { unsigned _sp = 0; while (cond) { __builtin_amdgcn_s_sleep(1); \
    if ((++_sp & 255u) == 0u) { if (xb_ld(&(bar)[XB_TMO])) break; if (_sp > XB_SPIN_CAP) { atomicAdd(&(bar)[XB_TMO], 1u); break; } } } } while (0)

struct XcdBarrier {
    unsigned* bar; unsigned x;
    volatile LAS unsigned* st;
};

__device__ __forceinline__ XcdBarrier xcd_barrier_post(unsigned* bar, volatile LAS unsigned* st) {
    XcdBarrier b; b.bar = bar; b.x = xb_xcc_id(); b.st = st;
    if (threadIdx.x == 0) (void)xb_add(&bar[XB_XCNT(b.x)], 1u);
    return b;
}
__device__ __forceinline__ void xcd_barrier_complete(unsigned* bar, unsigned x, unsigned& nloc, unsigned& nx) {
    const unsigned G = gridDim.x * gridDim.y * gridDim.z;
    unsigned sum, cnt, mine, sp = 0u;
    for (;;) {
        sum = 0u; cnt = 0u; mine = 0u;
#pragma unroll
        for (unsigned j = 0; j < 16; ++j) { const unsigned c = xb_ld(&bar[XB_XCNT(j)]); sum += c; cnt += (c > 0u) ? 1u : 0u; mine = (j == x) ? c : mine; }
        if (sum == G) break;
        __builtin_amdgcn_s_sleep(1);
        if ((++sp & 255u) == 0u) { if (xb_ld(&bar[XB_TMO])) break; if (sp > XB_SPIN_CAP) { atomicAdd(&bar[XB_TMO], 1u); break; } }
    }
    nloc = mine > 0u ? mine : 1u; nx = cnt > 0u ? cnt : 1u;
}

__device__ __forceinline__ void xcd_barrier(const XcdBarrier& b) {
    asm volatile("s_waitcnt vmcnt(0)" ::: "memory");
    __syncthreads();
    if (threadIdx.x == 0) {
        unsigned* bar = b.bar;
        __builtin_amdgcn_s_waitcnt(0);
        unsigned nloc = b.st[0], nx = b.st[1];
        if (nloc == 0u) { xcd_barrier_complete(bar, b.x, nloc, nx); b.st[0] = nloc; b.st[1] = nx; }
        const unsigned old = xb_add(&bar[XB_XSUB(b.x)], 1u);
        const unsigned gen = old / nloc;
        if (old + 1u == (gen + 1u) * nloc) {
            __builtin_amdgcn_fence(__ATOMIC_RELEASE, "agent");
            asm volatile("s_waitcnt vmcnt(0)" ::: "memory");
            const unsigned og = xb_add(&bar[XB_TOP], 1u);
            const unsigned tg = og / nx;
            if (og + 1u == (tg + 1u) * nx) xb_add(&bar[XB_TOPGEN], 1u);
            else XB_SPIN(xb_ld(&bar[XB_TOPGEN]) == tg, bar);
            __builtin_amdgcn_fence(__ATOMIC_ACQUIRE, "agent");
            xb_add(&bar[XB_XGEN(b.x)], 1u);
            asm volatile("s_waitcnt vmcnt(0)" ::: "memory");
        } else {
            XB_SPIN(xb_ld(&bar[XB_XGEN(b.x)]) == gen, bar);
            __builtin_amdgcn_fence(__ATOMIC_ACQUIRE, "agent");
            asm volatile("s_waitcnt vmcnt(0)" ::: "memory");
        }
    }
    __syncthreads();
}


struct Args {
    const float* in[25]; float* out; unsigned char* ws; int pad0, pad1;
};
typedef const Args __attribute__((address_space(4)))* KArgs;
enum { I_X = 0, I_GMIX, I_WIN, I_BF, I_GQ, I_GK, I_GSGU, I_WSP, I_BSP, I_WDW, I_BDW, I_GCONV, I_WPOOL, I_PSCALE, I_WBR, I_BGATE, I_WOUT, I_GFFN,
       I_WFG, I_WFU, I_WFD, I_WROUTER, I_WEG, I_WEU, I_WED };
__device__ __forceinline__ int opaque_v(int v) { asm volatile("" : "+v"(v)); return v; }
__device__ __forceinline__ KArgs kargs() { KArgs p = (KArgs)__builtin_amdgcn_kernarg_segment_ptr(); asm volatile("" : "+s"(p)); return p; }

#ifndef F8_MASK
#define F8_MASK 0xE
#endif
constexpr float WBS = 704.0f;
constexpr float WI8S = 1024.0f;
constexpr float W8S_UP = 32.0f, W8S_DN = 64.0f;
static_assert((F8_MASK & 0xA) == 0xA, "the MoE layers' FFN weights are stored as fp8");
#ifndef MK_ATTN2
#define MK_ATTN2 1
#endif
#ifndef MK_MERGE_N1
#define MK_MERGE_N1 1
#endif
#ifndef MK_ONLY
#define MK_ONLY -1
#endif
#define PH(n) (MK_ONLY < 0 || MK_ONLY == (n))
#ifndef MK_DUP
#define MK_DUP -1
#endif
#ifndef MK_TIME_MASK
#define MK_TIME_MASK 0
#endif
#define T_BEGIN(n) cur_ph = (n); unsigned long long tb_ = 0; if ((MK_TIME_MASK >> (n)) & 1) tb_ = __builtin_amdgcn_s_memrealtime();
#define T_END(n) if ((MK_TIME_MASK >> (n)) & 1) { const unsigned long long te_ = __builtin_amdgcn_s_memrealtime(), dt_ = te_ - tb_; while (__builtin_amdgcn_s_memrealtime() - te_ < dt_) __builtin_amdgcn_s_sleep(4); }
#define DUP(n) for (int rep_ = 0; rep_ < ((MK_DUP == (n)) ? 2 : 1); ++rep_)

#define FFN_PREP() do { KArgs ka = kargs(); unsigned char* ws = ka->ws; const int lane = opaque_v(TIDR) & 63; int f8i_ = ((F8_MASK >> l) | l) & 1; asm volatile("" : "+s"(f8i_)); const bool f8l_ = f8i_ != 0;        \
        if (!moe) ffn_prep(false, f8l_, ka->in[I_WFG] + (size_t)fi * DM * FFD, ka->in[I_WFU] + (size_t)fi * DM * FFD, ka->in[I_WFD] + (size_t)fi * FFD * DM, ws + WF_GU, ws + WF_D_DENSE, scr, gw, NGW, lane); \
        else ffn_prep(true, true, ka->in[I_WEG] + (size_t)fi * NEXP * DM * FFE, ka->in[I_WEU] + (size_t)fi * NEXP * DM * FFE, ka->in[I_WED] + (size_t)fi * NEXP * FFE * DM, ws + WF_GU, ws + WF_D_MOE, scr, gw, NGW, lane); \
        __syncthreads(); } while (0)
#define TIDR (wave * 64 + lane_id_v())
__global__ void __launch_bounds__(NWAVES * 64, 2) fwd_kernel(Args args_unused) {
    extern __shared__ __attribute__((aligned(16))) unsigned char lds_raw[];
    LAS unsigned char* lds = (LAS unsigned char*)lds_raw;
    const int tid = threadIdx.x, lane = tid & 63, wave = __builtin_amdgcn_readfirstlane(tid >> 6);
    const int G = gridDim.x, bx = blockIdx.x;
    const int gw = bx * NWAVES + wave, NGW = G * NWAVES;
    const int vcu = (G % 8 == 0) ? (bx % 8) * (G / 8) + bx / 8 : bx;
    volatile LAS unsigned* MISC = (volatile LAS unsigned*)(lds + MISC_OFF);
    for (int u = tid; u < 64; u += NWAVES * 64) ((LAS unsigned*)(lds + MISC_OFF))[u] = 0u;
    __syncthreads();
    XcdBarrier bar;
    { KArgs ka = kargs(); bar = xcd_barrier_post((unsigned*)(ka->ws + WS_CTL) + CW_BAR, MISC + 8); }
#ifndef MK_SKEW_WG
#define MK_SKEW_WG -1
#endif
#ifndef MK_SKEW_MASK
#define MK_SKEW_MASK 0xFFFF
#endif
#define GRID_BAR() do { unsigned long long tw0_ = 0; if (MK_SKEW_WG >= 0) tw0_ = __builtin_amdgcn_s_memrealtime(); GRID_BAR0(); if (MK_SKEW_WG >= 0 && ((MK_SKEW_MASK >> cur_ph) & 1)) skew_acc += __builtin_amdgcn_s_memrealtime() - tw0_; } while (0)
#define GRID_BAR0() do { XcdBarrier b_ = bar; asm volatile("" : "+s"(b_.bar), "+s"(b_.x)); xcd_barrier(b_); } while (0)
    LAS float* scr = (LAS float*)(lds + wave * 16384);
    int cur_ph = 0; unsigned long long skew_acc = 0;

    for (int l = 0; l < NLAYER; ++l) {
        const bool moe = (l & 1) != 0; const int fi = l >> 1;
        const bool f8 = moe ? true : (((F8_MASK >> l) & 1) != 0);
        { T_BEGIN(1)
        if (PH(1)) {
            KArgs ka = kargs(); unsigned char* ws = ka->ws; bf16_t* xout = (bf16_t*)(ws + WS_XB); const int lane = opaque_v(TIDR) & 63;
            unsigned char* Wproj8 = ws + WM_PROJ;
            int off = 0;
            const float* win = ka->in[I_WIN] + (size_t)l * DM * INW;
            DUP(12) {
            tr_segment8<true>(win, INW, DM, C_Q, 512, Wproj8, 0, -1, WI8S, scr, gw, NGW, lane, off);
            tr_segment8<true>(win, INW, DM, C_K, 512, Wproj8, 512, -1, WI8S, scr, gw, NGW, lane, off);
            tr_segment8<true>(win, INW, DM, C_V, 512, ws + WM_V, 0, 0, WI8S, scr, gw, NGW, lane, off);
            tr_segment8<true>(win, INW, DM, C_SU, 1024, Wproj8, 1024, 0, WI8S, scr, gw, NGW, lane, off);
            tr_segment8<true>(win, INW, DM, C_CONV, 512, Wproj8, 2048, 128, WI8S, scr, gw, NGW, lane, off);
            tr_segment8<true>(win, INW, DM, C_CONV + 512, 512, Wproj8, 2048 + 128, 128, WI8S, scr, gw, NGW, lane, off);
            tr_segment8<true>(win, INW, DM, C_POOL, 512, Wproj8, 3072, 0, WI8S, scr, gw, NGW, lane, off);
            tr_segment8<true>(win, INW, DM, C_GATE, 4096, ws + WM_G8, 0, 0, WI8S, scr, gw, NGW, lane, off);
            for (int i = 0; i < 4; ++i) tr_segment8<true>(ka->in[I_WBR] + ((size_t)l * 4 + i) * 512 * 1024, 1024, 512, 0, 1024, ws + WM_B + (size_t)i * 1024 * 512, 0, 0, WBS, scr, gw, NGW, lane, off);
            tr_segment(ka->in[I_WOUT] + (size_t)l * 1024 * 1024, 1024, 1024, 0, 1024, (bf16_t*)(ws + WM_OUT), 0, 0, scr, gw, NGW, lane, off);
            for (int g = 0; g < 4; ++g) tr_segment(ka->in[I_WPOOL] + ((size_t)l * 4 + g) * 128 * 128, 128, 128, 0, 128, (bf16_t*)(ws + WM_PG) + (size_t)g * 128 * 128, 0, 0, scr, gw, NGW, lane, off);
            { const float* wsp = ka->in[I_WSP] + (size_t)l * 8 * 128 * 128; bf16_t* Wsp = (bf16_t*)(ws + WM_SP);
              for (int i = bx * 512 + opaque_v(TIDR); i < 8 * 128 * 128; i += G * 512) { const int t = (i >> 7) & 127, s = i & 127; Wsp[i] = (s <= t) ? f2bf(wsp[i]) : (bf16_t)0; } }
            }
            const float* xin32 = (l == 0) ? ka->in[I_X] : nullptr;
            const bf16_t* yc = (l > 0 && ((l - 1) & 1)) ? (const bf16_t*)(ws + WS_XS) : nullptr;
            for (int rep_ = 0; rep_ < ((MK_DUP == 13 && yc == nullptr) ? 2 : 1); ++rep_) norm_rows<0>(xin32, xout, xout, yc != nullptr, yc, ka->in[I_GMIX] + l * DM, nullptr, ws + WS_H8, (float*)(ws + WS_HS), win + C_F, INW, ka->in[I_BF] + l * 8, (float*)(ws + WS_LF), nullptr, nullptr, gw, NGW, lane);
        }
        GRID_BAR();
        T_END(1) }
        { T_BEGIN(2)
        DUP(2) if (PH(2)) {
            KArgs ka = kargs(); unsigned char* ws = ka->ws;
            pg8::Gemm g{(bf16_t*)(ws + WS_H8), (bf16_t*)(ws + WM_PROJ), NTOK, NPROJ, DM / 2}; pg8::StaticOrder S; S.init(NTOK, NPROJ, G, bx);
            pg8::EpiProjI8 E{ws, WS_Q, WS_K, WS_SUV, WS_CY, WS_PIN, ka->in[I_GQ] + l * 64, ka->in[I_GK] + l * 64, (const float*)(ws + WS_HS), 1.0f / WI8S};
            pg8::gemm_phase<pg8::EpiProjI8, pg8::StaticOrder, true, true, false, true, ZC_PROJ>(lds, g, S, E, wave);
        }
        DUP(16) if (PH(2)) {
            KArgs ka = kargs(); unsigned char* ws = ka->ws;
            pg8::Gemm g{(bf16_t*)(ws + WS_H8), (bf16_t*)(ws + WM_G8), NTOK, 4096, DM / 2}; pg8::StaticOrder S; S.init(NTOK, 4096, G, bx);
            pg8::EpiGateI8 E{ws + WS_G, ka->in[I_BGATE] + (size_t)l * 4096, (const float*)(ws + WS_HS), 1.0f / WI8S};
            pg8::gemm_phase<pg8::EpiGateI8, pg8::StaticOrder, true, true, false, true, ZC_GATE>(lds, g, S, E, wave);
        }
        DUP(2) if (PH(2)) {
            KArgs ka = kargs(); unsigned char* ws = ka->ws;
            pg8::Gemm g2{(bf16_t*)(ws + WM_V), (bf16_t*)(ws + WS_H8), 512, NTOK, DM / 2}; pg8::StaticOrder S2; S2.init(512, NTOK, G, bx);
            pg8::EpiVtI8 E2{(bf16_t*)(ws + WS_VT), NTOK, (const float*)(ws + WS_HS), 1.0f / WI8S, (int)__builtin_offsetof(Args, ws), (int)(WS_CTL + (CW_VMAX + 16 * l) * 4)};
            pg8::gemm_phase<pg8::EpiVtI8, pg8::StaticOrder, true, true, false, true>(lds, g2, S2, E2, wave);
        }
        GRID_BAR();
        T_END(2) }
        { T_BEGIN(3)
        DUP(3) if (PH(3)) {
            if (bx & 1) { FFN_PREP(); if (MK_DUP == 17) FFN_PREP(); }
#ifndef MK_NO_ATTN
#if MK_ATTN2
            DUP(31) for (int i = 0;; ++i) {
                int bh, qb;
                if (G == 256) { if (i >= 2) break; bh = bx >> 1; const int s = (bx & 1); qb = (i == 0) ? s : 3 - s; }
                else { const int u = i * G + bx; if (u >= 512) break; bh = u >> 2; qb = u & 3; }
                KArgs ka = kargs(); unsigned char* ws = ka->ws;
                attn_unit2(lds, bh >> 3, bh & 7, qb, (const bf16_t*)(ws + WS_Q), (const bf16_t*)(ws + WS_K), (const bf16_t*)(ws + WS_VT), (const float*)(ws + WS_LF), ka->in[I_GQ] + l * 64, ka->in[I_GK] + l * 64, ws + WS_YS, (float*)(ws + WS_YSC), (const unsigned*)(ws + WS_CTL) + CW_VMAX + 16 * l + (bh >> 3), opaque_v(TIDR));
            }
#else
            DUP(31) for (int i = 0;; ++i) {
                int bh, qb;
                if (G == 256) { if (i >= 4) break; bh = bx >> 1; const int s = (bx & 1); qb = (i == 0) ? s : (i == 1) ? 7 - s : (i == 2) ? 2 + s : 5 - s; }
                else { const int u = i * G + bx; if (u >= 1024) break; bh = u >> 3; qb = u & 7; }
                KArgs ka = kargs(); unsigned char* ws = ka->ws;
                attn_unit(lds, bh >> 3, bh & 7, qb, (const bf16_t*)(ws + WS_Q), (const bf16_t*)(ws + WS_K), (const bf16_t*)(ws + WS_VT), (const float*)(ws + WS_LF),
                          ka->in[I_GQ] + l * 64, ka->in[I_GK] + l * 64, (bf16_t*)(ws + WS_YS), opaque_v(TIDR));
            }
#endif
#endif
#ifndef MK_NO_SGU
            DUP(32) for (int c = bx; c < 256; c += G) {
                KArgs ka = kargs(); unsigned char* ws = ka->ws;
                sgu_unit(lds, c, (const bf16_t*)(ws + WS_SUV), ka->in[I_GSGU] + l * 512, (const bf16_t*)(ws + WM_SP), ka->in[I_BSP] + l * 8 * 128, ws + WS_YS + (size_t)NTOK * 512, (float*)(ws + WS_YSC) + NTOK, opaque_v(TIDR));
            }
#endif
#ifndef MK_NO_CONV
            DUP(33) if (bx < 512) {
                                v4u pst[10], cst[12];
                int t = bx;
                { KArgs ka = kargs(); conv_load(t, (const bf16_t*)(ka->ws + WS_CY), opaque_v(TIDR), cst); }
                for (;;) {
                    float w[31]; float bias;
                    { KArgs ka = kargs(); const float* wdw = ka->in[I_WDW] + (size_t)l * 31 * 512; const int tq_ = opaque_v(TIDR);
#pragma unroll
                      for (int j = 0; j < 31; ++j) w[j] = wdw[j * 512 + tq_];
                      bias = ka->in[I_BDW][l * 512 + tq_]; }
                    conv_stage(lds, t, opaque_v(TIDR), cst); __syncthreads();
                    { KArgs ka = kargs(); pool_load(t, (const bf16_t*)(ka->ws + WS_PIN), opaque_v(TIDR), pst); }
                    { KArgs ka = kargs(); unsigned char* ws = ka->ws; conv_main(lds, t, w, bias, ka->in[I_GCONV] + l * 512, ws + WS_YS + (size_t)2 * NTOK * 512, (float*)(ws + WS_YSC) + 2 * NTOK, opaque_v(TIDR)); }
                    pool_stage(lds, opaque_v(TIDR), pst); __syncthreads();
                    pool_sums(lds, t, opaque_v(TIDR));
                    const int tn = t + G;
                    { KArgs ka = kargs(); pool_main(lds, t, (const bf16_t*)(ka->ws + WM_PG), ka->in[I_PSCALE] + l * 512, opaque_v(TIDR)); }
                    if (tn < 512) { KArgs ka = kargs(); conv_load(tn, (const bf16_t*)(ka->ws + WS_CY), opaque_v(TIDR), cst); }
                    { KArgs ka = kargs(); unsigned char* ws = ka->ws; pool_out(lds, t, ws + WS_YS + (size_t)3 * NTOK * 512, (float*)(ws + WS_YSC) + 3 * NTOK, opaque_v(TIDR)); }
                    if (tn >= 512) break;
                    t = tn;
                }
            }
#endif
            if (!(bx & 1)) { FFN_PREP(); if (MK_DUP == 17) FFN_PREP(); }
        }
        GRID_BAR();
        T_END(3) }
        { T_BEGIN(4)
        DUP(4) if (PH(4)) {
            KArgs ka = kargs(); unsigned char* ws = ka->ws;
            pg8::Gemm g{(bf16_t*)(ws + WS_YS), (bf16_t*)(ws + WM_B), 4 * NTOK, 4096, 256};
#if MK_MERGE_N1
            pg8::MergeOrder2 S{G, vcu};
            pg8::EpiMerge2 E{ws + WS_G, (bf16_t*)(ws + WS_MG), (const float*)(ws + WS_YSC), NTOK, 1.0f / (WBS * 255.0f)};
            pg8::gemm_phase_n1<pg8::EpiMerge2, pg8::MergeOrder2, true>(lds, g, S, E, wave);
#else
            pg8::MergeOrder S{G, vcu};
            pg8::EpiMerge E{(bf16_t*)(ws + WS_G), (bf16_t*)(ws + WS_MG)};
            pg8::gemm_phase<pg8::EpiMerge, pg8::MergeOrder, true, true>(lds, g, S, E, wave);
#endif
        }
        GRID_BAR();
        T_END(4) }
        { T_BEGIN(5)
        if (PH(5)) {
            KArgs ka = kargs(); unsigned char* ws = ka->ws; bf16_t* xout = (bf16_t*)(ws + WS_XB);
            pg8::Gemm g{(bf16_t*)(ws + WS_MG), (bf16_t*)(ws + WM_OUT), NTOK, DM, DM}; pg8::StaticOrder S; S.init(NTOK, DM, G, bx);
            pg8::EpiResid E{(l == 0) ? ka->in[I_X] : nullptr, xout, xout, 1.0f};
            pg8::gemm_phase<pg8::EpiResid, pg8::StaticOrder, true, true>(lds, g, S, E, wave);
        }
        GRID_BAR();
        T_END(5) }
        { T_BEGIN(6)
        if (PH(6)) {
            KArgs ka = kargs(); unsigned char* ws = ka->ws; bf16_t* xout = (bf16_t*)(ws + WS_XB); const int lane = opaque_v(TIDR) & 63;
            unsigned char* H8 = ws + WS_H; bf16_t* Hb = nullptr; float* HS2 = (float*)(ws + WS_HS2);
            DUP(15) if (!moe) norm_rows<1>(nullptr, xout, xout, false, nullptr, ka->in[I_GFFN] + l * DM, Hb, H8, HS2, nullptr, 0, nullptr, nullptr, nullptr, nullptr, gw, NGW, lane);
            else norm_rows<2>(nullptr, xout, xout, false, nullptr, ka->in[I_GFFN] + l * DM, Hb, H8, HS2, ka->in[I_WROUTER] + (size_t)fi * DM * 8, 8, nullptr, nullptr, (int*)(ws + WS_ASG),
                             (gu32*)(ws + WS_CTL) + CW_CNT + fi * 1024, gw, NGW, lane);
        }
        GRID_BAR();
        T_END(6) }
        if (!moe) {
        { T_BEGIN(7)
            DUP(7) if (PH(7)) {
                KArgs ka = kargs(); unsigned char* ws = ka->ws;
                {
                    pg8::Gemm g{(bf16_t*)(ws + WS_H), (bf16_t*)(ws + WF_GU), NTOK, 2 * FFD, DM / 2}; pg8::StaticOrder S; S.init(NTOK, 2 * FFD, G, bx);
                    pg8::EpiSwigluI8 E{f8 ? ws + WS_ACT : nullptr, (bf16_t*)(ws + WS_ACT), FFD, 2 * FFD / 256, (const float*)(ws + WS_HS2), 1.0f / WI8S};
                    pg8::gemm_phase<pg8::EpiSwigluI8, pg8::StaticOrder, true, true, false, true, true>(lds, g, S, E, wave);
                }
            }
            GRID_BAR();
        T_END(7) }
        { T_BEGIN(8)
            if (PH(8)) {
                KArgs ka = kargs(); unsigned char* ws = ka->ws; bf16_t* xout = (bf16_t*)(ws + WS_XB);
                if (!f8) {
                    pg8::Gemm g{(bf16_t*)(ws + WS_ACT), (bf16_t*)(ws + WF_D_DENSE), NTOK, DM, FFD}; pg8::StaticOrder S; S.init(NTOK, DM, G, bx);
                    pg8::EpiResid E{nullptr, xout, xout, 1.0f};
                    pg8::gemm_phase<pg8::EpiResid, pg8::StaticOrder, true, true>(lds, g, S, E, wave);
                } else {
                    pg8::Gemm g{(bf16_t*)(ws + WS_ACT), (bf16_t*)(ws + WF_D_DENSE), NTOK, DM, FFD / 2}; pg8::StaticOrder S; S.init(NTOK, DM, G, bx);
                    pg8::EpiResid E{nullptr, xout, xout, 1.0f / W8S_DN};
                    pg8::gemm_phase<pg8::EpiResid, pg8::StaticOrder, true, true, true>(lds, g, S, E, wave);
                }
            }
            GRID_BAR();
        T_END(8) }
        } else {
        { T_BEGIN(9)
            DUP(9) if (PH(9)) {
                KArgs ka = kargs(); unsigned char* ws = ka->ws;
                { const int t_ = opaque_v(TIDR); moe_scatter((gu32*)(ws + WS_CTL) + CW_CNT + fi * 1024, (const int*)(ws + WS_ASG), (const bf16_t*)(ws + WS_H), (bf16_t*)(ws + WS_XS), (int*)(ws + WS_RINFO), (const float*)(ws + WS_HS2), (float*)(ws + WS_XSS), gw, NGW, t_ & 63, t_, bx, G, true); }
            }
            GRID_BAR();
        T_END(9) }
        { T_BEGIN(10)
            DUP(10) if (PH(10)) {
                KArgs ka = kargs(); unsigned char* ws = ka->ws;
                pg8::GroupedOrder S; S.G = G; S.c = vcu; S.nct = 2 * FFE / 256; { int ps[8]; moe_offsets((gu32*)(ws + WS_CTL) + CW_CNT + fi * 1024, ps, S.tend, S.T); }
                {
                    pg8::Gemm g{(bf16_t*)(ws + WS_XS), (bf16_t*)(ws + WF_GU), PMAX, NEXP * 2 * FFE, DM / 2};
                    pg8::EpiSwigluI8 E{ws + WS_ACT, nullptr, FFE, 2 * FFE / 256, (const float*)(ws + WS_XSS), 1.0f / WI8S};
                    pg8::gemm_phase<pg8::EpiSwigluI8, pg8::GroupedOrder, true, true, false, true, true>(lds, g, S, E, wave);
                }
            }
            GRID_BAR();
        T_END(10) }
        { T_BEGIN(11)
            DUP(11) if (PH(11)) {
                KArgs ka = kargs(); unsigned char* ws = ka->ws;
                pg8::GroupedOrder S; S.G = G; S.c = vcu; S.nct = 4; { int ps[8]; moe_offsets((gu32*)(ws + WS_CTL) + CW_CNT + fi * 1024, ps, S.tend, S.T); }
                if (!f8) {
                    pg8::Gemm g{(bf16_t*)(ws + WS_ACT), (bf16_t*)(ws + WF_D_MOE), PMAX, NEXP * DM, FFE};
                    pg8::EpiDownMoe E{(const int*)(ws + WS_RINFO), (bf16_t*)(ws + WS_XS), 1.0f};
                    pg8::gemm_phase<pg8::EpiDownMoe, pg8::GroupedOrder, true, true>(lds, g, S, E, wave);
                } else {
                    pg8::Gemm g{(bf16_t*)(ws + WS_ACT), (bf16_t*)(ws + WF_D_MOE), PMAX, NEXP * DM, FFE / 2};
                    pg8::EpiDownMoe E{(const int*)(ws + WS_RINFO), (bf16_t*)(ws + WS_XS), 1.0f / W8S_DN};
                    pg8::gemm_phase<pg8::EpiDownMoe, pg8::GroupedOrder, true, true, true>(lds, g, S, E, wave);
                }
            }
            GRID_BAR();
        T_END(11) }
        }
    }
    if (MK_SKEW_WG >= 0 && (int)blockIdx.x == MK_SKEW_WG) { const unsigned long long te_ = __builtin_amdgcn_s_memrealtime(); while (__builtin_amdgcn_s_memrealtime() - te_ < skew_acc) __builtin_amdgcn_s_sleep(4); }
    { KArgs ka = kargs(); final_combine(ka->out, (const bf16_t*)(ka->ws + WS_XB), (const bf16_t*)(ka->ws + WS_XS), gw, NGW, opaque_v(TIDR) & 63); }
}

extern "C" void kernel_launch(void* const* d_in, const int* in_sizes, int n_in, void* d_out, int out_size, void* d_ws, size_t ws_size, hipStream_t stream) {
    static int grid = 0;
    if (grid == 0) {
        if (n_in != 25 || in_sizes[0] != NTOK * DM || out_size != NTOK * DM || ws_size < WS_END) {
            fprintf(stderr, "kernel_launch: unexpected shapes / workspace (n_in %d, in0 %d, out %d, ws %zu < %zu)\n", n_in, n_in > 0 ? in_sizes[0] : -1, out_size, ws_size, (size_t)WS_END); grid = -1; return; }
        int dev = 0, cus = 0, per_cu = 0;
        if (hipGetDevice(&dev) != hipSuccess || hipDeviceGetAttribute(&cus, hipDeviceAttributeMultiprocessorCount, dev) != hipSuccess) { grid = -1; return; }
        if (hipFuncSetAttribute((const void*)fwd_kernel, hipFuncAttributeMaxDynamicSharedMemorySize, LDS_BYTES) != hipSuccess) { fprintf(stderr, "kernel_launch: hipFuncSetAttribute failed\n"); grid = -1; return; }
        if (hipOccupancyMaxActiveBlocksPerMultiprocessor(&per_cu, (const void*)fwd_kernel, NWAVES * 64, LDS_BYTES) != hipSuccess || per_cu < 1) { fprintf(stderr, "kernel_launch: occupancy query reports %d\n", per_cu); }
        (void)hipGetLastError();
        grid = cus;
    }
    if (grid < 0) return;
    if (hipMemsetAsync((char*)d_ws + WS_CTL, 0, CTL_ZERO_BYTES, stream) != hipSuccess) return;
    Args a{};
    for (int i = 0; i < 25; ++i) a.in[i] = (const float*)d_in[i];
    a.out = (float*)d_out; a.ws = (unsigned char*)d_ws;
    hipLaunchKernelGGL(fwd_kernel, dim3(grid), dim3(NWAVES * 64), LDS_BYTES, stream, a);
}
```
